# Optimizing an MI355X kernel written in HIP

```python
import math
import jax, jax.numpy as jnp
from jax import lax
import numpy as np

D_MODEL = 1024
BATCH = 8
SEQ = 2048
DEPTH = 4

GRID_W = 64
CTX_LEN = 256
N_MIXERS = 2
DA_HEADS = 8
DA_HEAD_DIM = D_MODEL // DA_HEADS // 2
DA_V_DIM = 2 * DA_HEAD_DIM
Q_BLOCK = 128
ROPE_THETA = 10000.0
CHUNK = 128
SG_WIDTH = D_MODEL
SG_GROUPS = 8
SG_GROUP_DIM = SG_WIDTH // SG_GROUPS
D_FF = 2816
N_MOD = 9
RMS_EPS = 1e-6
LN_EPS = 1e-5
N_A_LAYERS = (DEPTH + 1) // 2
N_B_LAYERS = DEPTH // 2

kernel_name = "hybrid_diffattn_sgmlp_macaron_ctxprefix"


def rms_norm(x, g, eps=RMS_EPS):
    xf = x.astype(jnp.float32)
    y = xf * lax.rsqrt(jnp.mean(xf * xf, axis=-1, keepdims=True) + eps)
    return (y * g.astype(jnp.float32)).astype(x.dtype)


def layer_norm(x, g, b, eps=LN_EPS):
    xf = x.astype(jnp.float32)
    mu = jnp.mean(xf, axis=-1, keepdims=True)
    xc = xf - mu
    y = xc * lax.rsqrt(jnp.mean(xc * xc, axis=-1, keepdims=True) + eps)
    return (y * g.astype(jnp.float32) + b.astype(jnp.float32)).astype(x.dtype)


def modulate(x, g, shift, scale):
    return rms_norm(x, g) * (1 + scale) + shift


def ffn_sublayer(h, shift, scale, gate, g, w_gu, w_down):
    xn = modulate(h, g, shift, scale)
    gu = xn @ w_gu
    a, u = gu[..., :D_FF], gu[..., D_FF:]
    y = (jax.nn.silu(a) * u) @ w_down
    return h + 0.5 * gate * y


def axial_rope_tables(n_tokens, dtype):
    rows_n = n_tokens // GRID_W
    row = jnp.repeat(jnp.arange(rows_n), GRID_W)
    col = jnp.tile(jnp.arange(GRID_W), rows_n)
    n_freq = DA_HEAD_DIM // 4
    inv = ROPE_THETA ** (-jnp.arange(n_freq, dtype=jnp.float32) / n_freq)
    pos = jnp.stack([row, col], axis=-1).astype(jnp.float32)
    ang = pos[:, :, None] * inv
    return jnp.cos(ang).astype(dtype), jnp.sin(ang).astype(dtype)


def apply_axial_rope(x, cos, sin):
    shp = x.shape
    xr = x.reshape(shp[:-1] + (2, 2, DA_HEAD_DIM // 4))
    x1, x2 = xr[..., 0, :], xr[..., 1, :]
    cb, sb = cos[:, None, None], sin[:, None, None]
    out = jnp.stack([x1 * cb - x2 * sb, x2 * cb + x1 * sb], axis=-2)
    return out.reshape(shp)


def diff_attend(q, k, v, lam):
    s = jnp.einsum('bqhrd,bkhrd->bhrqk', q, k,
                   preferred_element_type=jnp.float32) * (DA_HEAD_DIM ** -0.5)
    p = jax.nn.softmax(s, axis=-1)
    w = p[:, :, 0] - lam * p[:, :, 1]
    return jnp.einsum('bhqk,bkhe->bqhe', w.astype(v.dtype), v)


def diff_head_out(o, subln_g, lam_init, w_out):
    o = rms_norm(o, subln_g) * (1.0 - lam_init)
    return o.reshape(o.shape[:2] + (D_MODEL,)) @ w_out


def diff_attention_mixer(xl, xc, w_in, w_out, lam_vecs, subln_g, lam_init, cos, sin, ctx_out):
    B, S, _ = xl.shape
    C = xc.shape[1]
    D = D_MODEL
    lv = lam_vecs.astype(jnp.float32)
    lam = (jnp.exp(jnp.sum(lv[0] * lv[1])) - jnp.exp(jnp.sum(lv[2] * lv[3])) + lam_init)
    qkv = xl @ w_in
    q = apply_axial_rope(qkv[..., :D].reshape(B, S, DA_HEADS, 2, DA_HEAD_DIM), cos, sin)
    k = apply_axial_rope(qkv[..., D:2 * D].reshape(B, S, DA_HEADS, 2, DA_HEAD_DIM), cos, sin)
    v = qkv[..., 2 * D:].reshape(B, S, DA_HEADS, DA_V_DIM)
    kv_c = xc @ w_in[:, D:]
    k_c = kv_c[..., :D].reshape(B, C, DA_HEADS, 2, DA_HEAD_DIM)
    v_c = kv_c[..., D:].reshape(B, C, DA_HEADS, DA_V_DIM)
    k_all = jnp.concatenate([k_c, k], axis=1)
    v_all = jnp.concatenate([v_c, v], axis=1)
    nb = S // Q_BLOCK
    qb = q.reshape(B, nb, Q_BLOCK, DA_HEADS, 2, DA_HEAD_DIM).transpose(1, 0, 2, 3, 4, 5)
    ob = lax.map(lambda qi: diff_attend(qi, k_all, v_all, lam), qb)
    o = ob.transpose(1, 0, 2, 3, 4).reshape(B, S, DA_HEADS, DA_V_DIM)
    y = diff_head_out(o, subln_g, lam_init, w_out)
    if ctx_out:
        q_c = (xc @ w_in[:, :D]).reshape(B, C, DA_HEADS, 2, DA_HEAD_DIM)
        o_c = diff_attend(q_c, k_c, v_c, lam)
        y_c = diff_head_out(o_c, subln_g, lam_init, w_out)
    else:
        y_c = None
    return y, y_c


def spatial_gating_mlp(x, w_in, ln_g, ln_b, w_s, b_s, w_out):
    B, L, _ = x.shape
    z = jax.nn.gelu(x @ w_in)
    u, v = z[..., :SG_WIDTH], z[..., SG_WIDTH:]
    v = layer_norm(v, ln_g, ln_b)
    nc = L // CHUNK
    vg = v.reshape(B, nc, CHUNK, SG_GROUPS, SG_GROUP_DIM)
    mixed = jnp.einsum('gts,bnsgc->bntgc', w_s, vg) + b_s.T[None, None, :, :, None]
    return (u * mixed.reshape(B, L, SG_WIDTH)) @ w_out


def setup_inputs(seed: int = 0) -> dict:
    key = jax.random.key(seed)
    ks = jax.random.split(key, 24)
    f32 = jnp.float32
    D = D_MODEL
    nrm = lambda k, shp, s: jax.random.normal(k, shp, f32) * s
    return {
        "x": nrm(ks[0], (BATCH, SEQ, D), 1.0),
        "c": nrm(ks[1], (BATCH, D), 1.0),
        "ctx": nrm(ks[2], (BATCH, CTX_LEN, D), 1.0),
        "c_ctx": nrm(ks[3], (D,), 1.0),
        "w_mod": nrm(ks[4], (DEPTH, D, N_MOD * D), 0.5 * D ** -0.5),
        "b_mod": nrm(ks[5], (DEPTH, N_MOD * D), 0.01),
        "norm_g": 1.0 + nrm(ks[6], (DEPTH, 3, D), 0.01),
        "w_ffn_gu": nrm(ks[7], (DEPTH, 2, D, 2 * D_FF), D ** -0.5),
        "w_ffn_down": nrm(ks[8], (DEPTH, 2, D_FF, D), D_FF ** -0.5),
        "da_w_in": nrm(ks[9], (N_A_LAYERS, D, 3 * D), D ** -0.5),
        "da_w_out": nrm(ks[10], (N_A_LAYERS, D, D), D ** -0.5),
        "da_lambda": nrm(ks[11], (N_A_LAYERS, 4, DA_HEAD_DIM), 0.1),
        "da_subln_g": 1.0 + nrm(ks[12], (N_A_LAYERS, DA_V_DIM), 0.01),
        "sg_w_in": nrm(ks[13], (N_B_LAYERS, D, 2 * SG_WIDTH), D ** -0.5),
        "sg_ln_g": 1.0 + nrm(ks[14], (N_B_LAYERS, SG_WIDTH), 0.01),
        "sg_ln_b": nrm(ks[15], (N_B_LAYERS, SG_WIDTH), 0.01),
        "sg_w_s": nrm(ks[16], (N_B_LAYERS, SG_GROUPS, CHUNK, CHUNK), CHUNK ** -0.5),
        "sg_b_s": 1.0 + nrm(ks[17], (N_B_LAYERS, SG_GROUPS, CHUNK), 0.01),
        "sg_w_out": nrm(ks[18], (N_B_LAYERS, SG_WIDTH, D), SG_WIDTH ** -0.5),
        "final_g": 1.0 + nrm(ks[19], (D,), 0.01),
    }


def reference(x, c, ctx, c_ctx, w_mod, b_mod, norm_g, w_ffn_gu, w_ffn_down,
              da_w_in, da_w_out, da_lambda, da_subln_g,
              sg_w_in, sg_ln_g, sg_ln_b, sg_w_s, sg_b_s, sg_w_out, final_g):
    B, S, _ = x.shape
    cos, sin = axial_rope_tables(S, x.dtype)
    last_ctx_layer = max(i for i in range(DEPTH) if i % N_MIXERS == 0)
    sc = jax.nn.silu(c)
    scc = jax.nn.silu(c_ctx)
    h, hc = x, ctx
    for i in range(DEPTH):
        j = i // N_MIXERS
        mode = 'full' if i < last_ctx_layer else ('kv' if i == last_ctx_layer else 'none')
        mx = (sc @ w_mod[i] + b_mod[i]).reshape(B, N_MOD, 1, D_MODEL)
        mx = [mx[:, k] for k in range(N_MOD)]
        mc = None
        if mode != 'none':
            mc = (scc @ w_mod[i] + b_mod[i]).reshape(N_MOD, D_MODEL)
        h = ffn_sublayer(h, mx[0], mx[1], mx[2], norm_g[i, 0], w_ffn_gu[i, 0], w_ffn_down[i, 0])
        if mode != 'none':
            hc = ffn_sublayer(hc, mc[0], mc[1], mc[2], norm_g[i, 0], w_ffn_gu[i, 0], w_ffn_down[i, 0])
        xn = modulate(h, norm_g[i, 1], mx[3], mx[4])
        xcn = modulate(hc, norm_g[i, 1], mc[3], mc[4]) if mode != 'none' else None
        if i % N_MIXERS == 0:
            lam_init = 0.8 - 0.6 * math.exp(-0.3 * i)
            y, yc = diff_attention_mixer(xn, xcn, da_w_in[j], da_w_out[j], da_lambda[j],
                                         da_subln_g[j], lam_init, cos, sin, mode == 'full')
        else:
            y = spatial_gating_mlp(xn, sg_w_in[j], sg_ln_g[j], sg_ln_b[j], sg_w_s[j], sg_b_s[j], sg_w_out[j])
            yc = (spatial_gating_mlp(xcn, sg_w_in[j], sg_ln_g[j], sg_ln_b[j], sg_w_s[j], sg_b_s[j], sg_w_out[j])
                  if mode == 'full' else None)
        h = h + mx[5] * y
        if mode == 'full':
            hc = hc + mc[5] * yc
        h = ffn_sublayer(h, mx[6], mx[7], mx[8], norm_g[i, 2], w_ffn_gu[i, 1], w_ffn_down[i, 1])
        if mode == 'full':
            hc = ffn_sublayer(hc, mc[6], mc[7], mc[8], norm_g[i, 2], w_ffn_gu[i, 1], w_ffn_down[i, 1])
    return rms_norm(h, final_g)
```

```cpp
#include <hip/hip_runtime.h>
#include <hip/hip_cooperative_groups.h>
#include <cstdio>
#include <cstdint>
namespace cg = cooperative_groups;
namespace pg8 {
#define PG8_LAS __attribute__((address_space(3)))
typedef unsigned short bf16_t;
typedef short bf16x8 __attribute__((ext_vector_type(8)));
typedef float f32x4 __attribute__((ext_vector_type(4)));
typedef unsigned u32x4 __attribute__((ext_vector_type(4)));
constexpr int BM = 256, BK = 64, HALF = 128, HTB = HALF * BK * 2  , STAGE_BYTES = 8 * HTB, NXCD = 8, WGM = 8;

__host__ __device__ __forceinline__ int lds_byte(int r, int c) { const int st = (r >> 4) * 2 + (c >> 5), rr = r & 15, cc = c & 31, ob = rr * 64 + cc * 2; return st * 1024 + (ob ^ (((ob >> 9) & 1) << 5)); }
__host__ __device__ __forceinline__ void stage_rc(int b, int& R, int& C) { const int st = b / 1024, sb = b % 1024, swz = sb ^ (((sb >> 9) & 1) << 5); R = (st >> 1) * 16 + swz / 64; C = (st & 1) * 32 + (swz % 64) / 2; }
__host__ __device__ __forceinline__ int perm32(int rho) { const int n = rho >> 4, i = rho & 15; return 8 * (i >> 2) + 4 * n + (i & 3); }

struct Unit { int pm, pn; };
struct Gemm { const bf16_t* A; const bf16_t* Bt; int M, N, K; };

struct StaticOrder {
    int nM, nN, nwg, G, c;
    __host__ __device__ void init(int M, int N, int G_, int c_) { nM = M / BM; nN = N / BM; nwg = nM * nN; G = G_; c = c_; }
    __host__ __device__ bool next(int i, Unit& u) const {
        const long L = (long)i * G + c; if (L >= nwg) return false;
        int wgid = (int)L; { const int q = nwg / NXCD, r = nwg % NXCD, xcd = wgid % NXCD, off = wgid / NXCD; wgid = (xcd < r ? xcd * (q + 1) : r * (q + 1) + (xcd - r) * q) + off; }
        const int nig = WGM * nN, gid = wgid / nig, fm = gid * WGM, gsz = (nM - fm) < WGM ? (nM - fm) : WGM;
        u.pm = fm + ((wgid % nig) % gsz); u.pn = (wgid % nig) / gsz; return true;
    }
    __device__ __forceinline__ void a_ready(const Unit&) const {}
    __device__ __forceinline__ void done(const Unit&) const {}
};
__device__ __forceinline__ unsigned cvt_pk_bf16(float lo, float hi) { unsigned r; asm volatile("v_cvt_pk_bf16_f32 %0, %1, %2" : "=v"(r) : "v"(lo), "v"(hi)); return r; }
typedef float f32x2 __attribute__((ext_vector_type(2)));
template <class Epi, class Sched, bool ALIGN_EPI = false, bool SP2 = false>
__device__ __forceinline__ void gemm_phase(PG8_LAS unsigned char* lds, const Gemm g, const Sched& S, const Epi& E) {
    int tid_ = threadIdx.x; asm volatile("" : "+v"(tid_)); const int tid = tid_, wid = __builtin_amdgcn_readfirstlane(tid >> 6), lane = tid & 63, wr = wid >> 2, wc = wid & 3, fr = lane & 15, fq = lane >> 4;
    const int K = g.K, nt = K / BK;
    unsigned voffA[2], voffB[2];
#pragma unroll
    for (int i = 0; i < 2; ++i) { int R, C; stage_rc(tid * 16 + i * 8192, R, C); const int Rb = Epi::PERM ? ((R & ~31) + perm32(R & 31)) : R;
        voffA[i] = (unsigned)(R * K + C) * 2u; voffB[i] = (unsigned)(Rb * K + C) * 2u; }
    const size_t kstep = (size_t)(BK * 2);
    const size_t hstep = (size_t)HALF * K * 2;
    const size_t tstep = 2 * hstep;
    const unsigned ldsw = (unsigned)wid * 1024u;
    const int aoff = lds_byte(wr * 64 + fr, fq * 8), boff = lds_byte(wc * 32 + fr, fq * 8);
#define PG8_SA(b, h) (((b) * 2 + (h)) * HTB)
#define PG8_SB(b, h) ((4 + (b) * 2 + (h)) * HTB)
#define PG8_STAGE(bufoff, gbase, voff) do { _Pragma("unroll") for (int _i = 0; _i < 2; ++_i) \
        __builtin_amdgcn_global_load_lds((const unsigned*)((const char*)(gbase) + (voff)[_i]), (PG8_LAS unsigned*)(lds + (bufoff) + ldsw + _i * 8192), 16, 0, 0); } while (0)
#define PG8_LDA(dst, b, h) do { _Pragma("unroll") for (int m = 0; m < 4; ++m) _Pragma("unroll") for (int k = 0; k < 2; ++k) dst[m][k] = *(const PG8_LAS bf16x8*)(lds + PG8_SA(b, h) + aoff + m * 2048 + k * 1024); } while (0)
#define PG8_LDB(dst, b, h) do { _Pragma("unroll") for (int n = 0; n < 2; ++n) _Pragma("unroll") for (int k = 0; k < 2; ++k) dst[n][k] = *(const PG8_LAS bf16x8*)(lds + PG8_SB(b, h) + boff + n * 2048 + k * 1024); } while (0)
#define PG8_MMA(ai, bj, At, Bt) do { __builtin_amdgcn_s_setprio(1); _Pragma("unroll") for (int m = 0; m < 4; ++m) _Pragma("unroll") for (int n = 0; n < 2; ++n) _Pragma("unroll") for (int k = 0; k < 2; ++k) \
        acc[ai][bj][m][n] = __builtin_amdgcn_mfma_f32_16x16x32_bf16(Bt[n][k], At[m][k], acc[ai][bj][m][n], 0, 0, 0); __builtin_amdgcn_s_setprio(0); } while (0)
#define PG8_WAIT_V(n) asm volatile("s_waitcnt vmcnt(" #n ")" ::: "memory")
#define PG8_WAIT_L(n) asm volatile("s_waitcnt lgkmcnt(" #n ")" ::: "memory")
#define PG8_BAR __builtin_amdgcn_s_barrier()
#define PG8_SCHED __builtin_amdgcn_sched_barrier(0)
    Unit cur, nxt; int ui = 0;
    if (!S.next(0, cur)) return;
    f32x4 acc[2][2][4][2];
#pragma unroll
    for (int a = 0; a < 2; ++a)
#pragma unroll
        for (int b = 0; b < 2; ++b)
#pragma unroll
            for (int m = 0; m < 4; ++m)
#pragma unroll
                for (int n = 0; n < 2; ++n) acc[a][b][m][n] = (f32x4){0.f, 0.f, 0.f, 0.f};
    bf16x8 At[4][2], B0[2][2], B1[2][2];
    const char* cA = (const char*)g.A + (size_t)cur.pm * tstep; const char* cB = (const char*)g.Bt + (size_t)cur.pn * tstep;
    S.a_ready(cur);
    if constexpr (SP2) {
        PG8_STAGE(PG8_SB(0, 0), cB, voffB); PG8_STAGE(PG8_SB(0, 1), cB + hstep, voffB); PG8_STAGE(PG8_SA(0, 0), cA, voffA); PG8_STAGE(PG8_SA(0, 1), cA + hstep, voffA);
        if (wr == 1) PG8_BAR;
        PG8_WAIT_V(2); PG8_BAR;
        PG8_STAGE(PG8_SB(1, 0), cB + kstep, voffB); PG8_STAGE(PG8_SA(1, 0), cA + kstep, voffA); PG8_STAGE(PG8_SB(1, 1), cB + hstep + kstep, voffB);
        PG8_WAIT_V(6); PG8_BAR;
    } else {
        PG8_STAGE(PG8_SB(0, 0), cB, voffB); PG8_STAGE(PG8_SA(0, 0), cA, voffA); PG8_STAGE(PG8_SB(0, 1), cB + hstep, voffB); PG8_STAGE(PG8_SA(0, 1), cA + hstep, voffA);
        if (wr == 1) PG8_BAR;
        PG8_WAIT_V(4); PG8_BAR;
        PG8_STAGE(PG8_SB(1, 0), cB + kstep, voffB); PG8_STAGE(PG8_SA(1, 0), cA + kstep, voffA); PG8_STAGE(PG8_SB(1, 1), cB + hstep + kstep, voffB);
        PG8_WAIT_V(6); PG8_BAR;
    }
    for (;;) {
        const bool has_next = S.next(ui + 1, nxt);
        const char* nA = has_next ? (const char*)g.A + (size_t)nxt.pm * tstep : cA; const char* nB = has_next ? (const char*)g.Bt + (size_t)nxt.pn * tstep : cB;
        for (int t = 0; t < nt; t += 2) {
            const bool last = (t == nt - 2);
            const char* a1 = cA + (size_t)(t + 1) * kstep;
            const char* a2 = last ? nA : cA + (size_t)(t + 2) * kstep; const char* b2 = last ? nB : cB + (size_t)(t + 2) * kstep;
            const char* a3 = a2 + kstep; const char* b3 = b2 + kstep;
            if (last && has_next) S.a_ready(nxt);
            if constexpr (SP2) {
            PG8_LDB(B0, 0, 0); PG8_LDB(B1, 0, 1); PG8_SCHED; PG8_LDA(At, 0, 0); PG8_STAGE(PG8_SA(1, 1), a1 + hstep, voffA);
            PG8_WAIT_V(8); PG8_WAIT_L(0); PG8_BAR; PG8_MMA(0, 0, At, B0); PG8_MMA(0, 1, At, B1); PG8_BAR; PG8_SCHED;
            PG8_LDA(At, 0, 1); PG8_STAGE(PG8_SB(0, 0), b2, voffB); PG8_STAGE(PG8_SB(0, 1), b2 + hstep, voffB); PG8_STAGE(PG8_SA(0, 0), a2, voffA);
            PG8_WAIT_V(8); PG8_WAIT_L(0); PG8_BAR; PG8_MMA(1, 0, At, B0); PG8_MMA(1, 1, At, B1); PG8_BAR; PG8_SCHED;
            PG8_LDB(B0, 1, 0); PG8_LDB(B1, 1, 1); PG8_SCHED; PG8_LDA(At, 1, 0); PG8_STAGE(PG8_SA(0, 1), a2 + hstep, voffA);
            PG8_WAIT_V(8); PG8_WAIT_L(0); PG8_BAR; PG8_MMA(0, 0, At, B0); PG8_MMA(0, 1, At, B1); PG8_BAR; PG8_SCHED;
            PG8_LDA(At, 1, 1); PG8_STAGE(PG8_SB(1, 0), b3, voffB); PG8_STAGE(PG8_SB(1, 1), b3 + hstep, voffB); PG8_STAGE(PG8_SA(1, 0), a3, voffA);
            PG8_WAIT_V(8); PG8_WAIT_L(0); PG8_BAR; PG8_MMA(1, 0, At, B0); PG8_MMA(1, 1, At, B1); PG8_BAR; PG8_SCHED;
            } else {
            PG8_LDB(B0, 0, 0); PG8_SCHED; PG8_LDA(At, 0, 0); PG8_STAGE(PG8_SA(1, 1), a1 + hstep, voffA);
            PG8_WAIT_L(8); PG8_BAR; PG8_WAIT_L(0); PG8_MMA(0, 0, At, B0); PG8_BAR; PG8_SCHED;
            PG8_LDB(B1, 0, 1); PG8_STAGE(PG8_SB(0, 0), b2, voffB);
            PG8_BAR; PG8_WAIT_L(0); PG8_MMA(0, 1, At, B1); PG8_BAR;
            PG8_LDA(At, 0, 1); PG8_STAGE(PG8_SA(0, 0), a2, voffA);
            PG8_BAR; PG8_WAIT_L(0); PG8_MMA(1, 0, At, B0); PG8_BAR; PG8_SCHED;
            PG8_STAGE(PG8_SB(0, 1), b2 + hstep, voffB);
            PG8_WAIT_V(6); PG8_BAR; PG8_MMA(1, 1, At, B1); PG8_BAR;
            PG8_LDB(B0, 1, 0); PG8_SCHED; PG8_LDA(At, 1, 0); PG8_STAGE(PG8_SA(0, 1), a2 + hstep, voffA);
            PG8_WAIT_L(8); PG8_BAR; PG8_WAIT_L(0); PG8_MMA(0, 0, At, B0); PG8_BAR; PG8_SCHED;
            PG8_LDB(B1, 1, 1); PG8_STAGE(PG8_SB(1, 0), b3, voffB);
            PG8_BAR; PG8_WAIT_L(0); PG8_MMA(0, 1, At, B1); PG8_BAR;
            PG8_LDA(At, 1, 1); PG8_STAGE(PG8_SA(1, 0), a3, voffA);
            PG8_BAR; PG8_WAIT_L(0); PG8_MMA(1, 0, At, B0); PG8_BAR; PG8_SCHED;
            PG8_STAGE(PG8_SB(1, 1), b3 + hstep, voffB);
            PG8_WAIT_V(6); PG8_BAR; PG8_MMA(1, 1, At, B1); PG8_BAR;
            }
        }
        if constexpr (ALIGN_EPI) { if (wr == 0) PG8_BAR; }
        if constexpr (!Epi::AFTER_DRAIN) { E(acc, cur, wr, wc, fr, fq); S.done(cur); }
        if (!has_next) break;
#pragma unroll
        for (int a = 0; a < 2; ++a)
#pragma unroll
            for (int b = 0; b < 2; ++b)
#pragma unroll
                for (int m = 0; m < 4; ++m)
#pragma unroll
                    for (int n = 0; n < 2; ++n) acc[a][b][m][n] = (f32x4){0.f, 0.f, 0.f, 0.f};
        cur = nxt; cA = nA; cB = nB; ++ui;
        if constexpr (ALIGN_EPI) { if (wr == 1) PG8_BAR; }
    }
    PG8_WAIT_V(0);
    if constexpr (!ALIGN_EPI) { if (wr == 0) PG8_BAR; }
    PG8_BAR;
    if constexpr (Epi::AFTER_DRAIN) { E.fused(acc, cur, wr, wc, fr, fq, lds, wid, lane); S.done(cur); }
#undef PG8_SA
#undef PG8_SB
#undef PG8_STAGE
#undef PG8_LDA
#undef PG8_LDB
#undef PG8_MMA
#undef PG8_WAIT_V
#undef PG8_WAIT_L
#undef PG8_BAR
#undef PG8_SCHED
}
}

constexpr int DM = 1024, NBATCH = 8, SEQ = 2048, CTXL = 256, DFF = 2816, NHEAD = 8;
constexpr int TL = NBATCH * SEQ;
constexpr int TC = NBATCH * CTXL;
constexpr int TT = TL + TC;
constexpr int KVN = SEQ + CTXL;
constexpr int NMODW = 9 * DM;
constexpr float C2 = 0.125f * 1.4426950408889634f;

constexpr size_t MiB = (size_t)1 << 20;
constexpr size_t OFF_MOD = 0;
constexpr size_t OFF_ROPE = 1536 * 1024;
constexpr size_t OFF_SGST = 2 * MiB;
constexpr size_t OFF_WSS = 3 * MiB;
constexpr size_t OFF_WGU = 4 * MiB;
constexpr size_t OFF_WDN = OFF_WGU + 88 * MiB;
constexpr size_t OFF_WINA = OFF_WDN + 44 * MiB;
constexpr size_t OFF_WOUTA = OFF_WINA + 12 * MiB;
constexpr size_t OFF_WINS = OFF_WOUTA + 4 * MiB;
constexpr size_t OFF_WOUTS = OFF_WINS + 8 * MiB;
constexpr size_t OFF_H = OFF_WOUTS + 4 * MiB;
constexpr size_t OFF_XN = OFF_H + 72 * MiB;
constexpr size_t OFF_BIG = OFF_XN + 36 * MiB;
constexpr size_t WS_NEED = OFF_BIG + 108 * MiB;
constexpr size_t SZ_TOK = (size_t)TT * DM * 2;

#define LAS __attribute__((address_space(3)))
typedef unsigned short bf16;
typedef unsigned v4u __attribute__((ext_vector_type(4)));
typedef unsigned v2u __attribute__((ext_vector_type(2)));
typedef float f32x4 __attribute__((ext_vector_type(4)));
typedef float f32x16 __attribute__((ext_vector_type(16)));
typedef short bf16x8 __attribute__((ext_vector_type(8)));
typedef float f32x2_t __attribute__((ext_vector_type(2)));
typedef __bf16 bf16x2_t __attribute__((ext_vector_type(2)));

__device__ __forceinline__ unsigned pk2(float lo, float hi) { f32x2_t v = {lo, hi}; bf16x2_t b = __builtin_convertvector(v, bf16x2_t); return __builtin_bit_cast(unsigned, b); }
__device__ __forceinline__ bf16 f2bf(float f) { return (bf16)(pk2(f, 0.f) & 0xffffu); }
__device__ __forceinline__ float bf2f(unsigned b) { return __uint_as_float(b << 16); }
__device__ __forceinline__ float wave_sum(float v) {
#pragma unroll
    for (int o = 1; o < 64; o <<= 1) v += __shfl_xor(v, o);
    return v;
}
__device__ __forceinline__ float fast_exp2(float x) { return __builtin_amdgcn_exp2f(x); }
__device__ __forceinline__ float fast_rcp(float x) { return __builtin_amdgcn_rcpf(x); }
__device__ __forceinline__ float silu_f(float a) { return a * fast_rcp(1.0f + fast_exp2(-1.4426950408889634f * a)); }
__device__ __forceinline__ float gelu_tanh_f(float x) { const float u = x + 0.044715f * x * x * x; return x * fast_rcp(1.0f + fast_exp2(-2.302208198f * u)); }
__device__ __forceinline__ int crow(int i, int h) { return (i & 3) + 8 * (i >> 2) + 4 * h; }
#define MFMA32(a, b, c) __builtin_amdgcn_mfma_f32_32x32x16_bf16((a), (b), (c), 0, 0, 0)

using pg8::Unit;
struct EpiSwiGLU {
    static constexpr bool PERM = true, AFTER_DRAIN = false;
    bf16* O;
    __device__ __forceinline__ void operator()(const f32x4 (&acc)[2][2][4][2], const Unit& u, int wr, int wc, int fr, int fq) const {
        const int row0 = u.pm * 256 + wr * 64 + fr, col0 = u.pn * 128 + wc * 32 + 8 * fq;
#pragma unroll
        for (int ai = 0; ai < 2; ++ai)
#pragma unroll
            for (int m = 0; m < 4; ++m) {
                bf16* p = O + (size_t)(row0 + ai * 128 + m * 16) * DFF + col0;
                const f32x4 a0 = acc[ai][0][m][0], a1 = acc[ai][0][m][1], u0 = acc[ai][1][m][0], u1 = acc[ai][1][m][1];
                v4u w;
                w.x = pk2(silu_f(a0[0]) * u0[0], silu_f(a0[1]) * u0[1]); w.y = pk2(silu_f(a0[2]) * u0[2], silu_f(a0[3]) * u0[3]);
                w.z = pk2(silu_f(a1[0]) * u1[0], silu_f(a1[1]) * u1[1]); w.w = pk2(silu_f(a1[2]) * u1[2], silu_f(a1[3]) * u1[3]);
                *(v4u*)p = w;
            }
    }
};
struct EpiResid {
    static constexpr bool PERM = false, AFTER_DRAIN = false;
    float* H; const float* gate;
    float coef;
    __device__ __forceinline__ void operator()(const f32x4 (&acc)[2][2][4][2], const Unit& u, int wr, int wc, int fr, int fq) const {
        const int b9 = u.pm < 64 ? (u.pm >> 3) : 8;
        const float* gp = gate + (size_t)b9 * NMODW;
        const int row0 = u.pm * 256 + wr * 64 + fr;
#pragma unroll
        for (int bj = 0; bj < 2; ++bj)
#pragma unroll
            for (int n = 0; n < 2; ++n) {
                const int col = u.pn * 256 + bj * 128 + wc * 32 + n * 16 + 4 * fq;
                const f32x4 gv = *(const f32x4*)(gp + col) * coef;
#pragma unroll
                for (int ai = 0; ai < 2; ++ai)
#pragma unroll
                    for (int m = 0; m < 4; ++m) {
                        float* p = H + (size_t)(row0 + ai * 128 + m * 16) * DM + col;
                        const f32x4 h = *(const f32x4*)p;
                        *(f32x4*)p = h + gv * acc[ai][bj][m][n];
                    }
            }
    }
};
struct EpiQKV {
    static constexpr bool PERM = false, AFTER_DRAIN = false;
    bf16* Q; bf16* K; bf16* Vt; const float* rope;
    __device__ __forceinline__ void operator()(const f32x4 (&acc)[2][2][4][2], const Unit& u, int wr, int wc, int fr, int fq) const {
        const int sect = u.pn >> 2, ct = (u.pn & 3) * 256;
        const bool latent = u.pm < 64;
        if (sect < 2) {
            bf16* base = sect == 0 ? Q : K; const float sc = sect == 0 ? C2 : 1.0f;
            const int axis = wc & 1;
#pragma unroll
            for (int ai = 0; ai < 2; ++ai)
#pragma unroll
                for (int m = 0; m < 4; ++m) {
                    const int row = u.pm * 256 + ai * 128 + wr * 64 + m * 16 + fr;
                    f32x4 cs = (f32x4){1.f, 1.f, 1.f, 1.f}, sn = (f32x4){0.f, 0.f, 0.f, 0.f};
                    if (latent) { const int s = row & 2047; const int pos = axis ? (s & 63) : (s >> 6); cs = *(const f32x4*)(rope + pos * 32 + 4 * fq); sn = *(const f32x4*)(rope + pos * 32 + 16 + 4 * fq); }
#pragma unroll
                    for (int bj = 0; bj < 2; ++bj) {
                        const f32x4 x1 = acc[ai][bj][m][0], x2 = acc[ai][bj][m][1];
                        const f32x4 o1 = (x1 * cs - x2 * sn) * sc, o2 = (x2 * cs + x1 * sn) * sc;
                        bf16* p = base + (size_t)row * DM + ct + bj * 128 + wc * 32 + 4 * fq;
                        v2u w1, w2; w1.x = pk2(o1[0], o1[1]); w1.y = pk2(o1[2], o1[3]); w2.x = pk2(o2[0], o2[1]); w2.y = pk2(o2[2], o2[3]);
                        *(v2u*)p = w1; *(v2u*)(p + 16) = w2;
                    }
                }
        } else {
            const int swz = (fr & 3) | ((fr & 4) << 1) | ((fr & 8) >> 1);
#pragma unroll
            for (int ai = 0; ai < 2; ++ai)
#pragma unroll
                for (int m = 0; m < 4; ++m) {
                    const int row = u.pm * 256 + ai * 128 + wr * 64 + m * 16 + fr;
                    int b, kv; if (latent) { b = row >> 11; kv = row & 2047; } else { const int rr = row - TL; b = rr >> 8; kv = SEQ + (rr & 255); }
                    const int kvpos = (kv & ~15) | swz;
#pragma unroll
                    for (int bj = 0; bj < 2; ++bj) {
                        const int hd = (u.pn - 8) * 2 + bj;
                        bf16* vb = Vt + ((size_t)(b * NHEAD + hd) * 128 + wc * 32 + 4 * fq) * KVN + kvpos;
#pragma unroll
                        for (int n = 0; n < 2; ++n)
#pragma unroll
                            for (int i = 0; i < 4; ++i) vb[(size_t)(n * 16 + i) * KVN] = f2bf(acc[ai][bj][m][n][i]);
                    }
                }
        }
    }
};
struct EpiSG {
    static constexpr bool PERM = false, AFTER_DRAIN = false;
    bf16* ZU; bf16* ZVT; float* stats;
    __device__ __forceinline__ void operator()(const f32x4 (&acc)[2][2][4][2], const Unit& u, int wr, int wc, int fr, int fq) const {
        const int sect = u.pn >> 2, ct = (u.pn & 3) * 256;
#pragma unroll
        for (int ai = 0; ai < 2; ++ai)
#pragma unroll
            for (int m = 0; m < 4; ++m) {
                const int row = u.pm * 256 + ai * 128 + wr * 64 + m * 16 + fr;
                if (sect == 0) {
#pragma unroll
                    for (int bj = 0; bj < 2; ++bj)
#pragma unroll
                        for (int n = 0; n < 2; ++n) {
                            const f32x4 x = acc[ai][bj][m][n];
                            v2u w; w.x = pk2(gelu_tanh_f(x[0]), gelu_tanh_f(x[1])); w.y = pk2(gelu_tanh_f(x[2]), gelu_tanh_f(x[3]));
                            *(v2u*)(ZU + (size_t)row * DM + ct + bj * 128 + wc * 32 + n * 16 + 4 * fq) = w;
                        }
                } else {
                    const int chunk = row >> 7, s = row & 127;
                    float s1 = 0.f, s2 = 0.f;
#pragma unroll
                    for (int bj = 0; bj < 2; ++bj)
#pragma unroll
                        for (int n = 0; n < 2; ++n)
#pragma unroll
                            for (int i = 0; i < 4; ++i) {
                                const float z = gelu_tanh_f(acc[ai][bj][m][n][i]);
                                s1 += z; s2 += z * z;
                                const int c = ct + bj * 128 + wc * 32 + n * 16 + 4 * fq + i;
                                ZVT[((size_t)chunk * DM + c) * 128 + s] = f2bf(z);
                            }
                    s1 += __shfl_xor(s1, 16); s1 += __shfl_xor(s1, 32);
                    s2 += __shfl_xor(s2, 16); s2 += __shfl_xor(s2, 32);
                    if (fq == 0) { atomicAdd(stats + (size_t)row * 2, s1); atomicAdd(stats + (size_t)row * 2 + 1, s2); }
                }
            }
    }
};

template <class T> __device__ __forceinline__ T* as_global(T* p) { return (T*)(__attribute__((address_space(1))) T*)p; }
#define GAS __attribute__((address_space(1)))
struct Args { GAS const float* in_[20]; GAS float* out_; GAS unsigned char* ws_; };
typedef __attribute__((address_space(4))) const Args CArgs;
struct ArgView { CArgs* p;
    __device__ __forceinline__ const float* in(int i) const { return (const float*)p->in_[i]; }
    __device__ __forceinline__ float* out() const { return (float*)p->out_; }
    __device__ __forceinline__ unsigned char* ws() const { return (unsigned char*)p->ws_; } };
enum { I_X = 0, I_C, I_CTX, I_CCTX, I_WMOD, I_BMOD, I_NORMG, I_WGU, I_WDN, I_DAIN, I_DAOUT, I_DALAM, I_DASUB, I_SGIN, I_SGLNG, I_SGLNB, I_SGWS, I_SGBS, I_SGOUT, I_FINALG };

__device__ __forceinline__ ArgView get_args() { CArgs* p = (CArgs*)__builtin_amdgcn_kernarg_segment_ptr(); asm volatile("" : "+s"(p)); ArgView v; v.p = p; return v; }
__device__ __forceinline__ void transpose_item(const float* W, int K, int N, bf16* WT, int k0, int n0, int drow0, LAS float* scr, int lane) {
#pragma unroll 8
    for (int i = 0; i < 32; ++i) { const int kk = 2 * i + (lane >> 5); scr[kk * 33 + (lane & 31)] = W[(size_t)(k0 + kk) * N + n0 + (lane & 31)]; }
    asm volatile("s_waitcnt lgkmcnt(0)" ::: "memory");
    const int c = lane & 7;
#pragma unroll
    for (int j = 0; j < 4; ++j) { const int n = (lane >> 3) + 8 * j; const LAS float* s = scr + (8 * c) * 33 + n;
        v4u o; o.x = pk2(s[0 * 33], s[1 * 33]); o.y = pk2(s[2 * 33], s[3 * 33]); o.z = pk2(s[4 * 33], s[5 * 33]); o.w = pk2(s[6 * 33], s[7 * 33]);
        *(v4u*)(WT + (size_t)(drow0 + n) * K + k0 + 8 * c) = o; }
    asm volatile("s_waitcnt lgkmcnt(0)" ::: "memory");
}

__device__ __forceinline__ void prologue(LAS unsigned char* lds, int blk, int G, int tid) {
    const int lane = tid & 63, wave = tid >> 6;
    const ArgView a = get_args();
    unsigned char* ws = a.ws();
    {
        LAS float* sc = (LAS float*)lds; LAS float* red = sc + 9 * DM;
        for (int i = tid; i < 9 * DM; i += 512) { const int b = i >> 10, k = i & 1023; const float v = b < 8 ? a.in(I_C)[b * DM + k] : a.in(I_CCTX)[k]; sc[i] = v / (1.0f + __expf(-v)); }
        __syncthreads();
        float* MOD = (float*)(ws + OFF_MOD);
        for (int it = blk; it < 4 * 144; it += G) {
            const int l = it / 144, n0 = (it % 144) * 64, col = tid & 63, kp = tid >> 6;
            const float* wp = a.in(I_WMOD) + ((size_t)l * DM + kp * 128) * NMODW + n0 + col;
            float a0 = 0.f, a1 = 0.f, a2 = 0.f, a3 = 0.f, a4 = 0.f, a5 = 0.f, a6 = 0.f, a7 = 0.f, a8 = 0.f;
            const LAS float* sp = sc + kp * 128;
#pragma unroll 8
            for (int kk = 0; kk < 128; ++kk) {
                const float w = wp[(size_t)kk * NMODW];
                a0 += sp[kk] * w; a1 += sp[DM + kk] * w; a2 += sp[2 * DM + kk] * w; a3 += sp[3 * DM + kk] * w; a4 += sp[4 * DM + kk] * w;
                a5 += sp[5 * DM + kk] * w; a6 += sp[6 * DM + kk] * w; a7 += sp[7 * DM + kk] * w; a8 += sp[8 * DM + kk] * w;
            }
            LAS float* rp = red + kp * 9 * 64 + col;
            rp[0] = a0; rp[64] = a1; rp[128] = a2; rp[192] = a3; rp[256] = a4; rp[320] = a5; rp[384] = a6; rp[448] = a7; rp[512] = a8;
            __syncthreads();
            for (int o = tid; o < 576; o += 512) {
                const int b = o >> 6, cc = o & 63; float s = 0.f;
#pragma unroll
                for (int k8 = 0; k8 < 8; ++k8) s += red[(k8 * 9 + b) * 64 + cc];
                MOD[(size_t)(l * 9 + b) * NMODW + n0 + cc] = s + a.in(I_BMOD)[l * NMODW + n0 + cc];
            }
            __syncthreads();
        }
    }
    if (blk == G - 1) {
        float* rope = (float*)(ws + OFF_ROPE);
        for (int idx = tid; idx < 64 * 16; idx += 512) {
            const int pos = idx >> 4, f = idx & 15;
            const float inv = exp2f(-(float)f * 0.8304820237218406f);
            const float ang = (float)pos * inv;
            const double x = (double)ang; const double kq = rint(x * 0.15915494309189535); const double r = x - kq * 6.283185307179586476925;
            const double r2 = r * r; double ts = r, tc = 1.0, ss = r, cc = 1.0;
            for (int n = 1; n <= 16; ++n) { tc *= -r2 / (double)((2 * n - 1) * (2 * n)); ts *= -r2 / (double)((2 * n) * (2 * n + 1)); cc += tc; ss += ts; }
            rope[pos * 32 + f] = (float)cc; rope[pos * 32 + 16 + f] = (float)ss;
        }
    }
    {
        const int gt = blk * 512 + tid, NT = G * 512;
        float* st = (float*)(ws + OFF_SGST);
        for (int i = gt; i < 2 * TT * 2; i += NT) st[i] = 0.f;
        bf16* wss = (bf16*)(ws + OFF_WSS);
        for (int i = gt; i < 2 * 8 * 128 * 128; i += NT) wss[i] = f2bf(a.in(I_SGWS)[i]);
    }
    __syncthreads();
    {
        LAS float* scr = (LAS float*)(lds + wave * 16384);
        const int gw = blk * 8 + wave, NGW = G * 8;
        constexpr int I_GU = 16 * 176, I_DN = 44 * 32, I_AIN = 16 * 96, I_SQ = 16 * 32, I_SIN = 16 * 64;
        constexpr int E0 = 8 * I_GU, E1 = E0 + 8 * I_DN, E2 = E1 + 2 * I_AIN, E3 = E2 + 2 * I_SQ, E4 = E3 + 2 * I_SIN, E5 = E4 + 2 * I_SQ;
        for (int it = gw; it < E5; it += NGW) {
            if (it < E0) { const int mi = it / I_GU, r = it % I_GU, kb = r / 176, nb = r % 176; const int n0 = nb * 32; const int j = n0 < DFF ? n0 : n0 - DFF; const int half = n0 < DFF ? 0 : 1;
                transpose_item(a.in(I_WGU) + (size_t)mi * DM * 2 * DFF, DM, 2 * DFF, (bf16*)(ws + OFF_WGU) + (size_t)mi * 2 * DFF * DM, kb * 64, n0, 256 * (j >> 7) + 128 * half + (j & 127), scr, lane); }
            else if (it < E1) { const int q = it - E0, mi = q / I_DN, r = q % I_DN, kb = r / 32, nb = r % 32;
                transpose_item(a.in(I_WDN) + (size_t)mi * DFF * DM, DFF, DM, (bf16*)(ws + OFF_WDN) + (size_t)mi * DM * DFF, kb * 64, nb * 32, nb * 32, scr, lane); }
            else if (it < E2) { const int q = it - E1, mi = q / I_AIN, r = q % I_AIN, kb = r / 96, nb = r % 96;
                transpose_item(a.in(I_DAIN) + (size_t)mi * DM * 3 * DM, DM, 3 * DM, (bf16*)(ws + OFF_WINA) + (size_t)mi * 3 * DM * DM, kb * 64, nb * 32, nb * 32, scr, lane); }
            else if (it < E3) { const int q = it - E2, mi = q / I_SQ, r = q % I_SQ, kb = r / 32, nb = r % 32;
                transpose_item(a.in(I_DAOUT) + (size_t)mi * DM * DM, DM, DM, (bf16*)(ws + OFF_WOUTA) + (size_t)mi * DM * DM, kb * 64, nb * 32, nb * 32, scr, lane); }
            else if (it < E4) { const int q = it - E3, mi = q / I_SIN, r = q % I_SIN, kb = r / 64, nb = r % 64;
                transpose_item(a.in(I_SGIN) + (size_t)mi * DM * 2 * DM, DM, 2 * DM, (bf16*)(ws + OFF_WINS) + (size_t)mi * 2 * DM * DM, kb * 64, nb * 32, nb * 32, scr, lane); }
            else { const int q = it - E4, mi = q / I_SQ, r = q % I_SQ, kb = r / 32, nb = r % 32;
                transpose_item(a.in(I_SGOUT) + (size_t)mi * DM * DM, DM, DM, (bf16*)(ws + OFF_WOUTS) + (size_t)mi * DM * DM, kb * 64, nb * 32, nb * 32, scr, lane); }
        }
    }
}

__device__ __forceinline__ void norm_phase(const float* src_lat, const float* src_ctx, float* Hcopy, bf16* XN, const float* g, const float* modl, int ishift, int iscale, int Mrows, int gw, int NGW, int lane) {
    for (int row = gw; row < Mrows; row += NGW) {
        const float* xr = row < TL ? src_lat + (size_t)row * DM : src_ctx + (size_t)(row - TL) * DM;
        const int b9 = row < TL ? (row >> 11) : 8;
        f32x4 v[4]; float ss = 0.f;
#pragma unroll
        for (int j = 0; j < 4; ++j) { v[j] = ((const f32x4*)xr)[lane + 64 * j]; ss += (v[j][0] * v[j][0] + v[j][1] * v[j][1]) + (v[j][2] * v[j][2] + v[j][3] * v[j][3]); }
        const float rstd = 1.0f / sqrtf(wave_sum(ss) * (1.0f / DM) + 1e-6f);
        const float* mp = modl + (size_t)b9 * NMODW;
#pragma unroll
        for (int j = 0; j < 4; ++j) {
            const int col = 4 * lane + 256 * j;
            const f32x4 gg = *(const f32x4*)(g + col), sc = *(const f32x4*)(mp + iscale * DM + col), sh = *(const f32x4*)(mp + ishift * DM + col);
            const f32x4 y = (v[j] * rstd) * gg * (sc + 1.0f) + sh;
            v2u w; w.x = pk2(y[0], y[1]); w.y = pk2(y[2], y[3]);
            *(v2u*)(XN + (size_t)row * DM + col) = w;
            if (Hcopy) *(f32x4*)(Hcopy + (size_t)row * DM + col) = v[j];
        }
    }
}
__device__ __forceinline__ void final_norm_phase(const float* H, float* out, const float* g, int gw, int NGW, int lane) {
    for (int row = gw; row < TL; row += NGW) {
        const float* xr = H + (size_t)row * DM;
        f32x4 v[4]; float ss = 0.f;
#pragma unroll
        for (int j = 0; j < 4; ++j) { v[j] = ((const f32x4*)xr)[lane + 64 * j]; ss += (v[j][0] * v[j][0] + v[j][1] * v[j][1]) + (v[j][2] * v[j][2] + v[j][3] * v[j][3]); }
        const float rstd = 1.0f / sqrtf(wave_sum(ss) * (1.0f / DM) + 1e-6f);
#pragma unroll
        for (int j = 0; j < 4; ++j) { const int col = 4 * lane + 256 * j; const f32x4 gg = *(const f32x4*)(g + col); *(f32x4*)(out + (size_t)row * DM + col) = (v[j] * rstd) * gg; }
    }
}

constexpr int AT_KB = 64 * 272, AT_VB = 128 * 144, AT_K0 = 0, AT_V0 = 2 * AT_KB;
__device__ __forceinline__ void attn_phase(LAS unsigned char* lds, const bf16* Q, const bf16* K, const bf16* Vt, bf16* AO, const float* lam4, const float* subg, float lam_init, bool ctxq, int G, int blk, int tid) {
    const int lane = tid & 63, wave = __builtin_amdgcn_readfirstlane(tid >> 6), rg = wave & 3, r = wave >> 2, q32 = lane & 31, hi = lane >> 5;
    float lamv;
    { float x = lam4[lane] * lam4[64 + lane], y = lam4[128 + lane] * lam4[192 + lane]; x = wave_sum(x); y = wave_sum(y); lamv = __expf(x) - __expf(y) + lam_init; }
    const int nunits = 1024 + (ctxq ? 128 : 0);
    for (int uidx = blk; uidx < nunits; uidx += G) {
        int b, h, qrow0, t0, t1;
        if (uidx < 1024) { b = uidx >> 7; h = (uidx >> 4) & 7; qrow0 = b * SEQ + (uidx & 15) * 128; t0 = 0; t1 = 36; }
        else { const int v = uidx - 1024; b = v >> 4; h = (v >> 1) & 7; qrow0 = TL + b * CTXL + (v & 1) * 128; t0 = 32; t1 = 36; }
        bf16x8 qf[4];
        { const bf16* qp = Q + (size_t)(qrow0 + rg * 32 + q32) * DM + h * 128 + r * 64 + hi * 8;
#pragma unroll
          for (int d0 = 0; d0 < 4; ++d0) qf[d0] = *(const bf16x8*)(qp + d0 * 16); }
        f32x16 o[4];
#pragma unroll
        for (int db = 0; db < 4; ++db)
#pragma unroll
            for (int i = 0; i < 16; ++i) o[db][i] = 0.f;
        float mrun = -INFINITY, lrun = 0.f;
        const bf16* kbase = K + h * 128;
        const bf16* vbase = Vt + (size_t)(b * NHEAD + h) * 128 * KVN;
        v4u kreg[2], vreg[2];
#define AT_LOAD(t) do { const size_t rb = (t) < 32 ? (size_t)b * SEQ + (size_t)(t) * 64 : (size_t)TL + (size_t)b * CTXL + (size_t)((t) - 32) * 64; \
        _Pragma("unroll") for (int i_ = 0; i_ < 2; ++i_) { const int c_ = tid + 512 * i_; \
            kreg[i_] = *(const v4u*)(kbase + (rb + (c_ >> 4)) * DM + (c_ & 15) * 8); \
            vreg[i_] = *(const v4u*)(vbase + (size_t)(c_ >> 3) * KVN + (t) * 64 + (c_ & 7) * 8); } } while (0)
#define AT_STORE(buf) do { _Pragma("unroll") for (int i_ = 0; i_ < 2; ++i_) { const int c_ = tid + 512 * i_; \
            *(LAS v4u*)(lds + AT_K0 + (buf) * AT_KB + (c_ >> 4) * 272 + (c_ & 15) * 16) = kreg[i_]; \
            *(LAS v4u*)(lds + AT_V0 + (buf) * AT_VB + (c_ >> 3) * 144 + (c_ & 7) * 16) = vreg[i_]; } } while (0)
        AT_LOAD(t0); AT_STORE(0);
        __syncthreads();
        for (int t = t0; t < t1; ++t) {
            const int cur = (t - t0) & 1;
            if (t + 1 < t1) AT_LOAD(t + 1);
            const LAS unsigned char* kb = lds + AT_K0 + cur * AT_KB + q32 * 272 + (r * 64 + hi * 8) * 2;
            f32x16 s0, s1;
#pragma unroll
            for (int i = 0; i < 16; ++i) { s0[i] = 0.f; s1[i] = 0.f; }
#pragma unroll
            for (int d0 = 0; d0 < 4; ++d0) {
                const bf16x8 k0 = *(const LAS bf16x8*)(kb + d0 * 32), k1 = *(const LAS bf16x8*)(kb + 32 * 272 + d0 * 32);
                s0 = MFMA32(k0, qf[d0], s0); s1 = MFMA32(k1, qf[d0], s1);
            }
            float rm = fmaxf(s0[0], s1[0]);
#pragma unroll
            for (int i = 1; i < 16; ++i) rm = fmaxf(rm, fmaxf(s0[i], s1[i]));
            rm = fmaxf(rm, __shfl_xor(rm, 32));
            if (__any(rm > mrun + 8.0f)) {
                const float mn = fmaxf(mrun, rm), alpha = fast_exp2(mrun - mn);
                lrun *= alpha;
#pragma unroll
                for (int db = 0; db < 4; ++db)
#pragma unroll
                    for (int i = 0; i < 16; ++i) o[db][i] *= alpha;
                mrun = mn;
            }
            float psum = 0.f;
#pragma unroll
            for (int i = 0; i < 16; ++i) { s0[i] = fast_exp2(s0[i] - mrun); s1[i] = fast_exp2(s1[i] - mrun); psum += s0[i] + s1[i]; }
            lrun += psum;
            bf16x8 pf[4];
            { v4u w;
              w.x = pk2(s0[0], s0[1]); w.y = pk2(s0[2], s0[3]); w.z = pk2(s0[4], s0[5]); w.w = pk2(s0[6], s0[7]); pf[0] = __builtin_bit_cast(bf16x8, w);
              w.x = pk2(s0[8], s0[9]); w.y = pk2(s0[10], s0[11]); w.z = pk2(s0[12], s0[13]); w.w = pk2(s0[14], s0[15]); pf[1] = __builtin_bit_cast(bf16x8, w);
              w.x = pk2(s1[0], s1[1]); w.y = pk2(s1[2], s1[3]); w.z = pk2(s1[4], s1[5]); w.w = pk2(s1[6], s1[7]); pf[2] = __builtin_bit_cast(bf16x8, w);
              w.x = pk2(s1[8], s1[9]); w.y = pk2(s1[10], s1[11]); w.z = pk2(s1[12], s1[13]); w.w = pk2(s1[14], s1[15]); pf[3] = __builtin_bit_cast(bf16x8, w); }
            const LAS unsigned char* vb = lds + AT_V0 + cur * AT_VB + q32 * 144 + hi * 16;
#pragma unroll
            for (int db = 0; db < 4; ++db)
#pragma unroll
                for (int ks = 0; ks < 4; ++ks) {
                    const bf16x8 vf = *(const LAS bf16x8*)(vb + db * 32 * 144 + ks * 32);
                    o[db] = MFMA32(vf, pf[ks], o[db]);
                }
            if (t + 1 < t1) AT_STORE(cur ^ 1);
            __syncthreads();
        }
#undef AT_LOAD
#undef AT_STORE
        lrun += __shfl_xor(lrun, 32);
        const float inv = 1.0f / lrun;
        LAS float* xch = (LAS float*)lds + rg * 4096;
        if (r == 1) {
#pragma unroll
            for (int db = 0; db < 4; ++db)
#pragma unroll
                for (int i = 0; i < 16; ++i) xch[(db * 16 + i) * 64 + lane] = o[db][i] * inv;
        }
        __syncthreads();
        if (r == 0) {
            float ss = 0.f;
#pragma unroll
            for (int db = 0; db < 4; ++db)
#pragma unroll
                for (int i = 0; i < 16; ++i) { const float d = o[db][i] * inv - lamv * xch[(db * 16 + i) * 64 + lane]; o[db][i] = d; ss += d * d; }
            ss += __shfl_xor(ss, 32);
            const float rn = (1.0f / sqrtf(ss * (1.0f / 128.0f) + 1e-6f)) * (1.0f - lam_init);
            bf16* op = AO + (size_t)(qrow0 + rg * 32 + q32) * DM + h * 128;
#pragma unroll
            for (int db = 0; db < 4; ++db)
#pragma unroll
                for (int i4 = 0; i4 < 4; ++i4) {
                    const int dcol = 32 * db + 8 * i4 + 4 * hi;
                    const f32x4 g4 = *(const f32x4*)(subg + dcol);
                    v2u w; w.x = pk2(o[db][4 * i4] * rn * g4[0], o[db][4 * i4 + 1] * rn * g4[1]); w.y = pk2(o[db][4 * i4 + 2] * rn * g4[2], o[db][4 * i4 + 3] * rn * g4[3]);
                    *(v2u*)(op + dcol) = w;
                }
        }
        __syncthreads();
    }
}

__device__ __forceinline__ void sgmix_phase(LAS unsigned char* lds, const bf16* ZU, const bf16* ZVT, const float* stats, const bf16* WS, const float* bs, const float* lng, const float* lnb, bf16* Gout, int nchunks, int G, int blk, int tid) {
    const int lane = tid & 63, wave = __builtin_amdgcn_readfirstlane(tid >> 6), q32 = lane & 31, hi = lane >> 5;
    LAS float* smu = (LAS float*)(lds + 40960); LAS float* srs = smu + 128;
    for (int u = blk; u < nchunks * 8; u += G) {
        const int chunk = u >> 3, g = u & 7;
        if (tid < 128) { const int row = chunk * 128 + tid; const float s1 = stats[(size_t)row * 2], s2 = stats[(size_t)row * 2 + 1]; const float mu = s1 * (1.0f / DM); const float var = fmaxf(s2 * (1.0f / DM) - mu * mu, 0.f);
            smu[tid] = mu; srs[tid] = 1.0f / sqrtf(var + 1e-5f); }
        __syncthreads();
#pragma unroll
        for (int it = 0; it < 4; ++it) {
            const int idx = it * 512 + tid, c = idx >> 4, s8 = (idx & 15) * 8;
            const v4u raw = *(const v4u*)(ZVT + ((size_t)chunk * DM + g * 128 + c) * 128 + s8);
            const float gg = lng[g * 128 + c], bb = lnb[g * 128 + c];
            float y[8];
#pragma unroll
            for (int j = 0; j < 4; ++j) { const unsigned wv = raw[j];
                y[2 * j] = (bf2f(wv & 0xffffu) - smu[s8 + 2 * j]) * srs[s8 + 2 * j] * gg + bb;
                y[2 * j + 1] = (bf2f(wv >> 16) - smu[s8 + 2 * j + 1]) * srs[s8 + 2 * j + 1] * gg + bb; }
            v4u w; w.x = pk2(y[0], y[1]); w.y = pk2(y[2], y[3]); w.z = pk2(y[4], y[5]); w.w = pk2(y[6], y[7]);
            *(LAS v4u*)(lds + c * 272 + s8 * 2) = w;
        }
        __syncthreads();
        const int tb = wave >> 1, ch = wave & 1;
        f32x16 acc0, acc1;
#pragma unroll
        for (int i = 0; i < 16; ++i) { acc0[i] = 0.f; acc1[i] = 0.f; }
        const bf16* wp = WS + ((size_t)g * 128 + tb * 32 + q32) * 128 + hi * 8;
        const LAS unsigned char* bp = lds + (ch * 64 + q32) * 272 + hi * 16;
#pragma unroll
        for (int k = 0; k < 8; ++k) {
            const bf16x8 af = *(const bf16x8*)(wp + k * 16);
            const bf16x8 b0 = *(const LAS bf16x8*)(bp + k * 32), b1 = *(const LAS bf16x8*)(bp + 32 * 272 + k * 32);
            acc0 = MFMA32(af, b0, acc0); acc1 = MFMA32(af, b1, acc1);
        }
#pragma unroll
        for (int i = 0; i < 16; ++i) {
            const int t = tb * 32 + crow(i, hi); const size_t row = (size_t)chunk * 128 + t; const float bias = bs[g * 128 + t];
            const int col0 = g * 128 + ch * 64 + q32;
            Gout[row * DM + col0] = f2bf((acc0[i] + bias) * bf2f(ZU[row * DM + col0]));
            Gout[row * DM + col0 + 32] = f2bf((acc1[i] + bias) * bf2f(ZU[row * DM + col0 + 32]));
        }
        __syncthreads();
    }
}

constexpr int LDS_BYTES = 131072 + 2048;
__global__ void __launch_bounds__(512, 2) hybrid_fwd(Args a) {
    extern __shared__ __attribute__((aligned(16))) unsigned char lds_raw[];
    LAS unsigned char* lds = (LAS unsigned char*)lds_raw;
    cg::grid_group grid = cg::this_grid();
    const int G = gridDim.x, blk = blockIdx.x;

#ifndef DIS_PRO
    prologue(lds, blk, G, threadIdx.x);
#endif
    grid.sync();

    for (int ph = 0; ph < 41; ++ph) {
        int tid = threadIdx.x; asm volatile("" : "+v"(tid));
        const int lane = tid & 63, wave = __builtin_amdgcn_readfirstlane(tid >> 6);
        const int gw = blk * 8 + wave, NGW = G * 8;
        const ArgView a = get_args();
        unsigned char* ws = a.ws();
        float* H = (float*)(ws + OFF_H);
        bf16* XN = (bf16*)(ws + OFF_XN);
        bf16* BIG = (bf16*)(ws + OFF_BIG);
        const float* MOD = (const float*)(ws + OFF_MOD);
        if (ph == 40) { final_norm_phase(H, a.out(), a.in(I_FINALG), gw, NGW, lane); break; }
        const int l = ph / 10, s = ph % 10, j = l >> 1;
        const bool attn_layer = (l & 1) == 0;
        const float* modl = MOD + (size_t)l * 9 * NMODW;
        int Mrows = TT; if (l == 3 || (l == 2 && s >= 6)) Mrows = TL;
        if (s == 0 || s == 3 || s == 7) {
            const int k = s == 0 ? 0 : (s == 3 ? 1 : 2);
            const bool init = (ph == 0);
#ifndef DIS_NORM
            norm_phase(init ? a.in(I_X) : H, init ? a.in(I_CTX) : H + (size_t)TL * DM, init ? H : nullptr, XN, a.in(I_NORMG) + (size_t)(l * 3 + k) * DM, modl, 3 * k, 3 * k + 1, Mrows, gw, NGW, lane);
#endif
        } else if (s == 1 || s == 8) {
            const int f = s == 1 ? 0 : 1;
            pg8::Gemm g{XN, (const bf16*)(ws + OFF_WGU) + (size_t)(l * 2 + f) * 2 * DFF * DM, Mrows, 2 * DFF, DM};
            pg8::StaticOrder S; S.init(Mrows, 2 * DFF, G, blk);
            EpiSwiGLU E{BIG};
#ifndef DIS_GU
            pg8::gemm_phase<EpiSwiGLU, pg8::StaticOrder, true, true>(lds, g, S, E);
#endif
        } else if (s == 2 || s == 9 || s == 6) {
            const bf16* A; const bf16* Bt; int Kd; int gidx; float coef;
            if (s == 6) { A = XN; Kd = DM; gidx = 5; coef = 1.0f; Bt = attn_layer ? (const bf16*)(ws + OFF_WOUTA) + (size_t)j * DM * DM : (const bf16*)(ws + OFF_WOUTS) + (size_t)j * DM * DM; }
            else { const int f = s == 2 ? 0 : 1; A = BIG; Kd = DFF; gidx = s == 2 ? 2 : 8; coef = 0.5f; Bt = (const bf16*)(ws + OFF_WDN) + (size_t)(l * 2 + f) * DM * DFF; }
            pg8::Gemm g{A, Bt, Mrows, DM, Kd};
            pg8::StaticOrder S; S.init(Mrows, DM, G, blk);
            EpiResid E{H, modl + gidx * DM, coef};
#ifndef DIS_RES
            pg8::gemm_phase<EpiResid, pg8::StaticOrder, true, true>(lds, g, S, E);
#endif
        } else if (s == 4) {
            if (attn_layer) {
                pg8::Gemm g{XN, (const bf16*)(ws + OFF_WINA) + (size_t)j * 3 * DM * DM, Mrows, 3 * DM, DM};
                pg8::StaticOrder S; S.init(Mrows, 3 * DM, G, blk);
                EpiQKV E{BIG, (bf16*)((unsigned char*)BIG + SZ_TOK), (bf16*)((unsigned char*)BIG + 2 * SZ_TOK), (const float*)(ws + OFF_ROPE)};
#ifndef DIS_QKV
                pg8::gemm_phase<EpiQKV, pg8::StaticOrder, true, true>(lds, g, S, E);
#endif
            } else {
                pg8::Gemm g{XN, (const bf16*)(ws + OFF_WINS) + (size_t)j * 2 * DM * DM, Mrows, 2 * DM, DM};
                pg8::StaticOrder S; S.init(Mrows, 2 * DM, G, blk);
                EpiSG E{BIG, (bf16*)((unsigned char*)BIG + SZ_TOK), (float*)(ws + OFF_SGST) + (size_t)j * TT * 2};
#ifndef DIS_SG
                pg8::gemm_phase<EpiSG, pg8::StaticOrder, true, true>(lds, g, S, E);
#endif
            }
        } else {
            if (attn_layer) {
                const float lam_init = 0.8f - 0.6f * __expf(-0.3f * (float)l);
#ifndef DIS_ATT
                attn_phase(lds, BIG, (const bf16*)((unsigned char*)BIG + SZ_TOK), (const bf16*)((unsigned char*)BIG + 2 * SZ_TOK), XN, a.in(I_DALAM) + j * 256, a.in(I_DASUB) + j * 128, lam_init, l == 0, G, blk, tid);
#endif
            } else {
#ifndef DIS_MIX
                sgmix_phase(lds, BIG, (const bf16*)((unsigned char*)BIG + SZ_TOK), (const float*)(ws + OFF_SGST) + (size_t)j * TT * 2, (const bf16*)(ws + OFF_WSS) + (size_t)j * 8 * 128 * 128,
                            a.in(I_SGBS) + j * 8 * 128, a.in(I_SGLNG) + j * DM, a.in(I_SGLNB) + j * DM, XN, Mrows / 128, G, blk, tid);
#endif
            }
        }
        grid.sync();
    }
}

extern "C" void kernel_launch(void* const* d_in, const int* in_sizes, int n_in, void* d_out, int out_size, void* d_ws, size_t ws_size, hipStream_t stream) {
    static int grid = 0;
    if (grid == 0) {
        if (n_in != 20 || ws_size < WS_NEED || out_size != TL * DM) { fprintf(stderr, "kernel_launch: unexpected problem (n_in %d, ws %zu, out %d)\n", n_in, ws_size, out_size); grid = -1; return; }
        int dev = 0, cus = 0, per_cu = 0;
        if (hipGetDevice(&dev) != hipSuccess || hipDeviceGetAttribute(&cus, hipDeviceAttributeMultiprocessorCount, dev) != hipSuccess) { grid = -1; return; }
        if (hipFuncSetAttribute((const void*)hybrid_fwd, hipFuncAttributeMaxDynamicSharedMemorySize, LDS_BYTES) != hipSuccess) { fprintf(stderr, "kernel_launch: hipFuncSetAttribute failed\n"); grid = -1; return; }
        if (hipOccupancyMaxActiveBlocksPerMultiprocessor(&per_cu, (const void*)hybrid_fwd, 512, LDS_BYTES) != hipSuccess || per_cu < 1) { fprintf(stderr, "kernel_launch: occupancy query says %d\n", per_cu); per_cu = 1; }
        (void)hipGetLastError();
        grid = cus;
    }
    if (grid < 0) return;
    Args a{};
    for (int i = 0; i < 20; ++i) a.in_[i] = (GAS const float*)d_in[i];
    a.out_ = (GAS float*)d_out; a.ws_ = (GAS unsigned char*)d_ws;
    void* params[] = {&a};
    hipError_t e = hipLaunchCooperativeKernel((const void*)hybrid_fwd, dim3(grid), dim3(512), params, LDS_BYTES, stream);
    if (e != hipSuccess) fprintf(stderr, "kernel_launch: cooperative launch failed: %s (grid %d)\n", hipGetErrorString(e), grid);
}
```

```cpp
#include <hip/hip_runtime.h>
#include <hip/hip_cooperative_groups.h>
#include <cstdio>
#include <cstdint>
namespace cg = cooperative_groups;
namespace pg8 {
#define PG8_LAS __attribute__((address_space(3)))
typedef unsigned short bf16_t;
typedef short bf16x8 __attribute__((ext_vector_type(8)));
typedef float f32x4 __attribute__((ext_vector_type(4)));
typedef unsigned u32x4 __attribute__((ext_vector_type(4)));
constexpr int BM = 256, BK = 64, HALF = 128, HTB = HALF * BK * 2  , STAGE_BYTES = 8 * HTB, NXCD = 8, WGM = 8;

__host__ __device__ __forceinline__ int lds_byte(int r, int c) { const int st = (r >> 4) * 2 + (c >> 5), rr = r & 15, cc = c & 31, ob = rr * 64 + cc * 2; return st * 1024 + (ob ^ (((ob >> 9) & 1) << 5)); }
__host__ __device__ __forceinline__ void stage_rc(int b, int& R, int& C) { const int st = b / 1024, sb = b % 1024, swz = sb ^ (((sb >> 9) & 1) << 5); R = (st >> 1) * 16 + swz / 64; C = (st & 1) * 32 + (swz % 64) / 2; }
__host__ __device__ __forceinline__ int perm32(int rho) { const int n = rho >> 4, i = rho & 15; return 8 * (i >> 2) + 4 * n + (i & 3); }

struct Unit { int pm, pn, kt0, nkt, part; };
struct Gemm { const bf16_t* A; const bf16_t* Bt; int M, N, K; };

struct StaticOrder {
    int nM, nN, nwg, G, c, nkt_full;
    __host__ __device__ void init(int M, int N, int G_, int c_) { nM = M / BM; nN = N / BM; nwg = nM * nN; G = G_; c = c_; }
    __host__ __device__ bool next(int i, Unit& u) const {
        const long L = (long)i * G + c; if (L >= nwg) return false;
        int wgid = (int)L; { const int q = nwg / NXCD, r = nwg % NXCD, xcd = wgid % NXCD, off = wgid / NXCD; wgid = (xcd < r ? xcd * (q + 1) : r * (q + 1) + (xcd - r) * q) + off; }
        const int nig = WGM * nN, gid = wgid / nig, fm = gid * WGM, gsz = (nM - fm) < WGM ? (nM - fm) : WGM;
        u.pm = fm + ((wgid % nig) % gsz); u.pn = (wgid % nig) / gsz; u.kt0 = 0; u.nkt = nkt_full; u.part = -1; return true;
    }
    __device__ __forceinline__ void a_ready(const Unit&) const {}
    __device__ __forceinline__ void done(const Unit&) const {}
};
__device__ __forceinline__ unsigned cvt_pk_bf16(float lo, float hi) { unsigned r; asm volatile("v_cvt_pk_bf16_f32 %0, %1, %2" : "=v"(r) : "v"(lo), "v"(hi)); return r; }
typedef float f32x2 __attribute__((ext_vector_type(2)));
template <class Epi, class Sched, bool ALIGN_EPI = false, bool SP2 = false>
__device__ __forceinline__ void gemm_phase(PG8_LAS unsigned char* lds, const Gemm g, const Sched& S, const Epi& E) {
    int tid_ = threadIdx.x; asm volatile("" : "+v"(tid_)); const int tid = tid_, wid = __builtin_amdgcn_readfirstlane(tid >> 6), lane = tid & 63, wr = wid >> 2, wc = wid & 3, fr = lane & 15, fq = lane >> 4;
    const int K = g.K;
    unsigned voffA[2], voffB[2];
#pragma unroll
    for (int i = 0; i < 2; ++i) { int R, C; stage_rc(tid * 16 + i * 8192, R, C); const int Rb = Epi::PERM ? ((R & ~31) + perm32(R & 31)) : R;
        voffA[i] = (unsigned)(R * K + C) * 2u; voffB[i] = (unsigned)(Rb * K + C) * 2u; }
    const size_t kstep = (size_t)(BK * 2);
    const size_t hstep = (size_t)HALF * K * 2;
    const size_t tstep = 2 * hstep;
    const unsigned ldsw = (unsigned)wid * 1024u;
    const int aoff = lds_byte(wr * 64 + fr, fq * 8), boff = lds_byte(wc * 32 + fr, fq * 8);
#define PG8_SA(b, h) (((b) * 2 + (h)) * HTB)
#define PG8_SB(b, h) ((4 + (b) * 2 + (h)) * HTB)
#define PG8_STAGE(bufoff, gbase, voff) do { _Pragma("unroll") for (int _i = 0; _i < 2; ++_i) \
        __builtin_amdgcn_global_load_lds((const unsigned*)((const char*)(gbase) + (voff)[_i]), (PG8_LAS unsigned*)(lds + (bufoff) + ldsw + _i * 8192), 16, 0, 0); } while (0)
#define PG8_LDA(dst, b, h) do { _Pragma("unroll") for (int m = 0; m < 4; ++m) _Pragma("unroll") for (int k = 0; k < 2; ++k) dst[m][k] = *(const PG8_LAS bf16x8*)(lds + PG8_SA(b, h) + aoff + m * 2048 + k * 1024); } while (0)
#define PG8_LDB(dst, b, h) do { _Pragma("unroll") for (int n = 0; n < 2; ++n) _Pragma("unroll") for (int k = 0; k < 2; ++k) dst[n][k] = *(const PG8_LAS bf16x8*)(lds + PG8_SB(b, h) + boff + n * 2048 + k * 1024); } while (0)
#define PG8_MMA(ai, bj, At, Bt) do { __builtin_amdgcn_s_setprio(1); _Pragma("unroll") for (int m = 0; m < 4; ++m) _Pragma("unroll") for (int n = 0; n < 2; ++n) _Pragma("unroll") for (int k = 0; k < 2; ++k) \
        acc[ai][bj][m][n] = __builtin_amdgcn_mfma_f32_16x16x32_bf16(Bt[n][k], At[m][k], acc[ai][bj][m][n], 0, 0, 0); __builtin_amdgcn_s_setprio(0); } while (0)
#define PG8_WAIT_V(n) asm volatile("s_waitcnt vmcnt(" #n ")" ::: "memory")
#define PG8_WAIT_L(n) asm volatile("s_waitcnt lgkmcnt(" #n ")" ::: "memory")
#define PG8_BAR __builtin_amdgcn_s_barrier()
#define PG8_SCHED __builtin_amdgcn_sched_barrier(0)
    Unit cur, nxt; int ui = 0;
    if (!S.next(0, cur)) return;
    f32x4 acc[2][2][4][2];
#pragma unroll
    for (int a = 0; a < 2; ++a)
#pragma unroll
        for (int b = 0; b < 2; ++b)
#pragma unroll
            for (int m = 0; m < 4; ++m)
#pragma unroll
                for (int n = 0; n < 2; ++n) acc[a][b][m][n] = (f32x4){0.f, 0.f, 0.f, 0.f};
    bf16x8 At[4][2], B0[2][2], B1[2][2];
    const char* cA = (const char*)g.A + (size_t)cur.pm * tstep + (size_t)cur.kt0 * (BK * 2); const char* cB = (const char*)g.Bt + (size_t)cur.pn * tstep + (size_t)cur.kt0 * (BK * 2);
    S.a_ready(cur);
    if constexpr (SP2) {
        PG8_STAGE(PG8_SB(0, 0), cB, voffB); PG8_STAGE(PG8_SB(0, 1), cB + hstep, voffB); PG8_STAGE(PG8_SA(0, 0), cA, voffA); PG8_STAGE(PG8_SA(0, 1), cA + hstep, voffA);
        if (wr == 1) PG8_BAR;
        PG8_WAIT_V(2); PG8_BAR;
        PG8_STAGE(PG8_SB(1, 0), cB + kstep, voffB); PG8_STAGE(PG8_SA(1, 0), cA + kstep, voffA); PG8_STAGE(PG8_SB(1, 1), cB + hstep + kstep, voffB);
        PG8_WAIT_V(6); PG8_BAR;
    } else {
        PG8_STAGE(PG8_SB(0, 0), cB, voffB); PG8_STAGE(PG8_SA(0, 0), cA, voffA); PG8_STAGE(PG8_SB(0, 1), cB + hstep, voffB); PG8_STAGE(PG8_SA(0, 1), cA + hstep, voffA);
        if (wr == 1) PG8_BAR;
        PG8_WAIT_V(4); PG8_BAR;
        PG8_STAGE(PG8_SB(1, 0), cB + kstep, voffB); PG8_STAGE(PG8_SA(1, 0), cA + kstep, voffA); PG8_STAGE(PG8_SB(1, 1), cB + hstep + kstep, voffB);
        PG8_WAIT_V(6); PG8_BAR;
    }
    for (;;) {
        const bool has_next = S.next(ui + 1, nxt);
        const char* nA = has_next ? (const char*)g.A + (size_t)nxt.pm * tstep + (size_t)nxt.kt0 * (BK * 2) : cA; const char* nB = has_next ? (const char*)g.Bt + (size_t)nxt.pn * tstep + (size_t)nxt.kt0 * (BK * 2) : cB;
        const int nt = cur.nkt;
        for (int t = 0; t < nt; t += 2) {
            const bool last = (t == nt - 2);
            const char* a1 = cA + (size_t)(t + 1) * kstep;
            const char* a2 = last ? nA : cA + (size_t)(t + 2) * kstep; const char* b2 = last ? nB : cB + (size_t)(t + 2) * kstep;
            const char* a3 = a2 + kstep; const char* b3 = b2 + kstep;
            if (last && has_next) S.a_ready(nxt);
            if constexpr (SP2) {
            PG8_LDB(B0, 0, 0); PG8_LDB(B1, 0, 1); PG8_SCHED; PG8_LDA(At, 0, 0); PG8_STAGE(PG8_SA(1, 1), a1 + hstep, voffA);
            PG8_WAIT_V(8); PG8_WAIT_L(0); PG8_BAR; PG8_MMA(0, 0, At, B0); PG8_MMA(0, 1, At, B1); PG8_BAR; PG8_SCHED;
            PG8_LDA(At, 0, 1); PG8_STAGE(PG8_SB(0, 0), b2, voffB); PG8_STAGE(PG8_SB(0, 1), b2 + hstep, voffB); PG8_STAGE(PG8_SA(0, 0), a2, voffA);
            PG8_WAIT_V(8); PG8_WAIT_L(0); PG8_BAR; PG8_MMA(1, 0, At, B0); PG8_MMA(1, 1, At, B1); PG8_BAR; PG8_SCHED;
            PG8_LDB(B0, 1, 0); PG8_LDB(B1, 1, 1); PG8_SCHED; PG8_LDA(At, 1, 0); PG8_STAGE(PG8_SA(0, 1), a2 + hstep, voffA);
            PG8_WAIT_V(8); PG8_WAIT_L(0); PG8_BAR; PG8_MMA(0, 0, At, B0); PG8_MMA(0, 1, At, B1); PG8_BAR; PG8_SCHED;
            PG8_LDA(At, 1, 1); PG8_STAGE(PG8_SB(1, 0), b3, voffB); PG8_STAGE(PG8_SB(1, 1), b3 + hstep, voffB); PG8_STAGE(PG8_SA(1, 0), a3, voffA);
            PG8_WAIT_V(8); PG8_WAIT_L(0); PG8_BAR; PG8_MMA(1, 0, At, B0); PG8_MMA(1, 1, At, B1); PG8_BAR; PG8_SCHED;
            } else {
            PG8_LDB(B0, 0, 0); PG8_SCHED; PG8_LDA(At, 0, 0); PG8_STAGE(PG8_SA(1, 1), a1 + hstep, voffA);
            PG8_WAIT_L(8); PG8_BAR; PG8_WAIT_L(0); PG8_MMA(0, 0, At, B0); PG8_BAR; PG8_SCHED;
            PG8_LDB(B1, 0, 1); PG8_STAGE(PG8_SB(0, 0), b2, voffB);
            PG8_BAR; PG8_WAIT_L(0); PG8_MMA(0, 1, At, B1); PG8_BAR;
            PG8_LDA(At, 0, 1); PG8_STAGE(PG8_SA(0, 0), a2, voffA);
            PG8_BAR; PG8_WAIT_L(0); PG8_MMA(1, 0, At, B0); PG8_BAR; PG8_SCHED;
            PG8_STAGE(PG8_SB(0, 1), b2 + hstep, voffB);
            PG8_WAIT_V(6); PG8_BAR; PG8_MMA(1, 1, At, B1); PG8_BAR;
            PG8_LDB(B0, 1, 0); PG8_SCHED; PG8_LDA(At, 1, 0); PG8_STAGE(PG8_SA(0, 1), a2 + hstep, voffA);
            PG8_WAIT_L(8); PG8_BAR; PG8_WAIT_L(0); PG8_MMA(0, 0, At, B0); PG8_BAR; PG8_SCHED;
            PG8_LDB(B1, 1, 1); PG8_STAGE(PG8_SB(1, 0), b3, voffB);
            PG8_BAR; PG8_WAIT_L(0); PG8_MMA(0, 1, At, B1); PG8_BAR;
            PG8_LDA(At, 1, 1); PG8_STAGE(PG8_SA(1, 0), a3, voffA);
            PG8_BAR; PG8_WAIT_L(0); PG8_MMA(1, 0, At, B0); PG8_BAR; PG8_SCHED;
            PG8_STAGE(PG8_SB(1, 1), b3 + hstep, voffB);
            PG8_WAIT_V(6); PG8_BAR; PG8_MMA(1, 1, At, B1); PG8_BAR;
            }
        }
        if constexpr (ALIGN_EPI) { if (wr == 0) PG8_BAR; }
        if constexpr (!Epi::AFTER_DRAIN) { E(acc, cur, wr, wc, fr, fq); S.done(cur); }
        if (!has_next) break;
#pragma unroll
        for (int a = 0; a < 2; ++a)
#pragma unroll
            for (int b = 0; b < 2; ++b)
#pragma unroll
                for (int m = 0; m < 4; ++m)
#pragma unroll
                    for (int n = 0; n < 2; ++n) acc[a][b][m][n] = (f32x4){0.f, 0.f, 0.f, 0.f};
        cur = nxt; cA = nA; cB = nB; ++ui;
        if constexpr (ALIGN_EPI) { if (wr == 1) PG8_BAR; }
    }
    PG8_WAIT_V(0);
    if constexpr (!ALIGN_EPI) { if (wr == 0) PG8_BAR; }
    PG8_BAR;
    if constexpr (Epi::AFTER_DRAIN) { E.fused(acc, cur, wr, wc, fr, fq, lds, wid, lane); S.done(cur); }
#undef PG8_SA
#undef PG8_SB
#undef PG8_STAGE
#undef PG8_LDA
#undef PG8_LDB
#undef PG8_MMA
#undef PG8_WAIT_V
#undef PG8_WAIT_L
#undef PG8_BAR
#undef PG8_SCHED
}
}

constexpr int DM = 1024, NBATCH = 8, SEQ = 2048, CTXL = 256, DFF = 2816, NHEAD = 8;
constexpr int TL = NBATCH * SEQ;
constexpr int TC = NBATCH * CTXL;
constexpr int TT = TL + TC;
constexpr int KVN = SEQ + CTXL;
constexpr int NMODW = 9 * DM;
constexpr float C2 = 0.125f * 1.4426950408889634f;

constexpr size_t MiB = (size_t)1 << 20;
constexpr size_t OFF_MOD = 0;
constexpr size_t OFF_ROPE = 1536 * 1024;
constexpr size_t OFF_BAR = 1792 * 1024;
constexpr size_t OFF_WSS = 3 * MiB;
constexpr size_t OFF_WGU = 4 * MiB;
constexpr size_t OFF_WDN = OFF_WGU + 88 * MiB;
constexpr size_t OFF_WINA = OFF_WDN + 44 * MiB;
constexpr size_t OFF_WOUTA = OFF_WINA + 12 * MiB;
constexpr size_t OFF_WINS = OFF_WOUTA + 4 * MiB;
constexpr size_t OFF_WOUTS = OFF_WINS + 8 * MiB;
constexpr size_t OFF_H = OFF_WOUTS + 4 * MiB;
constexpr size_t OFF_XN = OFF_H + 72 * MiB;
constexpr size_t OFF_BIG = OFF_XN + 36 * MiB;
constexpr size_t OFF_PART = OFF_BIG + 108 * MiB;
constexpr size_t OFF_SGST2 = OFF_PART + 64 * MiB;
constexpr size_t WS_NEED = OFF_SGST2 + 6 * MiB;
constexpr size_t SZ_TOK = (size_t)TT * DM * 2;

#define LAS __attribute__((address_space(3)))
typedef unsigned short bf16;
typedef unsigned v4u __attribute__((ext_vector_type(4)));
typedef unsigned v2u __attribute__((ext_vector_type(2)));
typedef float f32x4 __attribute__((ext_vector_type(4)));
typedef float f32x16 __attribute__((ext_vector_type(16)));
typedef short bf16x8 __attribute__((ext_vector_type(8)));
typedef float f32x2_t __attribute__((ext_vector_type(2)));
typedef __bf16 bf16x2_t __attribute__((ext_vector_type(2)));

__device__ __forceinline__ unsigned pk2(float lo, float hi) { f32x2_t v = {lo, hi}; bf16x2_t b = __builtin_convertvector(v, bf16x2_t); return __builtin_bit_cast(unsigned, b); }
__device__ __forceinline__ bf16 f2bf(float f) { return (bf16)(pk2(f, 0.f) & 0xffffu); }
__device__ __forceinline__ float bf2f(unsigned b) { return __uint_as_float(b << 16); }
__device__ __forceinline__ f32x4 ldh4(const bf16* p) { const v2u r = *(const v2u*)p; return (f32x4){bf2f(r.x & 0xffffu), bf2f(r.x >> 16), bf2f(r.y & 0xffffu), bf2f(r.y >> 16)}; }
__device__ __forceinline__ void sth4(bf16* p, f32x4 v) { v2u w; w.x = pk2(v[0], v[1]); w.y = pk2(v[2], v[3]); *(v2u*)p = w; }
__device__ __forceinline__ int ncol(int lane, int j) { return 8 * lane + 512 * (j >> 1) + 4 * (j & 1); }
__device__ __forceinline__ void ldh8(const bf16* p, f32x4& a, f32x4& b) { const v4u r = *(const v4u*)p; a = (f32x4){bf2f(r.x & 0xffffu), bf2f(r.x >> 16), bf2f(r.y & 0xffffu), bf2f(r.y >> 16)}; b = (f32x4){bf2f(r.z & 0xffffu), bf2f(r.z >> 16), bf2f(r.w & 0xffffu), bf2f(r.w >> 16)}; }
__device__ __forceinline__ void sth8(bf16* p, f32x4 a, f32x4 b) { v4u w; w.x = pk2(a[0], a[1]); w.y = pk2(a[2], a[3]); w.z = pk2(b[0], b[1]); w.w = pk2(b[2], b[3]); *(v4u*)p = w; }
__device__ __forceinline__ float wave_sum(float v) {
#pragma unroll
    for (int o = 1; o < 64; o <<= 1) v += __shfl_xor(v, o);
    return v;
}
__device__ __forceinline__ float xhalf_max(float m) { auto rr = __builtin_amdgcn_permlane32_swap(__float_as_uint(m), __float_as_uint(m), false, false); return fmaxf(__uint_as_float(rr[0]), __uint_as_float(rr[1])); }
__device__ __forceinline__ float xhalf_sum(float m) { auto rr = __builtin_amdgcn_permlane32_swap(__float_as_uint(m), __float_as_uint(m), false, false); return __uint_as_float(rr[0]) + __uint_as_float(rr[1]); }
__device__ __forceinline__ float max3f(float a, float b, float c) { float r; asm("v_max3_f32 %0, %1, %2, %3" : "=v"(r) : "v"(a), "v"(b), "v"(c)); return r; }
__device__ __forceinline__ float fast_exp2(float x) { return __builtin_amdgcn_exp2f(x); }
__device__ __forceinline__ float fast_rcp(float x) { return __builtin_amdgcn_rcpf(x); }
__device__ __forceinline__ float silu_f(float a) { return a * fast_rcp(1.0f + fast_exp2(-1.4426950408889634f * a)); }
__device__ __forceinline__ float gelu_tanh_f(float x) { const float u = x + 0.044715f * x * x * x; return x * fast_rcp(1.0f + fast_exp2(-2.302208198f * u)); }
__device__ __forceinline__ int crow(int i, int h) { return (i & 3) + 8 * (i >> 2) + 4 * h; }
#define MFMA32(a, b, c) __builtin_amdgcn_mfma_f32_32x32x16_bf16((a), (b), (c), 0, 0, 0)

using pg8::Unit;
struct SplitOrder {
    pg8::StaticOrder lat; int G, c, nsl, nkt;
    __device__ __forceinline__ void init(int nsl_, int nkt_, int G_, int c_) { lat.init(TL, DM, G_, c_); lat.nkt_full = nkt_; G = G_; c = c_; nsl = nsl_; nkt = nkt_; }
    __device__ __forceinline__ bool next(int i, Unit& u) const {
        const int nrl = (256 + G - 1) / G;
        if (i < nrl) { if (lat.next(i, u)) return true; }
        const int q = (i - nrl) * G + c;
        if (i < nrl || q >= 32 * nsl) return false;
        const int tctx = q / nsl, sl = q % nsl, pairs = nkt >> 1, base = pairs / nsl, rem = pairs % nsl;
        u.pm = 64 + (tctx >> 2); u.pn = tctx & 3; u.kt0 = 2 * (sl * base + (sl < rem ? sl : rem)); u.nkt = 2 * (base + (sl < rem ? 1 : 0)); u.part = q; return true;
    }
    __device__ __forceinline__ void a_ready(const Unit&) const {}
    __device__ __forceinline__ void done(const Unit&) const {}
};
struct EpiSwiGLU {
    static constexpr bool PERM = true, AFTER_DRAIN = false;
    bf16* O;
    __device__ __forceinline__ void operator()(const f32x4 (&acc)[2][2][4][2], const Unit& u, int wr, int wc, int fr, int fq) const {
        const int row0 = u.pm * 256 + wr * 64 + fr, col0 = u.pn * 128 + wc * 32 + 8 * fq;
#pragma unroll
        for (int ai = 0; ai < 2; ++ai)
#pragma unroll
            for (int m = 0; m < 4; ++m) {
                bf16* p = O + (size_t)(row0 + ai * 128 + m * 16) * DFF + col0;
                const f32x4 a0 = acc[ai][0][m][0], a1 = acc[ai][0][m][1], u0 = acc[ai][1][m][0], u1 = acc[ai][1][m][1];
                v4u w;
                w.x = pk2(silu_f(a0[0]) * u0[0], silu_f(a0[1]) * u0[1]); w.y = pk2(silu_f(a0[2]) * u0[2], silu_f(a0[3]) * u0[3]);
                w.z = pk2(silu_f(a1[0]) * u1[0], silu_f(a1[1]) * u1[1]); w.w = pk2(silu_f(a1[2]) * u1[2], silu_f(a1[3]) * u1[3]);
                *(v4u*)p = w;
            }
    }
};
struct EpiResid {
    static constexpr bool PERM = true, AFTER_DRAIN = false;
    unsigned char* ws; const float* gate; int half;
    __device__ __forceinline__ void operator()(const f32x4 (&acc)[2][2][4][2], const Unit& u, int wr, int wc, int fr, int fq) const {
        bf16* H = (bf16*)(ws + OFF_H); bf16* part = (bf16*)(ws + OFF_PART); const float coef = half ? 0.5f : 1.0f;
        if (u.part >= 0) {
            bf16* pp = part + (size_t)u.part * 65536 + (size_t)(wr * 64 + fr) * 256 + wc * 32 + 8 * fq;
#pragma unroll
            for (int ai = 0; ai < 2; ++ai)
#pragma unroll
                for (int m = 0; m < 4; ++m)
#pragma unroll
                    for (int bj = 0; bj < 2; ++bj) {
                        const f32x4 x0 = acc[ai][bj][m][0], x1 = acc[ai][bj][m][1];
                        v4u w; w.x = pk2(x0[0], x0[1]); w.y = pk2(x0[2], x0[3]); w.z = pk2(x1[0], x1[1]); w.w = pk2(x1[2], x1[3]);
                        *(v4u*)(pp + (size_t)(ai * 128 + m * 16) * 256 + bj * 128) = w;
                    }
            return;
        }
        const int b9 = u.pm < 64 ? (u.pm >> 3) : 8;
        const float* gp = gate + (size_t)b9 * NMODW;
        const int row0 = u.pm * 256 + wr * 64 + fr;
#pragma unroll
        for (int bj = 0; bj < 2; ++bj) {
            const int col = u.pn * 256 + bj * 128 + wc * 32 + 8 * fq;
            const f32x4 gv0 = *(const f32x4*)(gp + col) * coef, gv1 = *(const f32x4*)(gp + col + 4) * coef;
            v4u h[2][4];
#pragma unroll
            for (int ai = 0; ai < 2; ++ai)
#pragma unroll
                for (int m = 0; m < 4; ++m) h[ai][m] = *(const v4u*)(H + (size_t)(row0 + ai * 128 + m * 16) * DM + col);
#pragma unroll
            for (int ai = 0; ai < 2; ++ai)
#pragma unroll
                for (int m = 0; m < 4; ++m) {
                    const v4u r = h[ai][m];
                    const f32x4 h0 = (f32x4){bf2f(r.x & 0xffffu), bf2f(r.x >> 16), bf2f(r.y & 0xffffu), bf2f(r.y >> 16)};
                    const f32x4 h1 = (f32x4){bf2f(r.z & 0xffffu), bf2f(r.z >> 16), bf2f(r.w & 0xffffu), bf2f(r.w >> 16)};
                    const f32x4 y0 = h0 + gv0 * acc[ai][bj][m][0], y1 = h1 + gv1 * acc[ai][bj][m][1];
                    v4u w; w.x = pk2(y0[0], y0[1]); w.y = pk2(y0[2], y0[3]); w.z = pk2(y1[0], y1[1]); w.w = pk2(y1[2], y1[3]);
                    *(v4u*)(H + (size_t)(row0 + ai * 128 + m * 16) * DM + col) = w;
                }
        }
    }
};
struct EpiQKV {
    static constexpr bool PERM = false, AFTER_DRAIN = false;
    bf16* Q; bf16* K; bf16* Vt; const float* rope;
    __device__ __forceinline__ void operator()(const f32x4 (&acc)[2][2][4][2], const Unit& u, int wr, int wc, int fr, int fq) const {
        const int sect = u.pn >> 2, ct = (u.pn & 3) * 256;
        const bool latent = u.pm < 64;
        if (sect < 2) {
            bf16* base = sect == 0 ? Q : K; const float sc = sect == 0 ? C2 : 1.0f;
            const int axis = wc & 1;
            f32x4 csv[2][4], snv[2][4];
#pragma unroll
            for (int ai = 0; ai < 2; ++ai)
#pragma unroll
                for (int m = 0; m < 4; ++m) {
                    const int row = u.pm * 256 + ai * 128 + wr * 64 + m * 16 + fr;
                    csv[ai][m] = (f32x4){1.f, 1.f, 1.f, 1.f}; snv[ai][m] = (f32x4){0.f, 0.f, 0.f, 0.f};
                    if (latent) { const int s = row & 2047; const int pos = axis ? (s & 63) : (s >> 6); csv[ai][m] = *(const f32x4*)(rope + pos * 32 + 4 * fq); snv[ai][m] = *(const f32x4*)(rope + pos * 32 + 16 + 4 * fq); }
                }
#pragma unroll
            for (int ai = 0; ai < 2; ++ai)
#pragma unroll
                for (int m = 0; m < 4; ++m) {
                    const int row = u.pm * 256 + ai * 128 + wr * 64 + m * 16 + fr;
                    const f32x4 cs = csv[ai][m], sn = snv[ai][m];
#pragma unroll
                    for (int bj = 0; bj < 2; ++bj) {
                        const f32x4 x1 = acc[ai][bj][m][0], x2 = acc[ai][bj][m][1];
                        const f32x4 o1 = (x1 * cs - x2 * sn) * sc, o2 = (x2 * cs + x1 * sn) * sc;
                        bf16* p = base + (size_t)row * DM + ct + bj * 128 + wc * 32 + 8 * fq;
                        v4u w; w.x = pk2(o1[0], o1[1]); w.y = pk2(o1[2], o1[3]); w.z = pk2(o2[0], o2[1]); w.w = pk2(o2[2], o2[3]);
                        *(v4u*)p = w;
                    }
                }
        } else {
            const int swz = (fr & 3) | ((fr & 4) << 1) | ((fr & 8) >> 1);
#pragma unroll
            for (int ai = 0; ai < 2; ++ai)
#pragma unroll
                for (int m = 0; m < 4; ++m) {
                    const int row = u.pm * 256 + ai * 128 + wr * 64 + m * 16 + fr;
                    int b, kv; if (latent) { b = row >> 11; kv = row & 2047; } else { const int rr = row - TL; b = rr >> 8; kv = SEQ + (rr & 255); }
                    const int kvpos = (kv & ~15) | swz;
#pragma unroll
                    for (int bj = 0; bj < 2; ++bj) {
                        const int hd = (u.pn - 8) * 2 + bj;
                        bf16* vb = Vt + ((size_t)(b * NHEAD + hd) * 128 + wc * 32 + 4 * fq) * KVN + kvpos;
#pragma unroll
                        for (int n = 0; n < 2; ++n)
#pragma unroll
                            for (int i = 0; i < 4; ++i) vb[(size_t)(n * 16 + i) * KVN] = f2bf(acc[ai][bj][m][n][i]);
                    }
                }
        }
    }
};
struct EpiSG {
    static constexpr bool PERM = true, AFTER_DRAIN = false;
    bf16* ZU; bf16* ZVT; float* stats;
    __device__ __forceinline__ void operator()(const f32x4 (&acc)[2][2][4][2], const Unit& u, int wr, int wc, int fr, int fq) const {
        const int sect = u.pn >> 2, ct = (u.pn & 3) * 256;
#pragma unroll
        for (int ai = 0; ai < 2; ++ai)
#pragma unroll
            for (int m = 0; m < 4; ++m) {
                const int row = u.pm * 256 + ai * 128 + wr * 64 + m * 16 + fr;
                if (sect == 0) {
#pragma unroll
                    for (int bj = 0; bj < 2; ++bj) {
                        const f32x4 x0 = acc[ai][bj][m][0], x1 = acc[ai][bj][m][1];
                        v4u w; w.x = pk2(gelu_tanh_f(x0[0]), gelu_tanh_f(x0[1])); w.y = pk2(gelu_tanh_f(x0[2]), gelu_tanh_f(x0[3])); w.z = pk2(gelu_tanh_f(x1[0]), gelu_tanh_f(x1[1])); w.w = pk2(gelu_tanh_f(x1[2]), gelu_tanh_f(x1[3]));
                        *(v4u*)(ZU + (size_t)row * DM + ct + bj * 128 + wc * 32 + 8 * fq) = w;
                    }
                } else {
                    const int chunk = row >> 7, s = row & 127;
                    float s1 = 0.f, s2 = 0.f;
#pragma unroll
                    for (int bj = 0; bj < 2; ++bj)
#pragma unroll
                        for (int n = 0; n < 2; ++n)
#pragma unroll
                            for (int i = 0; i < 4; ++i) {
                                const float z = gelu_tanh_f(acc[ai][bj][m][n][i]);
                                s1 += z; s2 += z * z;
                                const int c = ct + bj * 128 + wc * 32 + 8 * fq + 4 * n + i;
                                ZVT[((size_t)chunk * DM + c) * 128 + s] = f2bf(z);
                            }
                    s1 += __shfl_xor(s1, 16); s1 += __shfl_xor(s1, 32);
                    s2 += __shfl_xor(s2, 16); s2 += __shfl_xor(s2, 32);
                    if (fq == 0) { float* sp = stats + ((size_t)row * 16 + (u.pn - 4) * 4 + wc) * 2; sp[0] = s1; sp[1] = s2; }
                }
            }
    }
};

template <class T> __device__ __forceinline__ T* as_global(T* p) { return (T*)(__attribute__((address_space(1))) T*)p; }
#define GAS __attribute__((address_space(1)))
struct Args { GAS const float* in_[20]; GAS float* out_; GAS unsigned char* ws_; };
typedef __attribute__((address_space(4))) const Args CArgs;
struct ArgView { CArgs* p;
    __device__ __forceinline__ const float* in(int i) const { return (const float*)p->in_[i]; }
    __device__ __forceinline__ float* out() const { return (float*)p->out_; }
    __device__ __forceinline__ unsigned char* ws() const { return (unsigned char*)p->ws_; } };
enum { I_X = 0, I_C, I_CTX, I_CCTX, I_WMOD, I_BMOD, I_NORMG, I_WGU, I_WDN, I_DAIN, I_DAOUT, I_DALAM, I_DASUB, I_SGIN, I_SGLNG, I_SGLNB, I_SGWS, I_SGBS, I_SGOUT, I_FINALG };

__device__ __forceinline__ ArgView get_args() { CArgs* p = (CArgs*)__builtin_amdgcn_kernarg_segment_ptr(); asm volatile("" : "+s"(p)); ArgView v; v.p = p; return v; }
__device__ __forceinline__ void transpose_item(const float* W, int K, int N, bf16* WT, int k0, int n0, int drow0, LAS float* scr, int lane) {
    float rv[32];
#pragma unroll
    for (int i = 0; i < 32; ++i) rv[i] = W[(size_t)(k0 + 2 * i + (lane >> 5)) * N + n0 + (lane & 31)];
#pragma unroll
    for (int i = 0; i < 32; ++i) scr[(2 * i + (lane >> 5)) * 33 + (lane & 31)] = rv[i];
    asm volatile("s_waitcnt lgkmcnt(0)" ::: "memory");
    const int c = lane & 7;
#pragma unroll
    for (int j = 0; j < 4; ++j) { const int n = (lane >> 3) + 8 * j; const LAS float* s = scr + (8 * c) * 33 + n;
        v4u o; o.x = pk2(s[0 * 33], s[1 * 33]); o.y = pk2(s[2 * 33], s[3 * 33]); o.z = pk2(s[4 * 33], s[5 * 33]); o.w = pk2(s[6 * 33], s[7 * 33]);
        *(v4u*)(WT + (size_t)(drow0 + n) * K + k0 + 8 * c) = o; }
    asm volatile("s_waitcnt lgkmcnt(0)" ::: "memory");
}

__device__ __forceinline__ int conv_layer_count(int L) { return (L & 1) ? 9984 : 10496; }
__device__ __forceinline__ int conv_idle(int nwg, int G) { return (nwg % G) ? G - nwg % G : 0; }
__device__ __forceinline__ int conv_idle_phase(int l, int which, int G) {
    if (l > 2) return 0;
    if (which == 0) return conv_idle((TT / 256) * 22, G);
    if (which == 1) return conv_idle((TT / 256) * ((l & 1) ? 8 : 12), G);
    return conv_idle(((l < 2 ? TT : TL) / 256) * 22, G);
}
__device__ __forceinline__ int conv_idle_total(int l, int G) { return conv_idle_phase(l, 0, G) + conv_idle_phase(l, 1, G) + conv_idle_phase(l, 2, G); }
__device__ __forceinline__ void conv_layer_items(const ArgView& a, unsigned char* ws, int L, int first, int last, int w, int W, LAS float* scr, int lane) {
    constexpr int I_GU = 16 * 176, I_DN = 44 * 32, I_AIN = 16 * 96, I_SQ = 16 * 32, I_SIN = 16 * 64;
    const int j = L >> 1;
    for (int it = first + w; it < last; it += W) {
        if (it < 2 * I_GU) { const int mi = 2 * L + it / I_GU, r = it % I_GU, kb = r / 176, nb = r % 176; const int n0 = nb * 32; const int jj = n0 < DFF ? n0 : n0 - DFF; const int half = n0 < DFF ? 0 : 1;
            transpose_item(a.in(I_WGU) + (size_t)mi * DM * 2 * DFF, DM, 2 * DFF, (bf16*)(ws + OFF_WGU) + (size_t)mi * 2 * DFF * DM, kb * 64, n0, 256 * (jj >> 7) + 128 * half + (jj & 127), scr, lane); }
        else if (it < 2 * I_GU + 2 * I_DN) { const int q = it - 2 * I_GU, mi = 2 * L + q / I_DN, r = q % I_DN, kb = r / 32, nb = r % 32;
            transpose_item(a.in(I_WDN) + (size_t)mi * DFF * DM, DFF, DM, (bf16*)(ws + OFF_WDN) + (size_t)mi * DM * DFF, kb * 64, nb * 32, nb * 32, scr, lane); }
        else if ((L & 1) == 0) { const int q = it - 2 * I_GU - 2 * I_DN;
            if (q < I_AIN) { const int kb = q / 96, nb = q % 96;
                transpose_item(a.in(I_DAIN) + (size_t)j * DM * 3 * DM, DM, 3 * DM, (bf16*)(ws + OFF_WINA) + (size_t)j * 3 * DM * DM, kb * 64, nb * 32, nb * 32, scr, lane); }
            else { const int r = q - I_AIN, kb = r / 32, nb = r % 32;
                transpose_item(a.in(I_DAOUT) + (size_t)j * DM * DM, DM, DM, (bf16*)(ws + OFF_WOUTA) + (size_t)j * DM * DM, kb * 64, nb * 32, nb * 32, scr, lane); } }
        else { const int q = it - 2 * I_GU - 2 * I_DN;
            if (q < I_SIN) { const int kb = q / 64, nb = q % 64;
                transpose_item(a.in(I_SGIN) + (size_t)j * DM * 2 * DM, DM, 2 * DM, (bf16*)(ws + OFF_WINS) + (size_t)j * 2 * DM * DM, kb * 64, nb * 32, nb * 32, scr, lane); }
            else { const int r = q - I_SIN, kb = r / 32, nb = r % 32;
                transpose_item(a.in(I_SGOUT) + (size_t)j * DM * DM, DM, DM, (bf16*)(ws + OFF_WOUTS) + (size_t)j * DM * DM, kb * 64, nb * 32, nb * 32, scr, lane); } }
    }
}
__device__ __forceinline__ void prologue(LAS unsigned char* lds, int blk, int G, int tid) {
    const int lane = tid & 63, wave = tid >> 6;
    const ArgView a = get_args();
    unsigned char* ws = a.ws();
    {
        LAS float* sc = (LAS float*)lds; LAS float* red = sc + 9 * DM;
        for (int i = tid; i < 9 * DM; i += 512) { const int b = i >> 10, k = i & 1023; const float v = b < 8 ? a.in(I_C)[b * DM + k] : a.in(I_CCTX)[k]; sc[i] = v / (1.0f + __expf(-v)); }
        __syncthreads();
        float* MOD = (float*)(ws + OFF_MOD);
        LAS float* red4 = sc + 9 * DM;
        for (int it = blk; it < 4 * 36; it += G) {
            const int l = it / 36, n0 = (it % 36) * 256, kp = tid >> 6, ln = tid & 63;
            const float* wp = a.in(I_WMOD) + ((size_t)l * DM + kp * 128) * NMODW + n0 + 4 * ln;
            f32x4 a0 = {0.f, 0.f, 0.f, 0.f}, a1 = a0, a2 = a0, a3 = a0, a4 = a0, a5 = a0, a6 = a0, a7 = a0, a8 = a0;
            const LAS float* sp = sc + kp * 128;
#pragma unroll 2
            for (int kk = 0; kk < 128; kk += 4) {
                const f32x4 w0 = *(const f32x4*)(wp + (size_t)kk * NMODW), w1 = *(const f32x4*)(wp + (size_t)(kk + 1) * NMODW), w2 = *(const f32x4*)(wp + (size_t)(kk + 2) * NMODW), w3 = *(const f32x4*)(wp + (size_t)(kk + 3) * NMODW);
#define MOD_ACC(ab, b) do { const f32x4 s_ = *(const LAS f32x4*)(sp + (b) * DM + kk); ab += w0 * s_[0] + w1 * s_[1] + w2 * s_[2] + w3 * s_[3]; } while (0)
                MOD_ACC(a0, 0); MOD_ACC(a1, 1); MOD_ACC(a2, 2); MOD_ACC(a3, 3); MOD_ACC(a4, 4); MOD_ACC(a5, 5); MOD_ACC(a6, 6); MOD_ACC(a7, 7); MOD_ACC(a8, 8);
#undef MOD_ACC
            }
            LAS f32x4* rp = (LAS f32x4*)(red4 + (size_t)kp * 9 * 256) + ln;
            rp[0] = a0; rp[64] = a1; rp[128] = a2; rp[192] = a3; rp[256] = a4; rp[320] = a5; rp[384] = a6; rp[448] = a7; rp[512] = a8;
            __syncthreads();
            for (int o = tid; o < 9 * 256; o += 512) {
                const int b = o >> 8, cc = o & 255; float s = 0.f;
#pragma unroll
                for (int k8 = 0; k8 < 8; ++k8) s += red4[(k8 * 9 + b) * 256 + cc];
                MOD[(size_t)(l * 9 + b) * NMODW + n0 + cc] = s + a.in(I_BMOD)[l * NMODW + n0 + cc];
            }
            __syncthreads();
        }
    }
#ifdef PROBE_XMASK
    if (tid == 0) { LAS unsigned* pacc_ = (LAS unsigned*)(lds + 131072 + 1024); const unsigned t_ = (unsigned)__builtin_amdgcn_s_memrealtime(); pacc_[10] += t_ - pacc_[16]; pacc_[16] = t_; }
#endif
    if (blk == G - 1) {
        float* rope = (float*)(ws + OFF_ROPE);
        for (int idx = tid; idx < 64 * 16; idx += 512) {
            const int pos = idx >> 4, f = idx & 15;
            const float inv = exp2f(-(float)f * 0.8304820237218406f);
            const float ang = (float)pos * inv;
            const double x = (double)ang; const double kq = rint(x * 0.15915494309189535); const double r = x - kq * 6.283185307179586476925;
            const double r2 = r * r; double ts = r, tc = 1.0, ss = r, cc = 1.0;
            for (int n = 1; n <= 16; ++n) { tc *= -r2 / (double)((2 * n - 1) * (2 * n)); ts *= -r2 / (double)((2 * n) * (2 * n + 1)); cc += tc; ss += ts; }
            rope[pos * 32 + f] = (float)cc; rope[pos * 32 + 16 + f] = (float)ss;
        }
    }
    {
        const int gt = blk * 512 + tid, NT = G * 512;
        bf16* wss = (bf16*)(ws + OFF_WSS);
        for (int i = gt; i < 2 * 8 * 128 * 128; i += NT) wss[i] = f2bf(a.in(I_SGWS)[i]);
    }
    __syncthreads();
    {
        LAS float* scr = (LAS float*)(lds + wave * 16384);
        for (int L = 0; L < 4; ++L)
            if (L == 0 || conv_idle_total(L - 1, G) == 0) {
                if (G > 4 * 36 + 32) { if (blk >= 4 * 36) conv_layer_items(a, ws, L, 0, conv_layer_count(L), (blk - 4 * 36) * 8 + wave, (G - 4 * 36) * 8, scr, lane); }
                else conv_layer_items(a, ws, L, 0, conv_layer_count(L), blk * 8 + wave, G * 8, scr, lane);
            }
    }
#ifdef PROBE_XMASK
    __syncthreads();
    if (tid == 0) { LAS unsigned* pacc_ = (LAS unsigned*)(lds + 131072 + 1024); const unsigned t_ = (unsigned)__builtin_amdgcn_s_memrealtime(); pacc_[11] += t_ - pacc_[16]; pacc_[16] = t_; }
#endif
}

template <bool INIT>
__device__ __forceinline__ void norm_phase(const float* x_lat, const float* x_ctx, bf16* H, bf16* XN, const float* g, const float* modl, int ishift, int iscale, int Mrows, int gw, int NGW, int lane,
                                           const bf16* part, int nsl, const float* pgate, float pcoef) {
    const int rpw = (TL + NGW - 1) / NGW;
    f32x4 gs[4], sh[4]; int curb = -1;
    constexpr int R = 4;
    for (int i0 = 0; i0 < rpw; i0 += R) {
        f32x4 v[R][4]; float ss[R];
#pragma unroll
        for (int q = 0; q < R; ++q) {
            int row = gw * rpw + i0 + q; if (i0 + q >= rpw || row >= TL) row = gw * rpw < TL ? gw * rpw : 0;
#pragma unroll
            for (int j = 0; j < 4; j += 2) { if (INIT) { v[q][j] = *(const f32x4*)(x_lat + (size_t)row * DM + ncol(lane, j)); v[q][j + 1] = *(const f32x4*)(x_lat + (size_t)row * DM + ncol(lane, j + 1)); } else ldh8(H + (size_t)row * DM + ncol(lane, j), v[q][j], v[q][j + 1]); }
        }
#pragma unroll
        for (int q = 0; q < R; ++q) { float s = 0.f;
#pragma unroll
            for (int j = 0; j < 4; ++j) s += (v[q][j][0] * v[q][j][0] + v[q][j][1] * v[q][j][1]) + (v[q][j][2] * v[q][j][2] + v[q][j][3] * v[q][j][3]);
            ss[q] = s; }
#pragma unroll
        for (int o = 1; o < 64; o <<= 1) {
#pragma unroll
            for (int q = 0; q < R; ++q) ss[q] += __shfl_xor(ss[q], o);
        }
#pragma unroll
        for (int q = 0; q < R; ++q) {
            const int row = gw * rpw + i0 + q;
            if (i0 + q < rpw && row < TL) {
                const int b9 = row >> 11;
                if (b9 != curb) { curb = b9; const float* mp = modl + (size_t)b9 * NMODW;
#pragma unroll
                    for (int j = 0; j < 4; ++j) { const int col = ncol(lane, j); gs[j] = *(const f32x4*)(g + col) * (*(const f32x4*)(mp + iscale * DM + col) + 1.0f); sh[j] = *(const f32x4*)(mp + ishift * DM + col); } }
                const float rstd = 1.0f / sqrtf(ss[q] * (1.0f / DM) + 1e-6f);
#pragma unroll
                for (int j = 0; j < 4; j += 2) {
                    const int col = ncol(lane, j);
                    sth8(XN + (size_t)row * DM + col, (v[q][j] * rstd) * gs[j] + sh[j], (v[q][j + 1] * rstd) * gs[j + 1] + sh[j + 1]);
                    if (INIT) sth8(H + (size_t)row * DM + col, v[q][j], v[q][j + 1]);
                }
            }
        }
    }
    for (int row = TL + gw; row < Mrows; row += NGW) {
        f32x4 v[4];
#pragma unroll
        for (int j = 0; j < 4; j += 2) { if (INIT) { v[j] = *(const f32x4*)(x_ctx + (size_t)(row - TL) * DM + ncol(lane, j)); v[j + 1] = *(const f32x4*)(x_ctx + (size_t)(row - TL) * DM + ncol(lane, j + 1)); } else ldh8(H + (size_t)row * DM + ncol(lane, j), v[j], v[j + 1]); }
        if (nsl > 0) {
            const int rr = row - TL, pmc = rr >> 8, r = rr & 255;
#pragma unroll
            for (int j = 0; j < 4; ++j) {
                const int col = ncol(lane, j);
                const bf16* pb = part + ((size_t)(pmc * 4 + (col >> 8)) * nsl) * 65536 + (size_t)r * 256 + (col & 255);
                f32x4 pv[8];
#pragma unroll
                for (int sl = 0; sl < 8; ++sl) pv[sl] = sl < nsl ? ldh4(pb + (size_t)sl * 65536) : (f32x4){0.f, 0.f, 0.f, 0.f};
                const f32x4 sacc = ((pv[0] + pv[1]) + (pv[2] + pv[3])) + ((pv[4] + pv[5]) + (pv[6] + pv[7]));
                v[j] = v[j] + (*(const f32x4*)(pgate + col) * pcoef) * sacc;
                sth4(H + (size_t)row * DM + col, v[j]);
            }
        }
        float s = 0.f;
#pragma unroll
        for (int j = 0; j < 4; ++j) s += (v[j][0] * v[j][0] + v[j][1] * v[j][1]) + (v[j][2] * v[j][2] + v[j][3] * v[j][3]);
        s = wave_sum(s);
        const float rstd = 1.0f / sqrtf(s * (1.0f / DM) + 1e-6f);
        const float* mp = modl + (size_t)8 * NMODW;
#pragma unroll
        for (int j = 0; j < 4; ++j) {
            const int col = ncol(lane, j);
            const f32x4 gg = *(const f32x4*)(g + col), sc = *(const f32x4*)(mp + iscale * DM + col), s4 = *(const f32x4*)(mp + ishift * DM + col);
            const f32x4 y = (v[j] * rstd) * gg * (sc + 1.0f) + s4;
            v2u w; w.x = pk2(y[0], y[1]); w.y = pk2(y[2], y[3]);
            *(v2u*)(XN + (size_t)row * DM + col) = w;
            if (INIT) sth4(H + (size_t)row * DM + col, v[j]);
        }
    }
}
__device__ __forceinline__ void final_norm_phase(const bf16* H, float* out, const float* g, int gw, int NGW, int lane) {
    const int rpw = (TL + NGW - 1) / NGW;
    f32x4 gg[4];
#pragma unroll
    for (int j = 0; j < 4; ++j) gg[j] = *(const f32x4*)(g + ncol(lane, j));
    constexpr int R = 4;
    for (int i0 = 0; i0 < rpw; i0 += R) {
        f32x4 v[R][4]; float ss[R];
#pragma unroll
        for (int q = 0; q < R; ++q) {
            int row = gw * rpw + i0 + q; if (i0 + q >= rpw || row >= TL) row = gw * rpw < TL ? gw * rpw : 0;
#pragma unroll
            for (int j = 0; j < 4; j += 2) ldh8(H + (size_t)row * DM + ncol(lane, j), v[q][j], v[q][j + 1]);
        }
#pragma unroll
        for (int q = 0; q < R; ++q) { float s = 0.f;
#pragma unroll
            for (int j = 0; j < 4; ++j) s += (v[q][j][0] * v[q][j][0] + v[q][j][1] * v[q][j][1]) + (v[q][j][2] * v[q][j][2] + v[q][j][3] * v[q][j][3]);
            ss[q] = s; }
#pragma unroll
        for (int o = 1; o < 64; o <<= 1) {
#pragma unroll
            for (int q = 0; q < R; ++q) ss[q] += __shfl_xor(ss[q], o);
        }
#pragma unroll
        for (int q = 0; q < R; ++q) {
            const int row = gw * rpw + i0 + q;
            if (i0 + q < rpw && row < TL) {
                const float rstd = 1.0f / sqrtf(ss[q] * (1.0f / DM) + 1e-6f);
#pragma unroll
                for (int j = 0; j < 4; ++j) *(f32x4*)(out + (size_t)row * DM + ncol(lane, j)) = (v[q][j] * rstd) * gg[j];
            }
        }
    }
}

constexpr int AT_KB = 64 * 256, AT_VB = 128 * 128, AT_K0 = 0, AT_V0 = 3 * AT_KB;
template <int VAR>
__device__ __forceinline__ void attn_phase(LAS unsigned char* lds, const bf16* Q, const bf16* K, const bf16* Vt, bf16* AO, const float* lam4, const float* subg, float lam_init, bool ctxq, int G, int blk, int tid) {
    const int lane = tid & 63, wave = __builtin_amdgcn_readfirstlane(tid >> 6), rg = wave & 3, r = wave >> 2, q32 = lane & 31, hi = lane >> 5;
    float lamv;
    { float x = 0.f, y = 0.f;
      for (int i = 0; i < 64; ++i) { x += lam4[i] * lam4[64 + i]; y += lam4[128 + i] * lam4[192 + i]; }
      lamv = __expf(x) - __expf(y) + lam_init; }
    const int nunits = 1024 + (ctxq ? 128 : 0);
    const int vcu = (G % 8 == 0) ? (blk % 8) * (G / 8) + blk / 8 : blk;
    for (int uidx = vcu; uidx < nunits; uidx += G) {
        int b, h, qrow0, t0, t1;
        if (uidx < 1024) { b = uidx >> 7; h = (uidx >> 4) & 7; qrow0 = b * SEQ + (uidx & 15) * 128; t0 = 0; t1 = 36; }
        else { const int v = uidx - 1024; b = v >> 4; h = (v >> 1) & 7; qrow0 = TL + b * CTXL + (v & 1) * 128; t0 = 32; t1 = 36; }
        bf16x8 qf[4];
        { const bf16* qp = Q + (size_t)(qrow0 + rg * 32 + q32) * DM + h * 128 + r * 64 + hi * 8;
#pragma unroll
          for (int d0 = 0; d0 < 4; ++d0) qf[d0] = *(const bf16x8*)(qp + d0 * 16);
#pragma unroll
          for (int d0 = 0; d0 < 4; ++d0) asm volatile("" : "+v"(qf[d0])); }
        f32x16 o[4];
#pragma unroll
        for (int db = 0; db < 4; ++db)
#pragma unroll
            for (int i = 0; i < 16; ++i) o[db][i] = 0.f;
        float mrun = 0.f, lrun = 0.f;
        f32x16 negm;
#pragma unroll
        for (int i = 0; i < 16; ++i) negm[i] = 0.f;
        const bf16* kbase = K + h * 128;
        const bf16* vbase = Vt + (size_t)(b * NHEAD + h) * 128 * KVN;
#define AT_ROWB(t) ((t) < 32 ? (size_t)b * SEQ + (size_t)(t) * 64 : (size_t)TL + (size_t)b * CTXL + (size_t)((t) - 32) * 64)
#define AT_DMA(t, kbuf, vbuf) do { const char* kp_ = (const char*)kbase + AT_ROWB(t) * (size_t)(DM * 2); const char* vp_ = (const char*)vbase + (size_t)(t) * 128; \
            _Pragma("unroll") for (int i_ = 0; i_ < 2; ++i_) { \
                const int krow_ = 8 * wave + 4 * i_ + (lane >> 4); \
                __builtin_amdgcn_global_load_lds((const unsigned*)(kp_ + (size_t)krow_ * (DM * 2) + (((lane & 15) ^ (krow_ & 15)) * 16)), (LAS unsigned*)(lds + AT_K0 + (kbuf) * AT_KB + wave * 2048 + i_ * 1024), 16, 0, 0); } \
            _Pragma("unroll") for (int i_ = 0; i_ < 2; ++i_) { \
                const int vrow_ = 16 * wave + 8 * i_ + (lane >> 3); \
                __builtin_amdgcn_global_load_lds((const unsigned*)(vp_ + (size_t)vrow_ * (KVN * 2) + (((lane & 7) ^ ((vrow_ >> 1) & 7)) * 16)), (LAS unsigned*)(lds + AT_V0 + (vbuf) * AT_VB + wave * 2048 + i_ * 1024), 16, 0, 0); } } while (0)
#define AT_SB() __builtin_amdgcn_sched_barrier(0)
        unsigned kfo[4], vfo[4];
#pragma unroll
        for (int i = 0; i < 4; ++i) { kfo[i] = (unsigned)(q32 * 256 + (((r * 8 + 2 * i + hi) ^ (q32 & 15)) * 16)); vfo[i] = (unsigned)(q32 * 128 + (((2 * i + hi) ^ ((q32 >> 1) & 7)) * 16)); }
#define AT_QK(S0, S1, buf) do { const LAS unsigned char* kb_ = lds + AT_K0 + (buf) * AT_KB; bf16x8 kf_[4]; \
            _Pragma("unroll") for (int d_ = 0; d_ < 2; ++d_) { kf_[2 * d_] = *(const LAS bf16x8*)(kb_ + kfo[d_]); kf_[2 * d_ + 1] = *(const LAS bf16x8*)(kb_ + 32 * 256 + kfo[d_]); } \
            AT_SB(); \
            S0 = MFMA32(kf_[0], qf[0], negm); S1 = MFMA32(kf_[1], qf[0], negm); \
            S0 = MFMA32(kf_[2], qf[1], S0); S1 = MFMA32(kf_[3], qf[1], S1); \
            AT_SB(); \
            _Pragma("unroll") for (int d_ = 0; d_ < 2; ++d_) { kf_[2 * d_] = *(const LAS bf16x8*)(kb_ + kfo[d_ + 2]); kf_[2 * d_ + 1] = *(const LAS bf16x8*)(kb_ + 32 * 256 + kfo[d_ + 2]); } \
            AT_SB(); \
            S0 = MFMA32(kf_[0], qf[2], S0); S1 = MFMA32(kf_[1], qf[2], S1); S0 = MFMA32(kf_[2], qf[3], S0); S1 = MFMA32(kf_[3], qf[3], S1); } while (0)
        bf16x8 va[4];
#pragma unroll
        for (int i = 0; i < 4; ++i) va[i] = (bf16x8){0, 0, 0, 0, 0, 0, 0, 0};
#define AT_PV_PRE(VB) do { const LAS unsigned char* vb = lds + AT_V0 + (VB) * AT_VB; \
            _Pragma("unroll") for (int ks = 0; ks < 4; ++ks) va[ks] = *(const LAS bf16x8*)(vb + vfo[ks]); } while (0)
#define AT_PV_RUN(PF, VB) do { const LAS unsigned char* vb = lds + AT_V0 + (VB) * AT_VB; bf16x8 vc[4], ve[4]; \
            _Pragma("unroll") for (int ks = 0; ks < 4; ++ks) vc[ks] = *(const LAS bf16x8*)(vb + 1 * 32 * 128 + vfo[ks]); \
            _Pragma("unroll") for (int ks = 0; ks < 4; ++ks) ve[ks] = *(const LAS bf16x8*)(vb + 2 * 32 * 128 + vfo[ks]); \
            AT_SB(); __builtin_amdgcn_s_setprio(1); \
            _Pragma("unroll") for (int ks = 0; ks < 4; ++ks) o[0] = MFMA32(va[ks], PF[ks], o[0]); \
            AT_SB(); \
            _Pragma("unroll") for (int ks = 0; ks < 4; ++ks) va[ks] = *(const LAS bf16x8*)(vb + 3 * 32 * 128 + vfo[ks]); \
            AT_SB(); \
            _Pragma("unroll") for (int ks = 0; ks < 4; ++ks) o[1] = MFMA32(vc[ks], PF[ks], o[1]); \
            AT_SB(); \
            _Pragma("unroll") for (int ks = 0; ks < 4; ++ks) o[2] = MFMA32(ve[ks], PF[ks], o[2]); \
            AT_SB(); \
            _Pragma("unroll") for (int ks = 0; ks < 4; ++ks) o[3] = MFMA32(va[ks], PF[ks], o[3]); \
            __builtin_amdgcn_s_setprio(0); \
            AT_SB(); } while (0)
#define AT_STEP(C0, C1, t) do { \
            if (!(VAR & 8)) { if ((t) + 2 < t1) AT_DMA((t) + 2, (kc + 2) % 3, (vc4 + 2) & 3); } \
            if (!(VAR & 2)) { if (r == 1 && (t) > t0) AT_PV_PRE((vc4 + 3) & 3); } \
            if (!(VAR & 4)) AT_QK(C0, C1, kc); else { C0 = negm; C1 = negm; }    \
            if (!(VAR & 2)) { if (r == 1 && (t) > t0) AT_PV_RUN(pfp, (vc4 + 3) & 3); if (r == 0) AT_PV_PRE(vc4); } \
            AT_SB(); \
            asm volatile("s_nop 15\n\ts_nop 7" : "+v"(C0), "+v"(C1));     \
            if (!(VAR & 1)) { \
            float rm, rb_; \
            rm = max3f(C0[0], C0[1], C1[0]); rb_ = max3f(C0[2], C0[3], C1[1]); rm = max3f(rm, C1[2], C1[3]); \
            _Pragma("unroll") for (int i = 4; i < 16; i += 4) { rm = max3f(rm, C0[i], C0[i + 1]); rb_ = max3f(rb_, C0[i + 2], C0[i + 3]); rm = max3f(rm, C1[i], C1[i + 1]); rb_ = max3f(rb_, C1[i + 2], C1[i + 3]); } \
            rm = xhalf_max(fmaxf(rm, rb_)); \
            if (__any(rm > 8.0f) || (t) == t0) { const float dl = (t) == t0 ? rm : fmaxf(rm, 0.f), alpha = fast_exp2(-dl); mrun += dl; lrun *= alpha; \
                _Pragma("unroll") for (int i = 0; i < 16; ++i) { C0[i] -= dl; C1[i] -= dl; negm[i] = -mrun; } \
                _Pragma("unroll") for (int db = 0; db < 4; ++db) _Pragma("unroll") for (int i = 0; i < 16; ++i) o[db][i] *= alpha; } \
            f32x2_t ps_ = (f32x2_t){0.f, 0.f}; \
            _Pragma("unroll") for (int i = 0; i < 16; i += 2) { C0[i] = fast_exp2(C0[i]); C0[i + 1] = fast_exp2(C0[i + 1]); C1[i] = fast_exp2(C1[i]); C1[i + 1] = fast_exp2(C1[i + 1]); \
                ps_ += (f32x2_t){C0[i], C0[i + 1]}; ps_ += (f32x2_t){C1[i], C1[i + 1]}; } \
            lrun += ps_[0] + ps_[1]; \
            } \
            { v4u w; \
              w.x = pk2(C0[0], C0[1]); w.y = pk2(C0[2], C0[3]); w.z = pk2(C0[4], C0[5]); w.w = pk2(C0[6], C0[7]); pfp[0] = __builtin_bit_cast(bf16x8, w); \
              w.x = pk2(C0[8], C0[9]); w.y = pk2(C0[10], C0[11]); w.z = pk2(C0[12], C0[13]); w.w = pk2(C0[14], C0[15]); pfp[1] = __builtin_bit_cast(bf16x8, w); \
              w.x = pk2(C1[0], C1[1]); w.y = pk2(C1[2], C1[3]); w.z = pk2(C1[4], C1[5]); w.w = pk2(C1[6], C1[7]); pfp[2] = __builtin_bit_cast(bf16x8, w); \
              w.x = pk2(C1[8], C1[9]); w.y = pk2(C1[10], C1[11]); w.z = pk2(C1[12], C1[13]); w.w = pk2(C1[14], C1[15]); pfp[3] = __builtin_bit_cast(bf16x8, w); } \
            AT_SB(); \
            if (!(VAR & 2)) { if (r == 0) AT_PV_RUN(pfp, vc4); } \
            if (!(VAR & 8) && (t) + 2 < t1) asm volatile("s_waitcnt vmcnt(4) lgkmcnt(0)" ::: "memory"); else asm volatile("s_waitcnt vmcnt(0) lgkmcnt(0)" ::: "memory"); \
            __builtin_amdgcn_s_barrier(); asm volatile("" ::: "memory"); \
            kc = (kc + 1) % 3; vc4 = (vc4 + 1) & 3; } while (0)
        bf16x8 pfp[4];
#pragma unroll
        for (int i = 0; i < 4; ++i) pfp[i] = (bf16x8){0, 0, 0, 0, 0, 0, 0, 0};
        int kc = 0, vc4 = 0;
        AT_DMA(t0, 0, 0); AT_DMA(t0 + 1, 1, 1);
        asm volatile("s_waitcnt vmcnt(4) lgkmcnt(0)" ::: "memory"); __builtin_amdgcn_s_barrier(); asm volatile("" ::: "memory");
        for (int t = t0; t < t1; ++t) {
            f32x16 sa0, sa1;
            AT_STEP(sa0, sa1, t);
        }
        if (!(VAR & 2)) { if (r == 1) { AT_PV_PRE((vc4 + 3) & 3); AT_PV_RUN(pfp, (vc4 + 3) & 3); } }
        __syncthreads();
#undef AT_PV_PRE
#undef AT_PV_RUN
#undef AT_ROWB
#undef AT_DMA
#undef AT_SB
#undef AT_QK
#undef AT_STEP
        lrun = xhalf_sum(lrun);
        const float inv = 1.0f / lrun;
        LAS float* xch = (LAS float*)lds + rg * 4096;
        if (r == 1) {
#pragma unroll
            for (int db = 0; db < 4; ++db)
#pragma unroll
                for (int i = 0; i < 16; ++i) xch[(db * 16 + i) * 64 + lane] = o[db][i] * inv;
        }
        __syncthreads();
        if (r == 0) {
            float ss = 0.f;
#pragma unroll
            for (int db = 0; db < 4; ++db)
#pragma unroll
                for (int i = 0; i < 16; ++i) { const float d = o[db][i] * inv - lamv * xch[(db * 16 + i) * 64 + lane]; o[db][i] = d; ss += d * d; }
            ss = xhalf_sum(ss);
            const float rn = (1.0f / sqrtf(ss * (1.0f / 128.0f) + 1e-6f)) * (1.0f - lam_init);
            bf16* op = AO + (size_t)(qrow0 + rg * 32 + q32) * DM + h * 128;
#pragma unroll
            for (int db = 0; db < 4; ++db)
#pragma unroll
                for (int i4 = 0; i4 < 4; ++i4) {
                    const int dcol = 32 * db + 8 * i4 + 4 * hi;
                    const f32x4 g4 = *(const f32x4*)(subg + dcol);
                    v2u w; w.x = pk2(o[db][4 * i4] * rn * g4[0], o[db][4 * i4 + 1] * rn * g4[1]); w.y = pk2(o[db][4 * i4 + 2] * rn * g4[2], o[db][4 * i4 + 3] * rn * g4[3]);
                    *(v2u*)(op + dcol) = w;
                }
        }
        __syncthreads();
    }
}

__device__ __forceinline__ void sgmix_phase(LAS unsigned char* lds, const bf16* ZU, const bf16* ZVT, const float* stats, const bf16* WS, const float* bs, const float* lng, const float* lnb, bf16* Gout, int nchunks, int G, int blk, int tid) {
    const int lane = tid & 63, wave = __builtin_amdgcn_readfirstlane(tid >> 6), q32 = lane & 31, hi = lane >> 5;
    const int vcu = (G % 8 == 0) ? (blk % 8) * (G / 8) + blk / 8 : blk;
    const int tb = wave >> 1, ch = wave & 1;
    int buf = 0;
    for (int u = vcu; u < nchunks * 8; u += G, buf ^= 1) {
        const int chunk = u >> 3, g = u & 7;
        LAS unsigned char* tile = lds + buf * 34816;
        LAS float* smu = (LAS float*)(lds + 69632 + buf * 1024); LAS float* srs = smu + 128;
        const bf16* wp = WS + ((size_t)g * 128 + tb * 32 + q32) * 128 + hi * 8;
        bf16x8 wf[8];
#pragma unroll
        for (int k = 0; k < 8; ++k) wf[k] = *(const bf16x8*)(wp + k * 16);
        const int t = tb * 32 + q32; const size_t row = (size_t)chunk * 128 + t;
        const float bias = bs[g * 128 + t];
        v2u ug[2][4];
#pragma unroll
        for (int cb = 0; cb < 2; ++cb)
#pragma unroll
            for (int i4 = 0; i4 < 4; ++i4) ug[cb][i4] = *(const v2u*)(ZU + row * DM + g * 128 + ch * 64 + cb * 32 + 8 * i4 + 4 * hi);
        v4u raw[4];
#pragma unroll
        for (int it = 0; it < 4; ++it) { const int idx = it * 512 + tid, c = idx >> 4, s8 = (idx & 15) * 8; raw[it] = *(const v4u*)(ZVT + ((size_t)chunk * DM + g * 128 + c) * 128 + s8); }
        {
            const int r = tid >> 2, part = tid & 3;
            const f32x4* sp = (const f32x4*)(stats + ((size_t)(chunk * 128 + r) * 16 + part * 4) * 2);
            const f32x4 a0 = sp[0], a1 = sp[1];
            float s1 = (a0[0] + a0[2]) + (a1[0] + a1[2]), s2 = (a0[1] + a0[3]) + (a1[1] + a1[3]);
            s1 += __shfl_xor(s1, 1); s2 += __shfl_xor(s2, 1); s1 += __shfl_xor(s1, 2); s2 += __shfl_xor(s2, 2);
            if (part == 0) { const float mu = s1 * (1.0f / DM); const float var = fmaxf(s2 * (1.0f / DM) - mu * mu, 0.f); smu[r] = mu; srs[r] = 1.0f / sqrtf(var + 1e-5f); }
        }
        __syncthreads();
#pragma unroll
        for (int it = 0; it < 4; ++it) {
            const int idx = it * 512 + tid, c = idx >> 4, s8 = (idx & 15) * 8;
            const float gg = lng[g * 128 + c], bb = lnb[g * 128 + c];
            float y[8];
#pragma unroll
            for (int j = 0; j < 4; ++j) { const unsigned wv = raw[it][j];
                y[2 * j] = (bf2f(wv & 0xffffu) - smu[s8 + 2 * j]) * srs[s8 + 2 * j] * gg + bb;
                y[2 * j + 1] = (bf2f(wv >> 16) - smu[s8 + 2 * j + 1]) * srs[s8 + 2 * j + 1] * gg + bb; }
            v4u w; w.x = pk2(y[0], y[1]); w.y = pk2(y[2], y[3]); w.z = pk2(y[4], y[5]); w.w = pk2(y[6], y[7]);
            *(LAS v4u*)(tile + c * 272 + s8 * 2) = w;
        }
        __syncthreads();
        f32x16 acc0, acc1;
#pragma unroll
        for (int i = 0; i < 16; ++i) { acc0[i] = 0.f; acc1[i] = 0.f; }
        const LAS unsigned char* bp = tile + (ch * 64 + q32) * 272 + hi * 16;
#pragma unroll
        for (int k = 0; k < 8; ++k) {
            const bf16x8 b0 = *(const LAS bf16x8*)(bp + k * 32), b1 = *(const LAS bf16x8*)(bp + 32 * 272 + k * 32);
            acc0 = MFMA32(b0, wf[k], acc0); acc1 = MFMA32(b1, wf[k], acc1);
        }
#pragma unroll
        for (int i4 = 0; i4 < 4; ++i4) {
            const int col = g * 128 + ch * 64 + 8 * i4 + 4 * hi;
            const f32x4 u0 = (f32x4){bf2f(ug[0][i4].x & 0xffffu), bf2f(ug[0][i4].x >> 16), bf2f(ug[0][i4].y & 0xffffu), bf2f(ug[0][i4].y >> 16)};
            const f32x4 u1 = (f32x4){bf2f(ug[1][i4].x & 0xffffu), bf2f(ug[1][i4].x >> 16), bf2f(ug[1][i4].y & 0xffffu), bf2f(ug[1][i4].y >> 16)};
            const f32x4 m0 = (f32x4){acc0[4 * i4], acc0[4 * i4 + 1], acc0[4 * i4 + 2], acc0[4 * i4 + 3]}, m1 = (f32x4){acc1[4 * i4], acc1[4 * i4 + 1], acc1[4 * i4 + 2], acc1[4 * i4 + 3]};
            sth4(Gout + row * DM + col, (m0 + bias) * u0);
            sth4(Gout + row * DM + col + 32, (m1 + bias) * u1);
        }
    }
    __syncthreads();
}

#define XB_TMO      128
#define XB_XCNT(j)  (256  + 64 * (j))
#define XB_XSUB(j)  (1280 + 64 * (j))
#define XB_XGEN(j)  (2304 + 64 * (j))
#define XB_TOP      3328
#define XB_TOPGEN   3392
#define XCD_BAR_WORDS 3456
#define XB_SPIN_CAP (1u << 18)

__device__ __forceinline__ unsigned xb_ld(unsigned* p)              { return __hip_atomic_load(p, __ATOMIC_RELAXED, __HIP_MEMORY_SCOPE_AGENT); }
__device__ __forceinline__ unsigned xb_add(unsigned* p, unsigned v) { return __hip_atomic_fetch_add(p, v, __ATOMIC_RELAXED, __HIP_MEMORY_SCOPE_AGENT); }
__device__ __forceinline__ unsigned xb_xcc_id() { return (unsigned)__builtin_amdgcn_s_getreg((3 << 11) | 20) & 0xFu; }
#define XB_SPIN(cond, bar) do { unsigned _sp = 0; while (cond) { __builtin_amdgcn_s_sleep(1); \
    if ((++_sp & 255u) == 0u) { if (xb_ld(&(bar)[XB_TMO])) break; if (_sp > XB_SPIN_CAP) { atomicAdd(&(bar)[XB_TMO], 1u); break; } } } } while (0)

struct XcdBarrier {
    unsigned* bar; unsigned x;
    volatile LAS unsigned* st;
};

__device__ __forceinline__ XcdBarrier xcd_barrier_post(unsigned* bar, volatile LAS unsigned* st) {
    XcdBarrier b; b.bar = bar; b.x = xb_xcc_id(); b.st = st;
    if (threadIdx.x == 0) (void)xb_add(&bar[XB_XCNT(b.x)], 1u);
    return b;
}
__device__ __forceinline__ void xcd_barrier_complete(unsigned* bar, unsigned x, unsigned& nloc, unsigned& nx) {
    const unsigned G = gridDim.x * gridDim.y * gridDim.z;
    unsigned sum, cnt, mine, sp = 0u;
    for (;;) {
        sum = 0u; cnt = 0u; mine = 0u;
#pragma unroll
        for (unsigned j = 0; j < 16; ++j) { const unsigned c = xb_ld(&bar[XB_XCNT(j)]); sum += c; cnt += (c > 0u) ? 1u : 0u; mine = (j == x) ? c : mine; }
        if (sum == G) break;
        __builtin_amdgcn_s_sleep(1);
        if ((++sp & 255u) == 0u) { if (xb_ld(&bar[XB_TMO])) break; if (sp > XB_SPIN_CAP) { atomicAdd(&bar[XB_TMO], 1u); break; } }
    }
    nloc = mine > 0u ? mine : 1u; nx = cnt > 0u ? cnt : 1u;
}

__device__ __forceinline__ void xcd_barrier(const XcdBarrier& b) {
    asm volatile("s_waitcnt vmcnt(0)" ::: "memory");
    __syncthreads();
    if (threadIdx.x == 0) {
        unsigned* bar = b.bar;
        __builtin_amdgcn_s_waitcnt(0);
        unsigned nloc = b.st[0], nx = b.st[1];
        if (nloc == 0u) { xcd_barrier_complete(bar, b.x, nloc, nx); b.st[0] = nloc; b.st[1] = nx; }
        const unsigned old = xb_add(&bar[XB_XSUB(b.x)], 1u);
        const unsigned gen = old / nloc;
        if (old + 1u == (gen + 1u) * nloc) {
            __builtin_amdgcn_fence(__ATOMIC_RELEASE, "agent");
            asm volatile("s_waitcnt vmcnt(0)" ::: "memory");
            const unsigned og = xb_add(&bar[XB_TOP], 1u);
            const unsigned tg = og / nx;
            if (og + 1u == (tg + 1u) * nx) xb_add(&bar[XB_TOPGEN], 1u);
            else XB_SPIN(xb_ld(&bar[XB_TOPGEN]) == tg, bar);
            __builtin_amdgcn_fence(__ATOMIC_ACQUIRE, "agent");
            xb_add(&bar[XB_XGEN(b.x)], 1u);
            asm volatile("s_waitcnt vmcnt(0)" ::: "memory");
        } else {
            XB_SPIN(xb_ld(&bar[XB_XGEN(b.x)]) == gen, bar);
            __builtin_amdgcn_fence(__ATOMIC_ACQUIRE, "agent");
            asm volatile("s_waitcnt vmcnt(0)" ::: "memory");
        }
    }
    __syncthreads();
}

constexpr int LDS_BYTES = 131072 + 2048;
__global__ void __launch_bounds__(512, 2) hybrid_fwd(Args a) {
    extern __shared__ __attribute__((aligned(16))) unsigned char lds_raw[];
    LAS unsigned char* lds = (LAS unsigned char*)lds_raw;
    cg::grid_group grid = cg::this_grid();
    const int G = gridDim.x, blk = blockIdx.x;
    if (threadIdx.x < 4) ((LAS unsigned*)(lds + 131072 + 512))[threadIdx.x] = 0u;
    __syncthreads();
    (void)xcd_barrier_post((unsigned*)(get_args().ws() + OFF_BAR), (volatile LAS unsigned*)(lds + 131072 + 512));
#define GRID_BARRIER() do { XcdBarrier xb_; xb_.bar = (unsigned*)(get_args().ws() + OFF_BAR); xb_.x = (unsigned)__builtin_amdgcn_readfirstlane((int)xb_xcc_id()); xb_.st = (volatile LAS unsigned*)(lds + 131072 + 512); xcd_barrier(xb_); } while (0)

#ifdef PROBE_XMASK
    LAS unsigned* pacc = (LAS unsigned*)(lds + 131072 + 1024);
    if (threadIdx.x == 0) { for (int i = 0; i < 16; ++i) pacc[i] = 0u; const unsigned long long t = __builtin_amdgcn_s_memrealtime(); pacc[16] = (unsigned)t; }
#define PSTAMP(type) do { if (threadIdx.x == 0) { const unsigned t_ = (unsigned)__builtin_amdgcn_s_memrealtime(); pacc[(type)] += t_ - pacc[16]; pacc[16] = t_; } } while (0)
#else
#define PSTAMP(type) do {} while (0)
#endif
#ifndef DIS_PRO
    prologue(lds, blk, G, threadIdx.x);
#endif
    if (G == 0x7fffffff) grid.sync();
    GRID_BARRIER();
    PSTAMP(0);

    for (int ph = 0; ph < 41; ++ph) {
        int tid = threadIdx.x; asm volatile("" : "+v"(tid));
        const int lane = tid & 63, wave = __builtin_amdgcn_readfirstlane(tid >> 6);
        const int gw = blk * 8 + wave, NGW = G * 8;
        const ArgView a = get_args();
        unsigned char* ws = a.ws();
        bf16* H = (bf16*)(ws + OFF_H);
        bf16* XN = (bf16*)(ws + OFF_XN);
        bf16* BIG = (bf16*)(ws + OFF_BIG);
        const float* MOD = (const float*)(ws + OFF_MOD);
        if (ph == 40) { final_norm_phase(H, a.out(), a.in(I_FINALG), gw, NGW, lane);
#ifdef PROBE_XMASK
            GRID_BARRIER(); PSTAMP(9);
            if (blk == 0 && threadIdx.x == 0) {
                unsigned xt = 0, yt = 0;
                for (int i = 0; i < 16; ++i) { if ((PROBE_XMASK >> i) & 1) xt += pacc[i]; if ((PROBE_YMASK >> i) & 1) yt += pacc[i]; }
                const unsigned xus = xt / 100u, yq = (yt / 100u + 16u) / 32u;
                const unsigned long long spin = ((unsigned long long)xus + 2048ull * yq) * 100ull, t0 = __builtin_amdgcn_s_memrealtime();
                while (__builtin_amdgcn_s_memrealtime() - t0 < spin) __builtin_amdgcn_s_sleep(32);
            }
#endif
            break; }
        const int l = ph / 10, s = ph % 10, j = l >> 1;
        const bool attn_layer = (l & 1) == 0;
        const float* modl = MOD + (size_t)l * 9 * NMODW;
        int Mrows = TT; if (l == 3 || (l == 2 && s >= 6)) Mrows = TL;
        if (s == 0 || s == 3 || s == 7) {
            const int k = s == 0 ? 0 : (s == 3 ? 1 : 2);
            const bool init = (ph == 0);
#ifndef DIS_NORM
            int pl = l, pg = 2, pn = 0; float pc = 0.5f;
            if (k == 0) { pl = l - 1; pg = 8; pn = (l == 1 || l == 2) ? 8 : 0; }
            else if (k == 1) { pg = 2; pn = (l <= 2) ? 8 : 0; }
            else { pg = 5; pc = 1.0f; pn = (l <= 1) ? 4 : 0; }
            if (pl < 0) pl = 0;
            if (init) norm_phase<true>(a.in(I_X), a.in(I_CTX), H, XN, a.in(I_NORMG) + (size_t)(l * 3 + k) * DM, modl, 3 * k, 3 * k + 1, Mrows, gw, NGW, lane, (const bf16*)(ws + OFF_PART), 0, MOD, pc);
            else norm_phase<false>(nullptr, nullptr, H, XN, a.in(I_NORMG) + (size_t)(l * 3 + k) * DM, modl, 3 * k, 3 * k + 1, Mrows, gw, NGW, lane,
                       (const bf16*)(ws + OFF_PART), pn, MOD + (size_t)(pl * 9 + 8) * NMODW + pg * DM, pc);
#endif
        } else if (s == 1 || s == 8) {
            const int f = s == 1 ? 0 : 1;
            pg8::Gemm g{XN, (const bf16*)(ws + OFF_WGU) + (size_t)(l * 2 + f) * 2 * DFF * DM, Mrows, 2 * DFF, DM};
            pg8::StaticOrder S; S.init(Mrows, 2 * DFF, G, blk); S.nkt_full = DM / 64;
            EpiSwiGLU E{BIG};
#ifndef DIS_GU
            pg8::gemm_phase<EpiSwiGLU, pg8::StaticOrder, true, true>(lds, g, S, E);
#endif
        } else if (s == 2 || s == 9 || s == 6) {
            const bf16* A; const bf16* Bt; int Kd; int gidx; float coef;
            if (s == 6) { A = XN; Kd = DM; gidx = 5; coef = 1.0f; Bt = attn_layer ? (const bf16*)(ws + OFF_WOUTA) + (size_t)j * DM * DM : (const bf16*)(ws + OFF_WOUTS) + (size_t)j * DM * DM; }
            else { const int f = s == 2 ? 0 : 1; A = BIG; Kd = DFF; gidx = s == 2 ? 2 : 8; coef = 0.5f; Bt = (const bf16*)(ws + OFF_WDN) + (size_t)(l * 2 + f) * DM * DFF; }
            pg8::Gemm g{A, Bt, Mrows, DM, Kd};
            SplitOrder S; S.init(Mrows == TT ? (Kd == DFF ? 8 : 4) : 0, Kd / 64, G, blk);
            EpiResid E{ws, modl + gidx * DM, coef == 0.5f ? 1 : 0};
#ifndef DIS_RES
            pg8::gemm_phase<EpiResid, SplitOrder, true, true>(lds, g, S, E);
#endif
        } else if (s == 4) {
            if (attn_layer) {
                pg8::Gemm g{XN, (const bf16*)(ws + OFF_WINA) + (size_t)j * 3 * DM * DM, Mrows, 3 * DM, DM};
                pg8::StaticOrder S; S.init(Mrows, 3 * DM, G, blk); S.nkt_full = DM / 64;
                EpiQKV E{BIG, (bf16*)((unsigned char*)BIG + SZ_TOK), (bf16*)((unsigned char*)BIG + 2 * SZ_TOK), (const float*)(ws + OFF_ROPE)};
#ifndef DIS_QKV
                pg8::gemm_phase<EpiQKV, pg8::StaticOrder, true, true>(lds, g, S, E);
#endif
            } else {
                pg8::Gemm g{XN, (const bf16*)(ws + OFF_WINS) + (size_t)j * 2 * DM * DM, Mrows, 2 * DM, DM};
                pg8::StaticOrder S; S.init(Mrows, 2 * DM, G, blk); S.nkt_full = DM / 64;
                EpiSG E{BIG, (bf16*)((unsigned char*)BIG + SZ_TOK), (float*)(ws + OFF_SGST2) + (size_t)j * TT * 32};
#ifndef DIS_SG
                pg8::gemm_phase<EpiSG, pg8::StaticOrder, true, true>(lds, g, S, E);
#endif
            }
        } else {
            if (attn_layer) {
                const float lam_init = 0.8f - 0.6f * __expf(-0.3f * (float)l);
#ifndef DIS_ATT
                attn_phase<0>(lds, BIG, (const bf16*)((unsigned char*)BIG + SZ_TOK), (const bf16*)((unsigned char*)BIG + 2 * SZ_TOK), XN, a.in(I_DALAM) + j * 256, a.in(I_DASUB) + j * 128, lam_init, l == 0, G, blk, tid);
#ifdef PROBE_ATT
                if (l == 0) attn_phase<PROBE_ATT>(lds, BIG, (const bf16*)((unsigned char*)BIG + SZ_TOK), (const bf16*)((unsigned char*)BIG + 2 * SZ_TOK), (bf16*)(ws + OFF_PART), a.in(I_DALAM) + j * 256, a.in(I_DASUB) + j * 128, lam_init, false, G, blk, tid);
#endif
#endif
            } else {
#ifndef DIS_MIX
                sgmix_phase(lds, BIG, (const bf16*)((unsigned char*)BIG + SZ_TOK), (const float*)(ws + OFF_SGST2) + (size_t)j * TT * 32, (const bf16*)(ws + OFF_WSS) + (size_t)j * 8 * 128 * 128,
                            a.in(I_SGBS) + j * 8 * 128, a.in(I_SGLNG) + j * DM, a.in(I_SGLNB) + j * DM, XN, Mrows / 128, G, blk, tid);
#endif
            }
        }
        if (l < 3 && (s == 1 || s == 4 || s == 8)) {
            const int which = s == 1 ? 0 : (s == 4 ? 1 : 2);
            const int nid = conv_idle_phase(l, which, G), tot_idle = conv_idle_total(l, G);
            const int nwg = which == 0 ? (TT / 256) * 22 : (which == 1 ? (TT / 256) * (attn_layer ? 12 : 8) : ((l < 2 ? TT : TL) / 256) * 22);
            const int rem = nwg % G;
            if (nid > 0 && blk >= rem) {
                const int L = l + 1, tot = conv_layer_count(L);
                const int before = which == 0 ? 0 : (which == 1 ? conv_idle_phase(l, 0, G) : conv_idle_phase(l, 0, G) + conv_idle_phase(l, 1, G));
                const int first = (int)((long long)tot * before / tot_idle), last = (int)((long long)tot * (before + nid) / tot_idle);
                conv_layer_items(a, ws, L, first, last, (blk - rem) * 8 + wave, nid * 8, (LAS float*)(lds + wave * 16384), lane);
            }
        }
        GRID_BARRIER();
#ifdef PROBE_SYNC3
        GRID_BARRIER(); GRID_BARRIER();
#endif
        PSTAMP(s == 0 || s == 3 || s == 7 ? 1 : (s == 1 || s == 8 ? 2 : (s == 2 || s == 9 ? 3 : (s == 6 ? 4 : (s == 4 ? (attn_layer ? 5 : 6) : (attn_layer ? 7 : 8))))));
    }
}

extern "C" void kernel_launch(void* const* d_in, const int* in_sizes, int n_in, void* d_out, int out_size, void* d_ws, size_t ws_size, hipStream_t stream) {
    static int grid = 0;
    if (grid == 0) {
        if (n_in != 20 || ws_size < WS_NEED || out_size != TL * DM) { fprintf(stderr, "kernel_launch: unexpected problem (n_in %d, ws %zu, out %d)\n", n_in, ws_size, out_size); grid = -1; return; }
        int dev = 0, cus = 0, per_cu = 0;
        if (hipGetDevice(&dev) != hipSuccess || hipDeviceGetAttribute(&cus, hipDeviceAttributeMultiprocessorCount, dev) != hipSuccess) { grid = -1; return; }
        if (hipFuncSetAttribute((const void*)hybrid_fwd, hipFuncAttributeMaxDynamicSharedMemorySize, LDS_BYTES) != hipSuccess) { fprintf(stderr, "kernel_launch: hipFuncSetAttribute failed\n"); grid = -1; return; }
        if (hipOccupancyMaxActiveBlocksPerMultiprocessor(&per_cu, (const void*)hybrid_fwd, 512, LDS_BYTES) != hipSuccess || per_cu < 1) { fprintf(stderr, "kernel_launch: occupancy query says %d\n", per_cu); per_cu = 1; }
        (void)hipGetLastError();
        grid = cus;
    }
    if (grid < 0) return;
    if (hipMemsetAsync((char*)d_ws + OFF_BAR, 0, 16384, stream) != hipSuccess) { fprintf(stderr, "kernel_launch: memset failed\n"); return; }
    Args a{};
    for (int i = 0; i < 20; ++i) a.in_[i] = (GAS const float*)d_in[i];
    a.out_ = (GAS float*)d_out; a.ws_ = (GAS unsigned char*)d_ws;
    void* params[] = {&a};
    hipError_t e = hipLaunchCooperativeKernel((const void*)hybrid_fwd, dim3(grid), dim3(512), params, LDS_BYTES, stream);
    if (e != hipSuccess) fprintf(stderr, "kernel_launch: cooperative launch failed: %s (grid %d)\n", hipGetErrorString(e), grid);
}
```

```cpp
#include <hip/hip_runtime.h>
#include <hip/hip_cooperative_groups.h>
#include <cstdio>
#include <cstdint>
namespace cg = cooperative_groups;
namespace pg8 {
#define PG8_LAS __attribute__((address_space(3)))
typedef unsigned short bf16_t;
typedef short bf16x8 __attribute__((ext_vector_type(8)));
typedef float f32x4 __attribute__((ext_vector_type(4)));
typedef unsigned u32x4 __attribute__((ext_vector_type(4)));
constexpr int BM = 256, BK = 64, HALF = 128, HTB = HALF * BK * 2  , STAGE_BYTES = 8 * HTB, NXCD = 8, WGM = 8;

__host__ __device__ __forceinline__ int lds_byte(int r, int c) { const int st = (r >> 4) * 2 + (c >> 5), rr = r & 15, cc = c & 31, ob = rr * 64 + cc * 2; return st * 1024 + (ob ^ (((ob >> 9) & 1) << 5)); }
__host__ __device__ __forceinline__ void stage_rc(int b, int& R, int& C) { const int st = b / 1024, sb = b % 1024, swz = sb ^ (((sb >> 9) & 1) << 5); R = (st >> 1) * 16 + swz / 64; C = (st & 1) * 32 + (swz % 64) / 2; }
__host__ __device__ __forceinline__ int perm32(int rho) { const int n = rho >> 4, i = rho & 15; return 8 * (i >> 2) + 4 * n + (i & 3); }

struct Unit { int pm, pn, kt0, nkt, part; };
struct Gemm { const bf16_t* A; const bf16_t* Bt; int M, N, K; };

struct StaticOrder {
    int nM, nN, nwg, G, c, nkt_full;
    __host__ __device__ void init(int M, int N, int G_, int c_) { nM = M / BM; nN = N / BM; nwg = nM * nN; G = G_; c = c_; }
    __host__ __device__ bool next(int i, Unit& u) const {
        const long L = (long)i * G + c; if (L >= nwg) return false;
        int wgid = (int)L; { const int q = nwg / NXCD, r = nwg % NXCD, xcd = wgid % NXCD, off = wgid / NXCD; wgid = (xcd < r ? xcd * (q + 1) : r * (q + 1) + (xcd - r) * q) + off; }
        const int nig = WGM * nN, gid = wgid / nig, fm = gid * WGM, gsz = (nM - fm) < WGM ? (nM - fm) : WGM;
        u.pm = fm + ((wgid % nig) % gsz); u.pn = (wgid % nig) / gsz; u.kt0 = 0; u.nkt = nkt_full; u.part = -1; return true;
    }
    __device__ __forceinline__ void a_ready(const Unit&) const {}
    __device__ __forceinline__ void done(const Unit&) const {}
};
__device__ __forceinline__ unsigned cvt_pk_bf16(float lo, float hi) { unsigned r; asm volatile("v_cvt_pk_bf16_f32 %0, %1, %2" : "=v"(r) : "v"(lo), "v"(hi)); return r; }
typedef float f32x2 __attribute__((ext_vector_type(2)));
template <class Epi, class Sched, bool ALIGN_EPI = false, bool SP2 = false>
__device__ __forceinline__ void gemm_phase(PG8_LAS unsigned char* lds, const Gemm g, const Sched& S, const Epi& E) {
    int tid_ = threadIdx.x; asm volatile("" : "+v"(tid_)); const int tid = tid_, wid = __builtin_amdgcn_readfirstlane(tid >> 6), lane = tid & 63, wr = wid >> 2, wc = wid & 3, fr = lane & 15, fq = lane >> 4;
    const int K = g.K;
    unsigned voffA[2], voffB[2];
#pragma unroll
    for (int i = 0; i < 2; ++i) { int R, C; stage_rc(tid * 16 + i * 8192, R, C); const int Rb = Epi::PERM ? ((R & ~31) + perm32(R & 31)) : R;
        voffA[i] = (unsigned)(R * K + C) * 2u; voffB[i] = (unsigned)(Rb * K + C) * 2u; }
    const size_t kstep = (size_t)(BK * 2);
    const size_t hstep = (size_t)HALF * K * 2;
    const size_t tstep = 2 * hstep;
    const unsigned ldsw = (unsigned)wid * 1024u;
    const int aoff = lds_byte(wr * 64 + fr, fq * 8), boff = lds_byte(wc * 32 + fr, fq * 8);
#define PG8_SA(b, h) (((b) * 2 + (h)) * HTB)
#define PG8_SB(b, h) ((4 + (b) * 2 + (h)) * HTB)
#define PG8_STAGE(bufoff, gbase, voff) do { _Pragma("unroll") for (int _i = 0; _i < 2; ++_i) \
        __builtin_amdgcn_global_load_lds((const unsigned*)((const char*)(gbase) + (voff)[_i]), (PG8_LAS unsigned*)(lds + (bufoff) + ldsw + _i * 8192), 16, 0, 0); } while (0)
#define PG8_LDA(dst, b, h) do { _Pragma("unroll") for (int m = 0; m < 4; ++m) _Pragma("unroll") for (int k = 0; k < 2; ++k) dst[m][k] = *(const PG8_LAS bf16x8*)(lds + PG8_SA(b, h) + aoff + m * 2048 + k * 1024); } while (0)
#define PG8_LDB(dst, b, h) do { _Pragma("unroll") for (int n = 0; n < 2; ++n) _Pragma("unroll") for (int k = 0; k < 2; ++k) dst[n][k] = *(const PG8_LAS bf16x8*)(lds + PG8_SB(b, h) + boff + n * 2048 + k * 1024); } while (0)
#define PG8_MMA(ai, bj, At, Bt) do { __builtin_amdgcn_s_setprio(1); _Pragma("unroll") for (int m = 0; m < 4; ++m) _Pragma("unroll") for (int n = 0; n < 2; ++n) _Pragma("unroll") for (int k = 0; k < 2; ++k) \
        acc[ai][bj][m][n] = __builtin_amdgcn_mfma_f32_16x16x32_bf16(Bt[n][k], At[m][k], acc[ai][bj][m][n], 0, 0, 0); __builtin_amdgcn_s_setprio(0); } while (0)
#define PG8_WAIT_V(n) asm volatile("s_waitcnt vmcnt(" #n ")" ::: "memory")
#define PG8_WAIT_L(n) asm volatile("s_waitcnt lgkmcnt(" #n ")" ::: "memory")
#define PG8_BAR __builtin_amdgcn_s_barrier()
#define PG8_SCHED __builtin_amdgcn_sched_barrier(0)
    Unit cur, nxt; int ui = 0;
    if (!S.next(0, cur)) return;
    f32x4 acc[2][2][4][2];
#pragma unroll
    for (int a = 0; a < 2; ++a)
#pragma unroll
        for (int b = 0; b < 2; ++b)
#pragma unroll
            for (int m = 0; m < 4; ++m)
#pragma unroll
                for (int n = 0; n < 2; ++n) acc[a][b][m][n] = (f32x4){0.f, 0.f, 0.f, 0.f};
    bf16x8 At[4][2], B0[2][2], B1[2][2];
    const char* cA = (const char*)g.A + (size_t)cur.pm * tstep + (size_t)cur.kt0 * (BK * 2); const char* cB = (const char*)g.Bt + (size_t)cur.pn * tstep + (size_t)cur.kt0 * (BK * 2);
    S.a_ready(cur);
    if constexpr (SP2) {
        PG8_STAGE(PG8_SB(0, 0), cB, voffB); PG8_STAGE(PG8_SB(0, 1), cB + hstep, voffB); PG8_STAGE(PG8_SA(0, 0), cA, voffA); PG8_STAGE(PG8_SA(0, 1), cA + hstep, voffA);
        if (wr == 1) PG8_BAR;
        PG8_WAIT_V(2); PG8_BAR;
        PG8_STAGE(PG8_SB(1, 0), cB + kstep, voffB); PG8_STAGE(PG8_SA(1, 0), cA + kstep, voffA); PG8_STAGE(PG8_SB(1, 1), cB + hstep + kstep, voffB);
        PG8_WAIT_V(6); PG8_BAR;
    } else {
        PG8_STAGE(PG8_SB(0, 0), cB, voffB); PG8_STAGE(PG8_SA(0, 0), cA, voffA); PG8_STAGE(PG8_SB(0, 1), cB + hstep, voffB); PG8_STAGE(PG8_SA(0, 1), cA + hstep, voffA);
        if (wr == 1) PG8_BAR;
        PG8_WAIT_V(4); PG8_BAR;
        PG8_STAGE(PG8_SB(1, 0), cB + kstep, voffB); PG8_STAGE(PG8_SA(1, 0), cA + kstep, voffA); PG8_STAGE(PG8_SB(1, 1), cB + hstep + kstep, voffB);
        PG8_WAIT_V(6); PG8_BAR;
    }
    for (;;) {
        const bool has_next = S.next(ui + 1, nxt);
        const char* nA = has_next ? (const char*)g.A + (size_t)nxt.pm * tstep + (size_t)nxt.kt0 * (BK * 2) : cA; const char* nB = has_next ? (const char*)g.Bt + (size_t)nxt.pn * tstep + (size_t)nxt.kt0 * (BK * 2) : cB;
        const int nt = cur.nkt;
        for (int t = 0; t < nt; t += 2) {
            const bool last = (t == nt - 2);
            const char* a1 = cA + (size_t)(t + 1) * kstep;
            const char* a2 = last ? nA : cA + (size_t)(t + 2) * kstep; const char* b2 = last ? nB : cB + (size_t)(t + 2) * kstep;
            const char* a3 = a2 + kstep; const char* b3 = b2 + kstep;
            if (last && has_next) S.a_ready(nxt);
            if constexpr (SP2) {
            PG8_LDB(B0, 0, 0); PG8_LDB(B1, 0, 1); PG8_SCHED; PG8_LDA(At, 0, 0); PG8_STAGE(PG8_SA(1, 1), a1 + hstep, voffA);
            PG8_WAIT_V(8); PG8_WAIT_L(0); PG8_BAR; PG8_MMA(0, 0, At, B0); PG8_MMA(0, 1, At, B1); PG8_BAR; PG8_SCHED;
            PG8_LDA(At, 0, 1); PG8_STAGE(PG8_SB(0, 0), b2, voffB); PG8_STAGE(PG8_SB(0, 1), b2 + hstep, voffB); PG8_STAGE(PG8_SA(0, 0), a2, voffA);
            PG8_WAIT_V(8); PG8_WAIT_L(0); PG8_BAR; PG8_MMA(1, 0, At, B0); PG8_MMA(1, 1, At, B1); PG8_BAR; PG8_SCHED;
            PG8_LDB(B0, 1, 0); PG8_LDB(B1, 1, 1); PG8_SCHED; PG8_LDA(At, 1, 0); PG8_STAGE(PG8_SA(0, 1), a2 + hstep, voffA);
            PG8_WAIT_V(8); PG8_WAIT_L(0); PG8_BAR; PG8_MMA(0, 0, At, B0); PG8_MMA(0, 1, At, B1); PG8_BAR; PG8_SCHED;
            PG8_LDA(At, 1, 1); PG8_STAGE(PG8_SB(1, 0), b3, voffB); PG8_STAGE(PG8_SB(1, 1), b3 + hstep, voffB); PG8_STAGE(PG8_SA(1, 0), a3, voffA);
            PG8_WAIT_V(8); PG8_WAIT_L(0); PG8_BAR; PG8_MMA(1, 0, At, B0); PG8_MMA(1, 1, At, B1); PG8_BAR; PG8_SCHED;
            } else {
            PG8_LDB(B0, 0, 0); PG8_SCHED; PG8_LDA(At, 0, 0); PG8_STAGE(PG8_SA(1, 1), a1 + hstep, voffA);
            PG8_WAIT_L(8); PG8_BAR; PG8_WAIT_L(0); PG8_MMA(0, 0, At, B0); PG8_BAR; PG8_SCHED;
            PG8_LDB(B1, 0, 1); PG8_STAGE(PG8_SB(0, 0), b2, voffB);
            PG8_BAR; PG8_WAIT_L(0); PG8_MMA(0, 1, At, B1); PG8_BAR;
            PG8_LDA(At, 0, 1); PG8_STAGE(PG8_SA(0, 0), a2, voffA);
            PG8_BAR; PG8_WAIT_L(0); PG8_MMA(1, 0, At, B0); PG8_BAR; PG8_SCHED;
            PG8_STAGE(PG8_SB(0, 1), b2 + hstep, voffB);
            PG8_WAIT_V(6); PG8_BAR; PG8_MMA(1, 1, At, B1); PG8_BAR;
            PG8_LDB(B0, 1, 0); PG8_SCHED; PG8_LDA(At, 1, 0); PG8_STAGE(PG8_SA(0, 1), a2 + hstep, voffA);
            PG8_WAIT_L(8); PG8_BAR; PG8_WAIT_L(0); PG8_MMA(0, 0, At, B0); PG8_BAR; PG8_SCHED;
            PG8_LDB(B1, 1, 1); PG8_STAGE(PG8_SB(1, 0), b3, voffB);
            PG8_BAR; PG8_WAIT_L(0); PG8_MMA(0, 1, At, B1); PG8_BAR;
            PG8_LDA(At, 1, 1); PG8_STAGE(PG8_SA(1, 0), a3, voffA);
            PG8_BAR; PG8_WAIT_L(0); PG8_MMA(1, 0, At, B0); PG8_BAR; PG8_SCHED;
            PG8_STAGE(PG8_SB(1, 1), b3 + hstep, voffB);
            PG8_WAIT_V(6); PG8_BAR; PG8_MMA(1, 1, At, B1); PG8_BAR;
            }
        }
        if constexpr (ALIGN_EPI) { if (wr == 0) PG8_BAR; }
        if constexpr (!Epi::AFTER_DRAIN) { E(acc, cur, wr, wc, fr, fq); S.done(cur); }
        if (!has_next) break;
#pragma unroll
        for (int a = 0; a < 2; ++a)
#pragma unroll
            for (int b = 0; b < 2; ++b)
#pragma unroll
                for (int m = 0; m < 4; ++m)
#pragma unroll
                    for (int n = 0; n < 2; ++n) acc[a][b][m][n] = (f32x4){0.f, 0.f, 0.f, 0.f};
        cur = nxt; cA = nA; cB = nB; ++ui;
        if constexpr (ALIGN_EPI) { if (wr == 1) PG8_BAR; }
    }
    PG8_WAIT_V(0);
    if constexpr (!ALIGN_EPI) { if (wr == 0) PG8_BAR; }
    PG8_BAR;
    if constexpr (Epi::AFTER_DRAIN) { E.fused(acc, cur, wr, wc, fr, fq, lds, wid, lane); S.done(cur); }
#undef PG8_SA
#undef PG8_SB
#undef PG8_STAGE
#undef PG8_LDA
#undef PG8_LDB
#undef PG8_MMA
#undef PG8_WAIT_V
#undef PG8_WAIT_L
#undef PG8_BAR
#undef PG8_SCHED
}
}

constexpr int DM = 1024, NBATCH = 8, SEQ = 2048, CTXL = 256, DFF = 2816, NHEAD = 8;
constexpr int TL = NBATCH * SEQ;
constexpr int TC = NBATCH * CTXL;
constexpr int TT = TL + TC;
constexpr int KVN = SEQ + CTXL;
constexpr int NMODW = 9 * DM;
constexpr float C2 = 0.125f * 1.4426950408889634f;

constexpr size_t MiB = (size_t)1 << 20;
constexpr size_t OFF_MOD = 0;
constexpr size_t OFF_ROPE = 1536 * 1024;
constexpr size_t OFF_BAR = 1792 * 1024;
constexpr size_t OFF_WSS = 3 * MiB;
constexpr size_t OFF_WGU = 4 * MiB;
constexpr size_t OFF_WDN = OFF_WGU + 88 * MiB;
constexpr size_t OFF_WINA = OFF_WDN + 44 * MiB;
constexpr size_t OFF_WOUTA = OFF_WINA + 12 * MiB;
constexpr size_t OFF_WINS = OFF_WOUTA + 4 * MiB;
constexpr size_t OFF_WOUTS = OFF_WINS + 8 * MiB;
constexpr size_t OFF_H = OFF_WOUTS + 4 * MiB;
constexpr size_t OFF_XN = OFF_H + 72 * MiB;
constexpr size_t OFF_BIG = OFF_XN + 36 * MiB;
constexpr size_t OFF_PART = OFF_BIG + 108 * MiB;
constexpr size_t OFF_SGST2 = OFF_PART + 64 * MiB;
constexpr size_t WS_NEED = OFF_SGST2 + 6 * MiB;
constexpr size_t SZ_TOK = (size_t)TT * DM * 2;

#define LAS __attribute__((address_space(3)))
typedef unsigned short bf16;
typedef unsigned v4u __attribute__((ext_vector_type(4)));
typedef unsigned v2u __attribute__((ext_vector_type(2)));
typedef float f32x4 __attribute__((ext_vector_type(4)));
typedef float f32x16 __attribute__((ext_vector_type(16)));
typedef short bf16x8 __attribute__((ext_vector_type(8)));
typedef float f32x2_t __attribute__((ext_vector_type(2)));
typedef __bf16 bf16x2_t __attribute__((ext_vector_type(2)));

__device__ __forceinline__ unsigned pk2(float lo, float hi) { f32x2_t v = {lo, hi}; bf16x2_t b = __builtin_convertvector(v, bf16x2_t); return __builtin_bit_cast(unsigned, b); }
__device__ __forceinline__ bf16 f2bf(float f) { return (bf16)(pk2(f, 0.f) & 0xffffu); }
__device__ __forceinline__ float bf2f(unsigned b) { return __uint_as_float(b << 16); }
__device__ __forceinline__ f32x4 ldh4(const bf16* p) { const v2u r = *(const v2u*)p; return (f32x4){bf2f(r.x & 0xffffu), bf2f(r.x >> 16), bf2f(r.y & 0xffffu), bf2f(r.y >> 16)}; }
__device__ __forceinline__ void sth4(bf16* p, f32x4 v) { v2u w; w.x = pk2(v[0], v[1]); w.y = pk2(v[2], v[3]); *(v2u*)p = w; }
__device__ __forceinline__ float wave_sum(float v) {
#pragma unroll
    for (int o = 1; o < 64; o <<= 1) v += __shfl_xor(v, o);
    return v;
}
__device__ __forceinline__ float xhalf_max(float m) { auto rr = __builtin_amdgcn_permlane32_swap(__float_as_uint(m), __float_as_uint(m), false, false); return fmaxf(__uint_as_float(rr[0]), __uint_as_float(rr[1])); }
__device__ __forceinline__ float xhalf_sum(float m) { auto rr = __builtin_amdgcn_permlane32_swap(__float_as_uint(m), __float_as_uint(m), false, false); return __uint_as_float(rr[0]) + __uint_as_float(rr[1]); }
__device__ __forceinline__ float max3f(float a, float b, float c) { float r; asm("v_max3_f32 %0, %1, %2, %3" : "=v"(r) : "v"(a), "v"(b), "v"(c)); return r; }
__device__ __forceinline__ float fast_exp2(float x) { return __builtin_amdgcn_exp2f(x); }
__device__ __forceinline__ float fast_rcp(float x) { return __builtin_amdgcn_rcpf(x); }
__device__ __forceinline__ float silu_f(float a) { return a * fast_rcp(1.0f + fast_exp2(-1.4426950408889634f * a)); }
__device__ __forceinline__ float gelu_tanh_f(float x) { const float u = x + 0.044715f * x * x * x; return x * fast_rcp(1.0f + fast_exp2(-2.302208198f * u)); }
__device__ __forceinline__ int crow(int i, int h) { return (i & 3) + 8 * (i >> 2) + 4 * h; }
#define MFMA32(a, b, c) __builtin_amdgcn_mfma_f32_32x32x16_bf16((a), (b), (c), 0, 0, 0)

using pg8::Unit;
struct SplitOrder {
    pg8::StaticOrder lat; int G, c, nsl, nkt;
    __device__ __forceinline__ void init(int nsl_, int nkt_, int G_, int c_) { lat.init(TL, DM, G_, c_); lat.nkt_full = nkt_; G = G_; c = c_; nsl = nsl_; nkt = nkt_; }
    __device__ __forceinline__ bool next(int i, Unit& u) const {
        const int nrl = (256 + G - 1) / G;
        if (i < nrl) { if (lat.next(i, u)) return true; }
        const int q = (i - nrl) * G + c;
        if (i < nrl || q >= 32 * nsl) return false;
        const int tctx = q / nsl, sl = q % nsl, pairs = nkt >> 1, base = pairs / nsl, rem = pairs % nsl;
        u.pm = 64 + (tctx >> 2); u.pn = tctx & 3; u.kt0 = 2 * (sl * base + (sl < rem ? sl : rem)); u.nkt = 2 * (base + (sl < rem ? 1 : 0)); u.part = q; return true;
    }
    __device__ __forceinline__ void a_ready(const Unit&) const {}
    __device__ __forceinline__ void done(const Unit&) const {}
};
struct EpiSwiGLU {
    static constexpr bool PERM = true, AFTER_DRAIN = false;
    bf16* O;
    __device__ __forceinline__ void operator()(const f32x4 (&acc)[2][2][4][2], const Unit& u, int wr, int wc, int fr, int fq) const {
        const int row0 = u.pm * 256 + wr * 64 + fr, col0 = u.pn * 128 + wc * 32 + 8 * fq;
#pragma unroll
        for (int ai = 0; ai < 2; ++ai)
#pragma unroll
            for (int m = 0; m < 4; ++m) {
                bf16* p = O + (size_t)(row0 + ai * 128 + m * 16) * DFF + col0;
                const f32x4 a0 = acc[ai][0][m][0], a1 = acc[ai][0][m][1], u0 = acc[ai][1][m][0], u1 = acc[ai][1][m][1];
                v4u w;
                w.x = pk2(silu_f(a0[0]) * u0[0], silu_f(a0[1]) * u0[1]); w.y = pk2(silu_f(a0[2]) * u0[2], silu_f(a0[3]) * u0[3]);
                w.z = pk2(silu_f(a1[0]) * u1[0], silu_f(a1[1]) * u1[1]); w.w = pk2(silu_f(a1[2]) * u1[2], silu_f(a1[3]) * u1[3]);
                *(v4u*)p = w;
            }
    }
};
struct EpiResid {
    static constexpr bool PERM = true, AFTER_DRAIN = false;
    unsigned char* ws; const float* gate; int half;
    __device__ __forceinline__ void operator()(const f32x4 (&acc)[2][2][4][2], const Unit& u, int wr, int wc, int fr, int fq) const {
        bf16* H = (bf16*)(ws + OFF_H); bf16* part = (bf16*)(ws + OFF_PART); const float coef = half ? 0.5f : 1.0f;
        if (u.part >= 0) {
            bf16* pp = part + (size_t)u.part * 65536 + (size_t)(wr * 64 + fr) * 256 + wc * 32 + 8 * fq;
#pragma unroll
            for (int ai = 0; ai < 2; ++ai)
#pragma unroll
                for (int m = 0; m < 4; ++m)
#pragma unroll
                    for (int bj = 0; bj < 2; ++bj) {
                        const f32x4 x0 = acc[ai][bj][m][0], x1 = acc[ai][bj][m][1];
                        v4u w; w.x = pk2(x0[0], x0[1]); w.y = pk2(x0[2], x0[3]); w.z = pk2(x1[0], x1[1]); w.w = pk2(x1[2], x1[3]);
                        *(v4u*)(pp + (size_t)(ai * 128 + m * 16) * 256 + bj * 128) = w;
                    }
            return;
        }
        const int b9 = u.pm < 64 ? (u.pm >> 3) : 8;
        const float* gp = gate + (size_t)b9 * NMODW;
        const int row0 = u.pm * 256 + wr * 64 + fr;
#pragma unroll
        for (int bj = 0; bj < 2; ++bj) {
            const int col = u.pn * 256 + bj * 128 + wc * 32 + 8 * fq;
            const f32x4 gv0 = *(const f32x4*)(gp + col) * coef, gv1 = *(const f32x4*)(gp + col + 4) * coef;
            v4u h[2][4];
#pragma unroll
            for (int ai = 0; ai < 2; ++ai)
#pragma unroll
                for (int m = 0; m < 4; ++m) h[ai][m] = *(const v4u*)(H + (size_t)(row0 + ai * 128 + m * 16) * DM + col);
#pragma unroll
            for (int ai = 0; ai < 2; ++ai)
#pragma unroll
                for (int m = 0; m < 4; ++m) {
                    const v4u r = h[ai][m];
                    const f32x4 h0 = (f32x4){bf2f(r.x & 0xffffu), bf2f(r.x >> 16), bf2f(r.y & 0xffffu), bf2f(r.y >> 16)};
                    const f32x4 h1 = (f32x4){bf2f(r.z & 0xffffu), bf2f(r.z >> 16), bf2f(r.w & 0xffffu), bf2f(r.w >> 16)};
                    const f32x4 y0 = h0 + gv0 * acc[ai][bj][m][0], y1 = h1 + gv1 * acc[ai][bj][m][1];
                    v4u w; w.x = pk2(y0[0], y0[1]); w.y = pk2(y0[2], y0[3]); w.z = pk2(y1[0], y1[1]); w.w = pk2(y1[2], y1[3]);
                    *(v4u*)(H + (size_t)(row0 + ai * 128 + m * 16) * DM + col) = w;
                }
        }
    }
};
constexpr int XP_OFF = 131072 + 2048, XP_WAVE = 16 * 144;
__device__ __forceinline__ void xpose_write(LAS unsigned char* xl, const f32x4& v, int m, int rpos, int fq) {
#pragma unroll
    for (int i = 0; i < 4; ++i) *(LAS bf16*)(xl + (4 * fq + i) * 144 + (16 * m + rpos) * 2) = f2bf(v[i]);
}
__device__ __forceinline__ void xpose_flush(LAS unsigned char* xl, int lane, bf16* gbase, size_t colstride) {
    asm volatile("s_waitcnt lgkmcnt(0)" ::: "memory");
    const int c = lane >> 2, q = lane & 3;
    const v4u a = *(const LAS v4u*)(xl + c * 144 + q * 32), b = *(const LAS v4u*)(xl + c * 144 + q * 32 + 16);
    asm volatile("s_waitcnt lgkmcnt(0)" ::: "memory");
    bf16* p = gbase + (size_t)c * colstride + 16 * q;
    *(v4u*)p = a; *(v4u*)(p + 8) = b;
}
struct EpiQKV {
    static constexpr bool PERM = false, AFTER_DRAIN = false;
    bf16* Q; bf16* K; bf16* Vt; const float* rope; LAS unsigned char* xp;
    __device__ __forceinline__ void operator()(const f32x4 (&acc)[2][2][4][2], const Unit& u, int wr, int wc, int fr, int fq) const {
        const int sect = u.pn >> 2, ct = (u.pn & 3) * 256;
        const bool latent = u.pm < 64;
        if (sect < 2) {
            bf16* base = sect == 0 ? Q : K; const float sc = sect == 0 ? C2 : 1.0f;
            const int axis = wc & 1;
            f32x4 csv[2][4], snv[2][4];
#pragma unroll
            for (int ai = 0; ai < 2; ++ai)
#pragma unroll
                for (int m = 0; m < 4; ++m) {
                    const int row = u.pm * 256 + ai * 128 + wr * 64 + m * 16 + fr;
                    csv[ai][m] = (f32x4){1.f, 1.f, 1.f, 1.f}; snv[ai][m] = (f32x4){0.f, 0.f, 0.f, 0.f};
                    if (latent) { const int s = row & 2047; const int pos = axis ? (s & 63) : (s >> 6); csv[ai][m] = *(const f32x4*)(rope + pos * 32 + 4 * fq); snv[ai][m] = *(const f32x4*)(rope + pos * 32 + 16 + 4 * fq); }
                }
#pragma unroll
            for (int ai = 0; ai < 2; ++ai)
#pragma unroll
                for (int m = 0; m < 4; ++m) {
                    const int row = u.pm * 256 + ai * 128 + wr * 64 + m * 16 + fr;
                    const f32x4 cs = csv[ai][m], sn = snv[ai][m];
#pragma unroll
                    for (int bj = 0; bj < 2; ++bj) {
                        const f32x4 x1 = acc[ai][bj][m][0], x2 = acc[ai][bj][m][1];
                        const f32x4 o1 = (x1 * cs - x2 * sn) * sc, o2 = (x2 * cs + x1 * sn) * sc;
                        bf16* p = base + (size_t)row * DM + ct + bj * 128 + wc * 32 + 4 * fq;
                        v2u w1, w2; w1.x = pk2(o1[0], o1[1]); w1.y = pk2(o1[2], o1[3]); w2.x = pk2(o2[0], o2[1]); w2.y = pk2(o2[2], o2[3]);
                        *(v2u*)p = w1; *(v2u*)(p + 16) = w2;
                    }
                }
        } else {
            const int swz = (fr & 3) | ((fr & 4) << 1) | ((fr & 8) >> 1);
            const int lane = fq * 16 + fr;
            LAS unsigned char* xl = xp + (wr * 4 + wc) * XP_WAVE;
#pragma unroll
            for (int ai = 0; ai < 2; ++ai) {
                const int rowblk = u.pm * 256 + ai * 128 + wr * 64;
                int b, kv0; if (latent) { b = rowblk >> 11; kv0 = rowblk & 2047; } else { const int rr = rowblk - TL; b = rr >> 8; kv0 = SEQ + (rr & 255); }
#pragma unroll
                for (int bj = 0; bj < 2; ++bj) {
                    const int hd = (u.pn - 8) * 2 + bj;
#pragma unroll
                    for (int n = 0; n < 2; ++n)
                    {
#pragma unroll
                        for (int m = 0; m < 4; ++m) xpose_write(xl, acc[ai][bj][m][n], m, swz, fq);
                        xpose_flush(xl, lane, Vt + ((size_t)(b * NHEAD + hd) * 128 + wc * 32 + n * 16) * KVN + kv0, (size_t)KVN);
                    }
                }
            }
        }
    }
};
struct EpiSG {
    static constexpr bool PERM = false, AFTER_DRAIN = false;
    bf16* ZU; bf16* ZVT; float* stats;
    __device__ __forceinline__ void operator()(const f32x4 (&acc)[2][2][4][2], const Unit& u, int wr, int wc, int fr, int fq) const {
        const int sect = u.pn >> 2, ct = (u.pn & 3) * 256;
#pragma unroll
        for (int ai = 0; ai < 2; ++ai)
#pragma unroll
            for (int m = 0; m < 4; ++m) {
                const int row = u.pm * 256 + ai * 128 + wr * 64 + m * 16 + fr;
                if (sect == 0) {
#pragma unroll
                    for (int bj = 0; bj < 2; ++bj)
#pragma unroll
                        for (int n = 0; n < 2; ++n) {
                            const f32x4 x = acc[ai][bj][m][n];
                            v2u w; w.x = pk2(gelu_tanh_f(x[0]), gelu_tanh_f(x[1])); w.y = pk2(gelu_tanh_f(x[2]), gelu_tanh_f(x[3]));
                            *(v2u*)(ZU + (size_t)row * DM + ct + bj * 128 + wc * 32 + n * 16 + 4 * fq) = w;
                        }
                } else {
                    const int chunk = row >> 7, s = row & 127;
                    float s1 = 0.f, s2 = 0.f;
#pragma unroll
                    for (int bj = 0; bj < 2; ++bj)
#pragma unroll
                        for (int n = 0; n < 2; ++n)
#pragma unroll
                            for (int i = 0; i < 4; ++i) {
                                const float z = gelu_tanh_f(acc[ai][bj][m][n][i]);
                                s1 += z; s2 += z * z;
                                const int c = ct + bj * 128 + wc * 32 + n * 16 + 4 * fq + i;
                                ZVT[((size_t)chunk * DM + c) * 128 + s] = f2bf(z);
                            }
                    s1 += __shfl_xor(s1, 16); s1 += __shfl_xor(s1, 32);
                    s2 += __shfl_xor(s2, 16); s2 += __shfl_xor(s2, 32);
                    if (fq == 0) { float* sp = stats + ((size_t)row * 16 + (u.pn - 4) * 4 + wc) * 2; sp[0] = s1; sp[1] = s2; }
                }
            }
    }
};

template <class T> __device__ __forceinline__ T* as_global(T* p) { return (T*)(__attribute__((address_space(1))) T*)p; }
#define GAS __attribute__((address_space(1)))
struct Args { GAS const float* in_[20]; GAS float* out_; GAS unsigned char* ws_; };
typedef __attribute__((address_space(4))) const Args CArgs;
struct ArgView { CArgs* p;
    __device__ __forceinline__ const float* in(int i) const { return (const float*)p->in_[i]; }
    __device__ __forceinline__ float* out() const { return (float*)p->out_; }
    __device__ __forceinline__ unsigned char* ws() const { return (unsigned char*)p->ws_; } };
enum { I_X = 0, I_C, I_CTX, I_CCTX, I_WMOD, I_BMOD, I_NORMG, I_WGU, I_WDN, I_DAIN, I_DAOUT, I_DALAM, I_DASUB, I_SGIN, I_SGLNG, I_SGLNB, I_SGWS, I_SGBS, I_SGOUT, I_FINALG };

__device__ __forceinline__ ArgView get_args() { CArgs* p = (CArgs*)__builtin_amdgcn_kernarg_segment_ptr(); asm volatile("" : "+s"(p)); ArgView v; v.p = p; return v; }
__device__ __forceinline__ void transpose_item(const float* W, int K, int N, bf16* WT, int k0, int n0, int drow0, LAS float* scr, int lane) {
    float rv[32];
#pragma unroll
    for (int i = 0; i < 32; ++i) rv[i] = W[(size_t)(k0 + 2 * i + (lane >> 5)) * N + n0 + (lane & 31)];
#pragma unroll
    for (int i = 0; i < 32; ++i) scr[(2 * i + (lane >> 5)) * 33 + (lane & 31)] = rv[i];
    asm volatile("s_waitcnt lgkmcnt(0)" ::: "memory");
    const int c = lane & 7;
#pragma unroll
    for (int j = 0; j < 4; ++j) { const int n = (lane >> 3) + 8 * j; const LAS float* s = scr + (8 * c) * 33 + n;
        v4u o; o.x = pk2(s[0 * 33], s[1 * 33]); o.y = pk2(s[2 * 33], s[3 * 33]); o.z = pk2(s[4 * 33], s[5 * 33]); o.w = pk2(s[6 * 33], s[7 * 33]);
        *(v4u*)(WT + (size_t)(drow0 + n) * K + k0 + 8 * c) = o; }
    asm volatile("s_waitcnt lgkmcnt(0)" ::: "memory");
}

__device__ __forceinline__ int conv_layer_count(int L) { return (L & 1) ? 9984 : 10496; }
__device__ __forceinline__ int conv_idle(int nwg, int G) { return (nwg % G) ? G - nwg % G : 0; }
__device__ __forceinline__ int conv_idle_phase(int l, int which, int G) {
    if (l > 2) return 0;
    if (which == 0) return conv_idle((TT / 256) * 22, G);
    if (which == 1) return conv_idle((TT / 256) * ((l & 1) ? 8 : 12), G);
    return conv_idle(((l < 2 ? TT : TL) / 256) * 22, G);
}
__device__ __forceinline__ int conv_idle_total(int l, int G) { return conv_idle_phase(l, 0, G) + conv_idle_phase(l, 1, G) + conv_idle_phase(l, 2, G); }
__device__ __forceinline__ void conv_layer_items(const ArgView& a, unsigned char* ws, int L, int first, int last, int w, int W, LAS float* scr, int lane) {
    constexpr int I_GU = 16 * 176, I_DN = 44 * 32, I_AIN = 16 * 96, I_SQ = 16 * 32, I_SIN = 16 * 64;
    const int j = L >> 1;
    for (int it = first + w; it < last; it += W) {
        if (it < 2 * I_GU) { const int mi = 2 * L + it / I_GU, r = it % I_GU, kb = r / 176, nb = r % 176; const int n0 = nb * 32; const int jj = n0 < DFF ? n0 : n0 - DFF; const int half = n0 < DFF ? 0 : 1;
            transpose_item(a.in(I_WGU) + (size_t)mi * DM * 2 * DFF, DM, 2 * DFF, (bf16*)(ws + OFF_WGU) + (size_t)mi * 2 * DFF * DM, kb * 64, n0, 256 * (jj >> 7) + 128 * half + (jj & 127), scr, lane); }
        else if (it < 2 * I_GU + 2 * I_DN) { const int q = it - 2 * I_GU, mi = 2 * L + q / I_DN, r = q % I_DN, kb = r / 32, nb = r % 32;
            transpose_item(a.in(I_WDN) + (size_t)mi * DFF * DM, DFF, DM, (bf16*)(ws + OFF_WDN) + (size_t)mi * DM * DFF, kb * 64, nb * 32, nb * 32, scr, lane); }
        else if ((L & 1) == 0) { const int q = it - 2 * I_GU - 2 * I_DN;
            if (q < I_AIN) { const int kb = q / 96, nb = q % 96;
                transpose_item(a.in(I_DAIN) + (size_t)j * DM * 3 * DM, DM, 3 * DM, (bf16*)(ws + OFF_WINA) + (size_t)j * 3 * DM * DM, kb * 64, nb * 32, nb * 32, scr, lane); }
            else { const int r = q - I_AIN, kb = r / 32, nb = r % 32;
                transpose_item(a.in(I_DAOUT) + (size_t)j * DM * DM, DM, DM, (bf16*)(ws + OFF_WOUTA) + (size_t)j * DM * DM, kb * 64, nb * 32, nb * 32, scr, lane); } }
        else { const int q = it - 2 * I_GU - 2 * I_DN;
            if (q < I_SIN) { const int kb = q / 64, nb = q % 64;
                transpose_item(a.in(I_SGIN) + (size_t)j * DM * 2 * DM, DM, 2 * DM, (bf16*)(ws + OFF_WINS) + (size_t)j * 2 * DM * DM, kb * 64, nb * 32, nb * 32, scr, lane); }
            else { const int r = q - I_SIN, kb = r / 32, nb = r % 32;
                transpose_item(a.in(I_SGOUT) + (size_t)j * DM * DM, DM, DM, (bf16*)(ws + OFF_WOUTS) + (size_t)j * DM * DM, kb * 64, nb * 32, nb * 32, scr, lane); } }
    }
}
__device__ __forceinline__ void prologue(LAS unsigned char* lds, int blk, int G, int tid) {
    const int lane = tid & 63, wave = tid >> 6;
    const ArgView a = get_args();
    unsigned char* ws = a.ws();
    {
        LAS float* sc = (LAS float*)lds; LAS float* red = sc + 9 * DM;
        for (int i = tid; i < 9 * DM; i += 512) { const int b = i >> 10, k = i & 1023; const float v = b < 8 ? a.in(I_C)[b * DM + k] : a.in(I_CCTX)[k]; sc[i] = v / (1.0f + __expf(-v)); }
        __syncthreads();
        float* MOD = (float*)(ws + OFF_MOD);
        LAS float* red4 = sc + 9 * DM;
        for (int it = blk; it < 4 * 36; it += G) {
            const int l = it / 36, n0 = (it % 36) * 256, kp = tid >> 6, ln = tid & 63;
            const float* wp = a.in(I_WMOD) + ((size_t)l * DM + kp * 128) * NMODW + n0 + 4 * ln;
            f32x4 a0 = {0.f, 0.f, 0.f, 0.f}, a1 = a0, a2 = a0, a3 = a0, a4 = a0, a5 = a0, a6 = a0, a7 = a0, a8 = a0;
            const LAS float* sp = sc + kp * 128;
#pragma unroll 2
            for (int kk = 0; kk < 128; kk += 4) {
                const f32x4 w0 = *(const f32x4*)(wp + (size_t)kk * NMODW), w1 = *(const f32x4*)(wp + (size_t)(kk + 1) * NMODW), w2 = *(const f32x4*)(wp + (size_t)(kk + 2) * NMODW), w3 = *(const f32x4*)(wp + (size_t)(kk + 3) * NMODW);
#define MOD_ACC(ab, b) do { const f32x4 s_ = *(const LAS f32x4*)(sp + (b) * DM + kk); ab += w0 * s_[0] + w1 * s_[1] + w2 * s_[2] + w3 * s_[3]; } while (0)
                MOD_ACC(a0, 0); MOD_ACC(a1, 1); MOD_ACC(a2, 2); MOD_ACC(a3, 3); MOD_ACC(a4, 4); MOD_ACC(a5, 5); MOD_ACC(a6, 6); MOD_ACC(a7, 7); MOD_ACC(a8, 8);
#undef MOD_ACC
            }
            LAS f32x4* rp = (LAS f32x4*)(red4 + (size_t)kp * 9 * 256) + ln;
            rp[0] = a0; rp[64] = a1; rp[128] = a2; rp[192] = a3; rp[256] = a4; rp[320] = a5; rp[384] = a6; rp[448] = a7; rp[512] = a8;
            __syncthreads();
            for (int o = tid; o < 9 * 256; o += 512) {
                const int b = o >> 8, cc = o & 255; float s = 0.f;
#pragma unroll
                for (int k8 = 0; k8 < 8; ++k8) s += red4[(k8 * 9 + b) * 256 + cc];
                MOD[(size_t)(l * 9 + b) * NMODW + n0 + cc] = s + a.in(I_BMOD)[l * NMODW + n0 + cc];
            }
            __syncthreads();
        }
    }
#ifdef PROBE_XMASK
    if (tid == 0) { LAS unsigned* pacc_ = (LAS unsigned*)(lds + 131072 + 1024); const unsigned t_ = (unsigned)__builtin_amdgcn_s_memrealtime(); pacc_[10] += t_ - pacc_[16]; pacc_[16] = t_; }
#endif
    if (blk == G - 1) {
        float* rope = (float*)(ws + OFF_ROPE);
        for (int idx = tid; idx < 64 * 16; idx += 512) {
            const int pos = idx >> 4, f = idx & 15;
            const float inv = exp2f(-(float)f * 0.8304820237218406f);
            const float ang = (float)pos * inv;
            const double x = (double)ang; const double kq = rint(x * 0.15915494309189535); const double r = x - kq * 6.283185307179586476925;
            const double r2 = r * r; double ts = r, tc = 1.0, ss = r, cc = 1.0;
            for (int n = 1; n <= 16; ++n) { tc *= -r2 / (double)((2 * n - 1) * (2 * n)); ts *= -r2 / (double)((2 * n) * (2 * n + 1)); cc += tc; ss += ts; }
            rope[pos * 32 + f] = (float)cc; rope[pos * 32 + 16 + f] = (float)ss;
        }
    }
    {
        const int gt = blk * 512 + tid, NT = G * 512;
        bf16* wss = (bf16*)(ws + OFF_WSS);
        for (int i = gt; i < 2 * 8 * 128 * 128; i += NT) wss[i] = f2bf(a.in(I_SGWS)[i]);
    }
    __syncthreads();
    {
        LAS float* scr = (LAS float*)(lds + wave * 16384);
        for (int L = 0; L < 4; ++L)
            if (L == 0 || conv_idle_total(L - 1, G) == 0) {
                if (G > 4 * 36 + 32) { if (blk >= 4 * 36) conv_layer_items(a, ws, L, 0, conv_layer_count(L), (blk - 4 * 36) * 8 + wave, (G - 4 * 36) * 8, scr, lane); }
                else conv_layer_items(a, ws, L, 0, conv_layer_count(L), blk * 8 + wave, G * 8, scr, lane);
            }
    }
#ifdef PROBE_XMASK
    __syncthreads();
    if (tid == 0) { LAS unsigned* pacc_ = (LAS unsigned*)(lds + 131072 + 1024); const unsigned t_ = (unsigned)__builtin_amdgcn_s_memrealtime(); pacc_[11] += t_ - pacc_[16]; pacc_[16] = t_; }
#endif
}

template <bool INIT>
__device__ __forceinline__ void norm_phase(const float* x_lat, const float* x_ctx, bf16* H, bf16* XN, const float* g, const float* modl, int ishift, int iscale, int Mrows, int gw, int NGW, int lane,
                                           const bf16* part, int nsl, const float* pgate, float pcoef) {
    const int rpw = (TL + NGW - 1) / NGW;
    f32x4 gs[4], sh[4]; int curb = -1;
    constexpr int R = 4;
    for (int i0 = 0; i0 < rpw; i0 += R) {
        f32x4 v[R][4]; float ss[R];
#pragma unroll
        for (int q = 0; q < R; ++q) {
            int row = gw * rpw + i0 + q; if (i0 + q >= rpw || row >= TL) row = gw * rpw < TL ? gw * rpw : 0;
#pragma unroll
            for (int j = 0; j < 4; ++j) v[q][j] = INIT ? ((const f32x4*)(x_lat + (size_t)row * DM))[lane + 64 * j] : ldh4(H + (size_t)row * DM + 4 * lane + 256 * j);
        }
#pragma unroll
        for (int q = 0; q < R; ++q) { float s = 0.f;
#pragma unroll
            for (int j = 0; j < 4; ++j) s += (v[q][j][0] * v[q][j][0] + v[q][j][1] * v[q][j][1]) + (v[q][j][2] * v[q][j][2] + v[q][j][3] * v[q][j][3]);
            ss[q] = s; }
#pragma unroll
        for (int o = 1; o < 64; o <<= 1) {
#pragma unroll
            for (int q = 0; q < R; ++q) ss[q] += __shfl_xor(ss[q], o);
        }
#pragma unroll
        for (int q = 0; q < R; ++q) {
            const int row = gw * rpw + i0 + q;
            if (i0 + q < rpw && row < TL) {
                const int b9 = row >> 11;
                if (b9 != curb) { curb = b9; const float* mp = modl + (size_t)b9 * NMODW;
#pragma unroll
                    for (int j = 0; j < 4; ++j) { const int col = 4 * lane + 256 * j; gs[j] = *(const f32x4*)(g + col) * (*(const f32x4*)(mp + iscale * DM + col) + 1.0f); sh[j] = *(const f32x4*)(mp + ishift * DM + col); } }
                const float rstd = 1.0f / sqrtf(ss[q] * (1.0f / DM) + 1e-6f);
#pragma unroll
                for (int j = 0; j < 4; ++j) {
                    const int col = 4 * lane + 256 * j;
                    const f32x4 y = (v[q][j] * rstd) * gs[j] + sh[j];
                    v2u w; w.x = pk2(y[0], y[1]); w.y = pk2(y[2], y[3]);
                    *(v2u*)(XN + (size_t)row * DM + col) = w;
                    if (INIT) sth4(H + (size_t)row * DM + col, v[q][j]);
                }
            }
        }
    }
    for (int row = TL + gw; row < Mrows; row += NGW) {
        f32x4 v[4];
#pragma unroll
        for (int j = 0; j < 4; ++j) v[j] = INIT ? ((const f32x4*)(x_ctx + (size_t)(row - TL) * DM))[lane + 64 * j] : ldh4(H + (size_t)row * DM + 4 * lane + 256 * j);
        if (nsl > 0) {
            const int rr = row - TL, pmc = rr >> 8, r = rr & 255;
#pragma unroll
            for (int j = 0; j < 4; ++j) {
                const bf16* pb = part + ((size_t)(pmc * 4 + j) * nsl) * 65536 + (size_t)r * 256 + 4 * lane;
                f32x4 pv[8];
#pragma unroll
                for (int sl = 0; sl < 8; ++sl) pv[sl] = sl < nsl ? ldh4(pb + (size_t)sl * 65536) : (f32x4){0.f, 0.f, 0.f, 0.f};
                const f32x4 sacc = ((pv[0] + pv[1]) + (pv[2] + pv[3])) + ((pv[4] + pv[5]) + (pv[6] + pv[7]));
                v[j] = v[j] + (*(const f32x4*)(pgate + 4 * lane + 256 * j) * pcoef) * sacc;
                sth4(H + (size_t)row * DM + 4 * lane + 256 * j, v[j]);
            }
        }
        float s = 0.f;
#pragma unroll
        for (int j = 0; j < 4; ++j) s += (v[j][0] * v[j][0] + v[j][1] * v[j][1]) + (v[j][2] * v[j][2] + v[j][3] * v[j][3]);
        s = wave_sum(s);
        const float rstd = 1.0f / sqrtf(s * (1.0f / DM) + 1e-6f);
        const float* mp = modl + (size_t)8 * NMODW;
#pragma unroll
        for (int j = 0; j < 4; ++j) {
            const int col = 4 * lane + 256 * j;
            const f32x4 gg = *(const f32x4*)(g + col), sc = *(const f32x4*)(mp + iscale * DM + col), s4 = *(const f32x4*)(mp + ishift * DM + col);
            const f32x4 y = (v[j] * rstd) * gg * (sc + 1.0f) + s4;
            v2u w; w.x = pk2(y[0], y[1]); w.y = pk2(y[2], y[3]);
            *(v2u*)(XN + (size_t)row * DM + col) = w;
            if (INIT) sth4(H + (size_t)row * DM + col, v[j]);
        }
    }
}
__device__ __forceinline__ void final_norm_phase(const bf16* H, float* out, const float* g, int gw, int NGW, int lane) {
    const int rpw = (TL + NGW - 1) / NGW;
    f32x4 gg[4];
#pragma unroll
    for (int j = 0; j < 4; ++j) gg[j] = *(const f32x4*)(g + 4 * lane + 256 * j);
    constexpr int R = 4;
    for (int i0 = 0; i0 < rpw; i0 += R) {
        f32x4 v[R][4]; float ss[R];
#pragma unroll
        for (int q = 0; q < R; ++q) {
            int row = gw * rpw + i0 + q; if (i0 + q >= rpw || row >= TL) row = gw * rpw < TL ? gw * rpw : 0;
#pragma unroll
            for (int j = 0; j < 4; ++j) v[q][j] = ldh4(H + (size_t)row * DM + 4 * lane + 256 * j);
        }
#pragma unroll
        for (int q = 0; q < R; ++q) { float s = 0.f;
#pragma unroll
            for (int j = 0; j < 4; ++j) s += (v[q][j][0] * v[q][j][0] + v[q][j][1] * v[q][j][1]) + (v[q][j][2] * v[q][j][2] + v[q][j][3] * v[q][j][3]);
            ss[q] = s; }
#pragma unroll
        for (int o = 1; o < 64; o <<= 1) {
#pragma unroll
            for (int q = 0; q < R; ++q) ss[q] += __shfl_xor(ss[q], o);
        }
#pragma unroll
        for (int q = 0; q < R; ++q) {
            const int row = gw * rpw + i0 + q;
            if (i0 + q < rpw && row < TL) {
                const float rstd = 1.0f / sqrtf(ss[q] * (1.0f / DM) + 1e-6f);
#pragma unroll
                for (int j = 0; j < 4; ++j) *(f32x4*)(out + (size_t)row * DM + 4 * lane + 256 * j) = (v[q][j] * rstd) * gg[j];
            }
        }
    }
}

constexpr int AT_KB = 64 * 256, AT_VB = 128 * 128, AT_K0 = 0, AT_V0 = 3 * AT_KB;
template <int VAR>
__device__ __forceinline__ void attn_phase(LAS unsigned char* lds, const bf16* Q, const bf16* K, const bf16* Vt, bf16* AO, const float* lam4, const float* subg, float lam_init, bool ctxq, int G, int blk, int tid) {
    const int lane = tid & 63, wave = __builtin_amdgcn_readfirstlane(tid >> 6), rg = wave & 3, r = wave >> 2, q32 = lane & 31, hi = lane >> 5;
    float lamv;
    { float x = 0.f, y = 0.f;
      for (int i = 0; i < 64; ++i) { x += lam4[i] * lam4[64 + i]; y += lam4[128 + i] * lam4[192 + i]; }
      lamv = __expf(x) - __expf(y) + lam_init; }
    const int nunits = 1024 + (ctxq ? 128 : 0);
    const int vcu = (G % 8 == 0) ? (blk % 8) * (G / 8) + blk / 8 : blk;
    for (int uidx = vcu; uidx < nunits; uidx += G) {
        int b, h, qrow0, t0, t1;
        if (uidx < 1024) { b = uidx >> 7; h = (uidx >> 4) & 7; qrow0 = b * SEQ + (uidx & 15) * 128; t0 = 0; t1 = 36; }
        else { const int v = uidx - 1024; b = v >> 4; h = (v >> 1) & 7; qrow0 = TL + b * CTXL + (v & 1) * 128; t0 = 32; t1 = 36; }
        bf16x8 qf[4];
        { const bf16* qp = Q + (size_t)(qrow0 + rg * 32 + q32) * DM + h * 128 + r * 64 + hi * 8;
#pragma unroll
          for (int d0 = 0; d0 < 4; ++d0) qf[d0] = *(const bf16x8*)(qp + d0 * 16);
#pragma unroll
          for (int d0 = 0; d0 < 4; ++d0) asm volatile("" : "+v"(qf[d0])); }
        f32x16 o[4];
#pragma unroll
        for (int db = 0; db < 4; ++db)
#pragma unroll
            for (int i = 0; i < 16; ++i) o[db][i] = 0.f;
        float mrun = 0.f, lrun = 0.f;
        f32x16 negm;
#pragma unroll
        for (int i = 0; i < 16; ++i) negm[i] = 0.f;
        const bf16* kbase = K + h * 128;
        const bf16* vbase = Vt + (size_t)(b * NHEAD + h) * 128 * KVN;
#define AT_ROWB(t) ((t) < 32 ? (size_t)b * SEQ + (size_t)(t) * 64 : (size_t)TL + (size_t)b * CTXL + (size_t)((t) - 32) * 64)
#define AT_DMA(t, kbuf, vbuf) do { const char* kp_ = (const char*)kbase + AT_ROWB(t) * (size_t)(DM * 2); const char* vp_ = (const char*)vbase + (size_t)(t) * 128; \
            _Pragma("unroll") for (int i_ = 0; i_ < 2; ++i_) { \
                const int krow_ = 8 * wave + 4 * i_ + (lane >> 4); \
                __builtin_amdgcn_global_load_lds((const unsigned*)(kp_ + (size_t)krow_ * (DM * 2) + (((lane & 15) ^ (krow_ & 15)) * 16)), (LAS unsigned*)(lds + AT_K0 + (kbuf) * AT_KB + wave * 2048 + i_ * 1024), 16, 0, 0); } \
            _Pragma("unroll") for (int i_ = 0; i_ < 2; ++i_) { \
                const int vrow_ = 16 * wave + 8 * i_ + (lane >> 3); \
                __builtin_amdgcn_global_load_lds((const unsigned*)(vp_ + (size_t)vrow_ * (KVN * 2) + (((lane & 7) ^ ((vrow_ >> 1) & 7)) * 16)), (LAS unsigned*)(lds + AT_V0 + (vbuf) * AT_VB + wave * 2048 + i_ * 1024), 16, 0, 0); } } while (0)
#define AT_SB() __builtin_amdgcn_sched_barrier(0)
        unsigned kfo[4], vfo[4];
#pragma unroll
        for (int i = 0; i < 4; ++i) { kfo[i] = (unsigned)(q32 * 256 + (((r * 8 + 2 * i + hi) ^ (q32 & 15)) * 16)); vfo[i] = (unsigned)(q32 * 128 + (((2 * i + hi) ^ ((q32 >> 1) & 7)) * 16)); }
#define AT_QK(S0, S1, buf) do { const LAS unsigned char* kb_ = lds + AT_K0 + (buf) * AT_KB; bf16x8 kf_[4]; \
            _Pragma("unroll") for (int d_ = 0; d_ < 2; ++d_) { kf_[2 * d_] = *(const LAS bf16x8*)(kb_ + kfo[d_]); kf_[2 * d_ + 1] = *(const LAS bf16x8*)(kb_ + 32 * 256 + kfo[d_]); } \
            AT_SB(); \
            S0 = MFMA32(kf_[0], qf[0], negm); S1 = MFMA32(kf_[1], qf[0], negm); \
            S0 = MFMA32(kf_[2], qf[1], S0); S1 = MFMA32(kf_[3], qf[1], S1); \
            AT_SB(); \
            _Pragma("unroll") for (int d_ = 0; d_ < 2; ++d_) { kf_[2 * d_] = *(const LAS bf16x8*)(kb_ + kfo[d_ + 2]); kf_[2 * d_ + 1] = *(const LAS bf16x8*)(kb_ + 32 * 256 + kfo[d_ + 2]); } \
            AT_SB(); \
            S0 = MFMA32(kf_[0], qf[2], S0); S1 = MFMA32(kf_[1], qf[2], S1); S0 = MFMA32(kf_[2], qf[3], S0); S1 = MFMA32(kf_[3], qf[3], S1); } while (0)
        bf16x8 va[4];
#pragma unroll
        for (int i = 0; i < 4; ++i) va[i] = (bf16x8){0, 0, 0, 0, 0, 0, 0, 0};
#define AT_PV_PRE(VB) do { const LAS unsigned char* vb = lds + AT_V0 + (VB) * AT_VB; \
            _Pragma("unroll") for (int ks = 0; ks < 4; ++ks) va[ks] = *(const LAS bf16x8*)(vb + vfo[ks]); } while (0)
#define AT_PV_RUN(PF, VB) do { const LAS unsigned char* vb = lds + AT_V0 + (VB) * AT_VB; bf16x8 vc[4], ve[4]; \
            _Pragma("unroll") for (int ks = 0; ks < 4; ++ks) vc[ks] = *(const LAS bf16x8*)(vb + 1 * 32 * 128 + vfo[ks]); \
            _Pragma("unroll") for (int ks = 0; ks < 4; ++ks) ve[ks] = *(const LAS bf16x8*)(vb + 2 * 32 * 128 + vfo[ks]); \
            AT_SB(); __builtin_amdgcn_s_setprio(1); \
            _Pragma("unroll") for (int ks = 0; ks < 4; ++ks) o[0] = MFMA32(va[ks], PF[ks], o[0]); \
            AT_SB(); \
            _Pragma("unroll") for (int ks = 0; ks < 4; ++ks) va[ks] = *(const LAS bf16x8*)(vb + 3 * 32 * 128 + vfo[ks]); \
            AT_SB(); \
            _Pragma("unroll") for (int ks = 0; ks < 4; ++ks) o[1] = MFMA32(vc[ks], PF[ks], o[1]); \
            AT_SB(); \
            _Pragma("unroll") for (int ks = 0; ks < 4; ++ks) o[2] = MFMA32(ve[ks], PF[ks], o[2]); \
            AT_SB(); \
            _Pragma("unroll") for (int ks = 0; ks < 4; ++ks) o[3] = MFMA32(va[ks], PF[ks], o[3]); \
            __builtin_amdgcn_s_setprio(0); \
            AT_SB(); } while (0)
#define AT_STEP(C0, C1, t) do { \
            if (!(VAR & 8)) { if ((t) + 2 < t1) AT_DMA((t) + 2, (kc + 2) % 3, (vc4 + 2) & 3); } \
            if (!(VAR & 2)) { if (r == 1 && (t) > t0) AT_PV_PRE((vc4 + 3) & 3); } \
            if (!(VAR & 4)) AT_QK(C0, C1, kc); else { C0 = negm; C1 = negm; }    \
            if (!(VAR & 2)) { if (r == 1 && (t) > t0) AT_PV_RUN(pfp, (vc4 + 3) & 3); if (r == 0) AT_PV_PRE(vc4); } \
            AT_SB(); \
            asm volatile("s_nop 15\n\ts_nop 7" : "+v"(C0), "+v"(C1));     \
            if (!(VAR & 1)) { \
            float rm, rb_; \
            rm = max3f(C0[0], C0[1], C1[0]); rb_ = max3f(C0[2], C0[3], C1[1]); rm = max3f(rm, C1[2], C1[3]); \
            _Pragma("unroll") for (int i = 4; i < 16; i += 4) { rm = max3f(rm, C0[i], C0[i + 1]); rb_ = max3f(rb_, C0[i + 2], C0[i + 3]); rm = max3f(rm, C1[i], C1[i + 1]); rb_ = max3f(rb_, C1[i + 2], C1[i + 3]); } \
            rm = xhalf_max(fmaxf(rm, rb_)); \
            if (__any(rm > 8.0f) || (t) == t0) { const float dl = (t) == t0 ? rm : fmaxf(rm, 0.f), alpha = fast_exp2(-dl); mrun += dl; lrun *= alpha; \
                _Pragma("unroll") for (int i = 0; i < 16; ++i) { C0[i] -= dl; C1[i] -= dl; negm[i] = -mrun; } \
                _Pragma("unroll") for (int db = 0; db < 4; ++db) _Pragma("unroll") for (int i = 0; i < 16; ++i) o[db][i] *= alpha; } \
            f32x2_t ps_ = (f32x2_t){0.f, 0.f}; \
            _Pragma("unroll") for (int i = 0; i < 16; i += 2) { C0[i] = fast_exp2(C0[i]); C0[i + 1] = fast_exp2(C0[i + 1]); C1[i] = fast_exp2(C1[i]); C1[i + 1] = fast_exp2(C1[i + 1]); \
                ps_ += (f32x2_t){C0[i], C0[i + 1]}; ps_ += (f32x2_t){C1[i], C1[i + 1]}; } \
            lrun += ps_[0] + ps_[1]; \
            } \
            { v4u w; \
              w.x = pk2(C0[0], C0[1]); w.y = pk2(C0[2], C0[3]); w.z = pk2(C0[4], C0[5]); w.w = pk2(C0[6], C0[7]); pfp[0] = __builtin_bit_cast(bf16x8, w); \
              w.x = pk2(C0[8], C0[9]); w.y = pk2(C0[10], C0[11]); w.z = pk2(C0[12], C0[13]); w.w = pk2(C0[14], C0[15]); pfp[1] = __builtin_bit_cast(bf16x8, w); \
              w.x = pk2(C1[0], C1[1]); w.y = pk2(C1[2], C1[3]); w.z = pk2(C1[4], C1[5]); w.w = pk2(C1[6], C1[7]); pfp[2] = __builtin_bit_cast(bf16x8, w); \
              w.x = pk2(C1[8], C1[9]); w.y = pk2(C1[10], C1[11]); w.z = pk2(C1[12], C1[13]); w.w = pk2(C1[14], C1[15]); pfp[3] = __builtin_bit_cast(bf16x8, w); } \
            AT_SB(); \
            if (!(VAR & 2)) { if (r == 0) AT_PV_RUN(pfp, vc4); } \
            if (!(VAR & 8) && (t) + 2 < t1) asm volatile("s_waitcnt vmcnt(4) lgkmcnt(0)" ::: "memory"); else asm volatile("s_waitcnt vmcnt(0) lgkmcnt(0)" ::: "memory"); \
            __builtin_amdgcn_s_barrier(); asm volatile("" ::: "memory"); \
            kc = (kc + 1) % 3; vc4 = (vc4 + 1) & 3; } while (0)
        bf16x8 pfp[4];
#pragma unroll
        for (int i = 0; i < 4; ++i) pfp[i] = (bf16x8){0, 0, 0, 0, 0, 0, 0, 0};
        int kc = 0, vc4 = 0;
        AT_DMA(t0, 0, 0); AT_DMA(t0 + 1, 1, 1);
        asm volatile("s_waitcnt vmcnt(4) lgkmcnt(0)" ::: "memory"); __builtin_amdgcn_s_barrier(); asm volatile("" ::: "memory");
        for (int t = t0; t < t1; ++t) {
            f32x16 sa0, sa1;
            AT_STEP(sa0, sa1, t);
        }
        if (!(VAR & 2)) { if (r == 1) { AT_PV_PRE((vc4 + 3) & 3); AT_PV_RUN(pfp, (vc4 + 3) & 3); } }
        __syncthreads();
#undef AT_PV_PRE
#undef AT_PV_RUN
#undef AT_ROWB
#undef AT_DMA
#undef AT_SB
#undef AT_QK
#undef AT_STEP
        lrun = xhalf_sum(lrun);
        const float inv = 1.0f / lrun;
        LAS float* xch = (LAS float*)lds + rg * 4096;
        if (r == 1) {
#pragma unroll
            for (int db = 0; db < 4; ++db)
#pragma unroll
                for (int i = 0; i < 16; ++i) xch[(db * 16 + i) * 64 + lane] = o[db][i] * inv;
        }
        __syncthreads();
        if (r == 0) {
            float ss = 0.f;
#pragma unroll
            for (int db = 0; db < 4; ++db)
#pragma unroll
                for (int i = 0; i < 16; ++i) { const float d = o[db][i] * inv - lamv * xch[(db * 16 + i) * 64 + lane]; o[db][i] = d; ss += d * d; }
            ss = xhalf_sum(ss);
            const float rn = (1.0f / sqrtf(ss * (1.0f / 128.0f) + 1e-6f)) * (1.0f - lam_init);
            bf16* op = AO + (size_t)(qrow0 + rg * 32 + q32) * DM + h * 128;
#pragma unroll
            for (int db = 0; db < 4; ++db)
#pragma unroll
                for (int i4 = 0; i4 < 4; ++i4) {
                    const int dcol = 32 * db + 8 * i4 + 4 * hi;
                    const f32x4 g4 = *(const f32x4*)(subg + dcol);
                    v2u w; w.x = pk2(o[db][4 * i4] * rn * g4[0], o[db][4 * i4 + 1] * rn * g4[1]); w.y = pk2(o[db][4 * i4 + 2] * rn * g4[2], o[db][4 * i4 + 3] * rn * g4[3]);
                    *(v2u*)(op + dcol) = w;
                }
        }
        __syncthreads();
    }
}

__device__ __forceinline__ void sgmix_phase(LAS unsigned char* lds, const bf16* ZU, const bf16* ZVT, const float* stats, const bf16* WS, const float* bs, const float* lng, const float* lnb, bf16* Gout, int nchunks, int G, int blk, int tid) {
    const int lane = tid & 63, wave = __builtin_amdgcn_readfirstlane(tid >> 6), q32 = lane & 31, hi = lane >> 5;
    const int vcu = (G % 8 == 0) ? (blk % 8) * (G / 8) + blk / 8 : blk;
    const int tb = wave >> 1, ch = wave & 1;
    int buf = 0;
    for (int u = vcu; u < nchunks * 8; u += G, buf ^= 1) {
        const int chunk = u >> 3, g = u & 7;
        LAS unsigned char* tile = lds + buf * 34816;
        LAS float* smu = (LAS float*)(lds + 69632 + buf * 1024); LAS float* srs = smu + 128;
        const bf16* wp = WS + ((size_t)g * 128 + tb * 32 + q32) * 128 + hi * 8;
        bf16x8 wf[8];
#pragma unroll
        for (int k = 0; k < 8; ++k) wf[k] = *(const bf16x8*)(wp + k * 16);
        const int t = tb * 32 + q32; const size_t row = (size_t)chunk * 128 + t;
        const float bias = bs[g * 128 + t];
        v2u ug[2][4];
#pragma unroll
        for (int cb = 0; cb < 2; ++cb)
#pragma unroll
            for (int i4 = 0; i4 < 4; ++i4) ug[cb][i4] = *(const v2u*)(ZU + row * DM + g * 128 + ch * 64 + cb * 32 + 8 * i4 + 4 * hi);
        v4u raw[4];
#pragma unroll
        for (int it = 0; it < 4; ++it) { const int idx = it * 512 + tid, c = idx >> 4, s8 = (idx & 15) * 8; raw[it] = *(const v4u*)(ZVT + ((size_t)chunk * DM + g * 128 + c) * 128 + s8); }
        {
            const int r = tid >> 2, part = tid & 3;
            const f32x4* sp = (const f32x4*)(stats + ((size_t)(chunk * 128 + r) * 16 + part * 4) * 2);
            const f32x4 a0 = sp[0], a1 = sp[1];
            float s1 = (a0[0] + a0[2]) + (a1[0] + a1[2]), s2 = (a0[1] + a0[3]) + (a1[1] + a1[3]);
            s1 += __shfl_xor(s1, 1); s2 += __shfl_xor(s2, 1); s1 += __shfl_xor(s1, 2); s2 += __shfl_xor(s2, 2);
            if (part == 0) { const float mu = s1 * (1.0f / DM); const float var = fmaxf(s2 * (1.0f / DM) - mu * mu, 0.f); smu[r] = mu; srs[r] = 1.0f / sqrtf(var + 1e-5f); }
        }
        __syncthreads();
#pragma unroll
        for (int it = 0; it < 4; ++it) {
            const int idx = it * 512 + tid, c = idx >> 4, s8 = (idx & 15) * 8;
            const float gg = lng[g * 128 + c], bb = lnb[g * 128 + c];
            float y[8];
#pragma unroll
            for (int j = 0; j < 4; ++j) { const unsigned wv = raw[it][j];
                y[2 * j] = (bf2f(wv & 0xffffu) - smu[s8 + 2 * j]) * srs[s8 + 2 * j] * gg + bb;
                y[2 * j + 1] = (bf2f(wv >> 16) - smu[s8 + 2 * j + 1]) * srs[s8 + 2 * j + 1] * gg + bb; }
            v4u w; w.x = pk2(y[0], y[1]); w.y = pk2(y[2], y[3]); w.z = pk2(y[4], y[5]); w.w = pk2(y[6], y[7]);
            *(LAS v4u*)(tile + c * 272 + s8 * 2) = w;
        }
        __syncthreads();
        f32x16 acc0, acc1;
#pragma unroll
        for (int i = 0; i < 16; ++i) { acc0[i] = 0.f; acc1[i] = 0.f; }
        const LAS unsigned char* bp = tile + (ch * 64 + q32) * 272 + hi * 16;
#pragma unroll
        for (int k = 0; k < 8; ++k) {
            const bf16x8 b0 = *(const LAS bf16x8*)(bp + k * 32), b1 = *(const LAS bf16x8*)(bp + 32 * 272 + k * 32);
            acc0 = MFMA32(b0, wf[k], acc0); acc1 = MFMA32(b1, wf[k], acc1);
        }
#pragma unroll
        for (int i4 = 0; i4 < 4; ++i4) {
            const int col = g * 128 + ch * 64 + 8 * i4 + 4 * hi;
            const f32x4 u0 = (f32x4){bf2f(ug[0][i4].x & 0xffffu), bf2f(ug[0][i4].x >> 16), bf2f(ug[0][i4].y & 0xffffu), bf2f(ug[0][i4].y >> 16)};
            const f32x4 u1 = (f32x4){bf2f(ug[1][i4].x & 0xffffu), bf2f(ug[1][i4].x >> 16), bf2f(ug[1][i4].y & 0xffffu), bf2f(ug[1][i4].y >> 16)};
            const f32x4 m0 = (f32x4){acc0[4 * i4], acc0[4 * i4 + 1], acc0[4 * i4 + 2], acc0[4 * i4 + 3]}, m1 = (f32x4){acc1[4 * i4], acc1[4 * i4 + 1], acc1[4 * i4 + 2], acc1[4 * i4 + 3]};
            sth4(Gout + row * DM + col, (m0 + bias) * u0);
            sth4(Gout + row * DM + col + 32, (m1 + bias) * u1);
        }
    }
    __syncthreads();
}

#define XB_TMO      128
#define XB_XCNT(j)  (256  + 64 * (j))
#define XB_XSUB(j)  (1280 + 64 * (j))
#define XB_XGEN(j)  (2304 + 64 * (j))
#define XB_TOP      3328
#define XB_TOPGEN   3392
#define XCD_BAR_WORDS 3456
#define XB_SPIN_CAP (1u << 18)

__device__ __forceinline__ unsigned xb_ld(unsigned* p)              { return __hip_atomic_load(p, __ATOMIC_RELAXED, __HIP_MEMORY_SCOPE_AGENT); }
__device__ __forceinline__ unsigned xb_add(unsigned* p, unsigned v) { return __hip_atomic_fetch_add(p, v, __ATOMIC_RELAXED, __HIP_MEMORY_SCOPE_AGENT); }
__device__ __forceinline__ unsigned xb_xcc_id() { return (unsigned)__builtin_amdgcn_s_getreg((3 << 11) | 20) & 0xFu; }
#define XB_SPIN(cond, bar) do { unsigned _sp = 0; while (cond) { __builtin_amdgcn_s_sleep(1); \
    if ((++_sp & 255u) == 0u) { if (xb_ld(&(bar)[XB_TMO])) break; if (_sp > XB_SPIN_CAP) { atomicAdd(&(bar)[XB_TMO], 1u); break; } } } } while (0)

struct XcdBarrier {
    unsigned* bar; unsigned x;
    volatile LAS unsigned* st;
};

__device__ __forceinline__ XcdBarrier xcd_barrier_post(unsigned* bar, volatile LAS unsigned* st) {
    XcdBarrier b; b.bar = bar; b.x = xb_xcc_id(); b.st = st;
    if (threadIdx.x == 0) (void)xb_add(&bar[XB_XCNT(b.x)], 1u);
    return b;
}
__device__ __forceinline__ void xcd_barrier_complete(unsigned* bar, unsigned x, unsigned& nloc, unsigned& nx) {
    const unsigned G = gridDim.x * gridDim.y * gridDim.z;
    unsigned sum, cnt, mine, sp = 0u;
    for (;;) {
        sum = 0u; cnt = 0u; mine = 0u;
#pragma unroll
        for (unsigned j = 0; j < 16; ++j) { const unsigned c = xb_ld(&bar[XB_XCNT(j)]); sum += c; cnt += (c > 0u) ? 1u : 0u; mine = (j == x) ? c : mine; }
        if (sum == G) break;
        __builtin_amdgcn_s_sleep(1);
        if ((++sp & 255u) == 0u) { if (xb_ld(&bar[XB_TMO])) break; if (sp > XB_SPIN_CAP) { atomicAdd(&bar[XB_TMO], 1u); break; } }
    }
    nloc = mine > 0u ? mine : 1u; nx = cnt > 0u ? cnt : 1u;
}

__device__ __forceinline__ void xcd_barrier(const XcdBarrier& b) {
    asm volatile("s_waitcnt vmcnt(0)" ::: "memory");
    __syncthreads();
    if (threadIdx.x == 0) {
        unsigned* bar = b.bar;
        __builtin_amdgcn_s_waitcnt(0);
        unsigned nloc = b.st[0], nx = b.st[1];
        if (nloc == 0u) { xcd_barrier_complete(bar, b.x, nloc, nx); b.st[0] = nloc; b.st[1] = nx; }
        const unsigned old = xb_add(&bar[XB_XSUB(b.x)], 1u);
        const unsigned gen = old / nloc;
        if (old + 1u == (gen + 1u) * nloc) {
            __builtin_amdgcn_fence(__ATOMIC_RELEASE, "agent");
            asm volatile("s_waitcnt vmcnt(0)" ::: "memory");
            const unsigned og = xb_add(&bar[XB_TOP], 1u);
            const unsigned tg = og / nx;
            if (og + 1u == (tg + 1u) * nx) xb_add(&bar[XB_TOPGEN], 1u);
            else XB_SPIN(xb_ld(&bar[XB_TOPGEN]) == tg, bar);
            __builtin_amdgcn_fence(__ATOMIC_ACQUIRE, "agent");
            xb_add(&bar[XB_XGEN(b.x)], 1u);
            asm volatile("s_waitcnt vmcnt(0)" ::: "memory");
        } else {
            XB_SPIN(xb_ld(&bar[XB_XGEN(b.x)]) == gen, bar);
            __builtin_amdgcn_fence(__ATOMIC_ACQUIRE, "agent");
            asm volatile("s_waitcnt vmcnt(0)" ::: "memory");
        }
    }
    __syncthreads();
}

constexpr int LDS_BYTES = 131072 + 2048 + 8 * XP_WAVE;
__global__ void __launch_bounds__(512, 2) hybrid_fwd(Args a) {
    extern __shared__ __attribute__((aligned(16))) unsigned char lds_raw[];
    LAS unsigned char* lds = (LAS unsigned char*)lds_raw;
    cg::grid_group grid = cg::this_grid();
    const int G = gridDim.x, blk = blockIdx.x;
    if (threadIdx.x < 4) ((LAS unsigned*)(lds + 131072 + 512))[threadIdx.x] = 0u;
    __syncthreads();
    (void)xcd_barrier_post((unsigned*)(get_args().ws() + OFF_BAR), (volatile LAS unsigned*)(lds + 131072 + 512));
#define GRID_BARRIER() do { XcdBarrier xb_; xb_.bar = (unsigned*)(get_args().ws() + OFF_BAR); xb_.x = (unsigned)__builtin_amdgcn_readfirstlane((int)xb_xcc_id()); xb_.st = (volatile LAS unsigned*)(lds + 131072 + 512); xcd_barrier(xb_); } while (0)

#ifdef PROBE_XMASK
    LAS unsigned* pacc = (LAS unsigned*)(lds + 131072 + 1024);
    if (threadIdx.x == 0) { for (int i = 0; i < 16; ++i) pacc[i] = 0u; const unsigned long long t = __builtin_amdgcn_s_memrealtime(); pacc[16] = (unsigned)t; }
#define PSTAMP(type) do { if (threadIdx.x == 0) { const unsigned t_ = (unsigned)__builtin_amdgcn_s_memrealtime(); pacc[(type)] += t_ - pacc[16]; pacc[16] = t_; } } while (0)
#else
#define PSTAMP(type) do {} while (0)
#endif
#ifndef DIS_PRO
    prologue(lds, blk, G, threadIdx.x);
#endif
    if (G == 0x7fffffff) grid.sync();
    GRID_BARRIER();
    PSTAMP(0);

    for (int ph = 0; ph < 41; ++ph) {
        int tid = threadIdx.x; asm volatile("" : "+v"(tid));
        const int lane = tid & 63, wave = __builtin_amdgcn_readfirstlane(tid >> 6);
        const int gw = blk * 8 + wave, NGW = G * 8;
        const ArgView a = get_args();
        unsigned char* ws = a.ws();
        bf16* H = (bf16*)(ws + OFF_H);
        bf16* XN = (bf16*)(ws + OFF_XN);
        bf16* BIG = (bf16*)(ws + OFF_BIG);
        const float* MOD = (const float*)(ws + OFF_MOD);
        if (ph == 40) { final_norm_phase(H, a.out(), a.in(I_FINALG), gw, NGW, lane);
#ifdef PROBE_XMASK
            GRID_BARRIER(); PSTAMP(9);
            if (blk == 0 && threadIdx.x == 0) {
                unsigned xt = 0, yt = 0;
                for (int i = 0; i < 16; ++i) { if ((PROBE_XMASK >> i) & 1) xt += pacc[i]; if ((PROBE_YMASK >> i) & 1) yt += pacc[i]; }
                const unsigned xus = xt / 100u, yq = (yt / 100u + 16u) / 32u;
                const unsigned long long spin = ((unsigned long long)xus + 2048ull * yq) * 100ull, t0 = __builtin_amdgcn_s_memrealtime();
                while (__builtin_amdgcn_s_memrealtime() - t0 < spin) __builtin_amdgcn_s_sleep(32);
            }
#endif
            break; }
        const int l = ph / 10, s = ph % 10, j = l >> 1;
        const bool attn_layer = (l & 1) == 0;
        const float* modl = MOD + (size_t)l * 9 * NMODW;
        int Mrows = TT; if (l == 3 || (l == 2 && s >= 6)) Mrows = TL;
        if (s == 0 || s == 3 || s == 7) {
            const int k = s == 0 ? 0 : (s == 3 ? 1 : 2);
            const bool init = (ph == 0);
#ifndef DIS_NORM
            int pl = l, pg = 2, pn = 0; float pc = 0.5f;
            if (k == 0) { pl = l - 1; pg = 8; pn = (l == 1 || l == 2) ? 8 : 0; }
            else if (k == 1) { pg = 2; pn = (l <= 2) ? 8 : 0; }
            else { pg = 5; pc = 1.0f; pn = (l <= 1) ? 4 : 0; }
            if (pl < 0) pl = 0;
            if (init) norm_phase<true>(a.in(I_X), a.in(I_CTX), H, XN, a.in(I_NORMG) + (size_t)(l * 3 + k) * DM, modl, 3 * k, 3 * k + 1, Mrows, gw, NGW, lane, (const bf16*)(ws + OFF_PART), 0, MOD, pc);
            else norm_phase<false>(nullptr, nullptr, H, XN, a.in(I_NORMG) + (size_t)(l * 3 + k) * DM, modl, 3 * k, 3 * k + 1, Mrows, gw, NGW, lane,
                       (const bf16*)(ws + OFF_PART), pn, MOD + (size_t)(pl * 9 + 8) * NMODW + pg * DM, pc);
#endif
        } else if (s == 1 || s == 8) {
            const int f = s == 1 ? 0 : 1;
            pg8::Gemm g{XN, (const bf16*)(ws + OFF_WGU) + (size_t)(l * 2 + f) * 2 * DFF * DM, Mrows, 2 * DFF, DM};
            pg8::StaticOrder S; S.init(Mrows, 2 * DFF, G, blk); S.nkt_full = DM / 64;
            EpiSwiGLU E{BIG};
#ifndef DIS_GU
            pg8::gemm_phase<EpiSwiGLU, pg8::StaticOrder, true, true>(lds, g, S, E);
#endif
        } else if (s == 2 || s == 9 || s == 6) {
            const bf16* A; const bf16* Bt; int Kd; int gidx; float coef;
            if (s == 6) { A = XN; Kd = DM; gidx = 5; coef = 1.0f; Bt = attn_layer ? (const bf16*)(ws + OFF_WOUTA) + (size_t)j * DM * DM : (const bf16*)(ws + OFF_WOUTS) + (size_t)j * DM * DM; }
            else { const int f = s == 2 ? 0 : 1; A = BIG; Kd = DFF; gidx = s == 2 ? 2 : 8; coef = 0.5f; Bt = (const bf16*)(ws + OFF_WDN) + (size_t)(l * 2 + f) * DM * DFF; }
            pg8::Gemm g{A, Bt, Mrows, DM, Kd};
            SplitOrder S; S.init(Mrows == TT ? (Kd == DFF ? 8 : 4) : 0, Kd / 64, G, blk);
            EpiResid E{ws, modl + gidx * DM, coef == 0.5f ? 1 : 0};
#ifndef DIS_RES
            pg8::gemm_phase<EpiResid, SplitOrder, true, true>(lds, g, S, E);
#endif
        } else if (s == 4) {
            if (attn_layer) {
                pg8::Gemm g{XN, (const bf16*)(ws + OFF_WINA) + (size_t)j * 3 * DM * DM, Mrows, 3 * DM, DM};
                pg8::StaticOrder S; S.init(Mrows, 3 * DM, G, blk); S.nkt_full = DM / 64;
                EpiQKV E{BIG, (bf16*)((unsigned char*)BIG + SZ_TOK), (bf16*)((unsigned char*)BIG + 2 * SZ_TOK), (const float*)(ws + OFF_ROPE), lds + XP_OFF};
#ifndef DIS_QKV
                pg8::gemm_phase<EpiQKV, pg8::StaticOrder, true, true>(lds, g, S, E);
#endif
            } else {
                pg8::Gemm g{XN, (const bf16*)(ws + OFF_WINS) + (size_t)j * 2 * DM * DM, Mrows, 2 * DM, DM};
                pg8::StaticOrder S; S.init(Mrows, 2 * DM, G, blk); S.nkt_full = DM / 64;
                EpiSG E{BIG, (bf16*)((unsigned char*)BIG + SZ_TOK), (float*)(ws + OFF_SGST2) + (size_t)j * TT * 32};
#ifndef DIS_SG
                pg8::gemm_phase<EpiSG, pg8::StaticOrder, true, true>(lds, g, S, E);
#endif
            }
        } else {
            if (attn_layer) {
                const float lam_init = 0.8f - 0.6f * __expf(-0.3f * (float)l);
#ifndef DIS_ATT
                attn_phase<0>(lds, BIG, (const bf16*)((unsigned char*)BIG + SZ_TOK), (const bf16*)((unsigned char*)BIG + 2 * SZ_TOK), XN, a.in(I_DALAM) + j * 256, a.in(I_DASUB) + j * 128, lam_init, l == 0, G, blk, tid);
#ifdef PROBE_ATT
                if (l == 0) attn_phase<PROBE_ATT>(lds, BIG, (const bf16*)((unsigned char*)BIG + SZ_TOK), (const bf16*)((unsigned char*)BIG + 2 * SZ_TOK), (bf16*)(ws + OFF_PART), a.in(I_DALAM) + j * 256, a.in(I_DASUB) + j * 128, lam_init, false, G, blk, tid);
#endif
#endif
            } else {
#ifndef DIS_MIX
                sgmix_phase(lds, BIG, (const bf16*)((unsigned char*)BIG + SZ_TOK), (const float*)(ws + OFF_SGST2) + (size_t)j * TT * 32, (const bf16*)(ws + OFF_WSS) + (size_t)j * 8 * 128 * 128,
                            a.in(I_SGBS) + j * 8 * 128, a.in(I_SGLNG) + j * DM, a.in(I_SGLNB) + j * DM, XN, Mrows / 128, G, blk, tid);
#endif
            }
        }
        if (l < 3 && (s == 1 || s == 4 || s == 8)) {
            const int which = s == 1 ? 0 : (s == 4 ? 1 : 2);
            const int nid = conv_idle_phase(l, which, G), tot_idle = conv_idle_total(l, G);
            const int nwg = which == 0 ? (TT / 256) * 22 : (which == 1 ? (TT / 256) * (attn_layer ? 12 : 8) : ((l < 2 ? TT : TL) / 256) * 22);
            const int rem = nwg % G;
            if (nid > 0 && blk >= rem) {
                const int L = l + 1, tot = conv_layer_count(L);
                const int before = which == 0 ? 0 : (which == 1 ? conv_idle_phase(l, 0, G) : conv_idle_phase(l, 0, G) + conv_idle_phase(l, 1, G));
                const int first = (int)((long long)tot * before / tot_idle), last = (int)((long long)tot * (before + nid) / tot_idle);
                conv_layer_items(a, ws, L, first, last, (blk - rem) * 8 + wave, nid * 8, (LAS float*)(lds + wave * 16384), lane);
            }
        }
        GRID_BARRIER();
#ifdef PROBE_SYNC3
        GRID_BARRIER(); GRID_BARRIER();
#endif
        PSTAMP(s == 0 || s == 3 || s == 7 ? 1 : (s == 1 || s == 8 ? 2 : (s == 2 || s == 9 ? 3 : (s == 6 ? 4 : (s == 4 ? (attn_layer ? 5 : 6) : (attn_layer ? 7 : 8))))));
    }
}

extern "C" void kernel_launch(void* const* d_in, const int* in_sizes, int n_in, void* d_out, int out_size, void* d_ws, size_t ws_size, hipStream_t stream) {
    static int grid = 0;
    if (grid == 0) {
        if (n_in != 20 || ws_size < WS_NEED || out_size != TL * DM) { fprintf(stderr, "kernel_launch: unexpected problem (n_in %d, ws %zu, out %d)\n", n_in, ws_size, out_size); grid = -1; return; }
        int dev = 0, cus = 0, per_cu = 0;
        if (hipGetDevice(&dev) != hipSuccess || hipDeviceGetAttribute(&cus, hipDeviceAttributeMultiprocessorCount, dev) != hipSuccess) { grid = -1; return; }
        if (hipFuncSetAttribute((const void*)hybrid_fwd, hipFuncAttributeMaxDynamicSharedMemorySize, LDS_BYTES) != hipSuccess) { fprintf(stderr, "kernel_launch: hipFuncSetAttribute failed\n"); grid = -1; return; }
        if (hipOccupancyMaxActiveBlocksPerMultiprocessor(&per_cu, (const void*)hybrid_fwd, 512, LDS_BYTES) != hipSuccess || per_cu < 1) { fprintf(stderr, "kernel_launch: occupancy query says %d\n", per_cu); per_cu = 1; }
        (void)hipGetLastError();
        grid = cus;
    }
    if (grid < 0) return;
    if (hipMemsetAsync((char*)d_ws + OFF_BAR, 0, 16384, stream) != hipSuccess) { fprintf(stderr, "kernel_launch: memset failed\n"); return; }
    Args a{};
    for (int i = 0; i < 20; ++i) a.in_[i] = (GAS const float*)d_in[i];
    a.out_ = (GAS float*)d_out; a.ws_ = (GAS unsigned char*)d_ws;
    void* params[] = {&a};
    hipError_t e = hipLaunchCooperativeKernel((const void*)hybrid_fwd, dim3(grid), dim3(512), params, LDS_BYTES, stream);
    if (e != hipSuccess) fprintf(stderr, "kernel_launch: cooperative launch failed: %s (grid %d)\n", hipGetErrorString(e), grid);
}
```

```cpp
#include <hip/hip_runtime.h>
#include <hip/hip_cooperative_groups.h>
#include <cstdio>
#include <cstdint>
namespace cg = cooperative_groups;
namespace pg8 {
#define PG8_LAS __attribute__((address_space(3)))
typedef unsigned short bf16_t;
typedef short bf16x8 __attribute__((ext_vector_type(8)));
typedef float f32x4 __attribute__((ext_vector_type(4)));
typedef unsigned u32x4 __attribute__((ext_vector_type(4)));
constexpr int BM = 256, BK = 64, HALF = 128, HTB = HALF * BK * 2  , STAGE_BYTES = 8 * HTB, NXCD = 8, WGM = 8;

__host__ __device__ __forceinline__ int lds_byte(int r, int c) { const int st = (r >> 4) * 2 + (c >> 5), rr = r & 15, cc = c & 31, ob = rr * 64 + cc * 2; return st * 1024 + (ob ^ (((ob >> 9) & 1) << 5)); }
__host__ __device__ __forceinline__ void stage_rc(int b, int& R, int& C) { const int st = b / 1024, sb = b % 1024, swz = sb ^ (((sb >> 9) & 1) << 5); R = (st >> 1) * 16 + swz / 64; C = (st & 1) * 32 + (swz % 64) / 2; }
__host__ __device__ __forceinline__ int perm32(int rho) { const int n = rho >> 4, i = rho & 15; return 8 * (i >> 2) + 4 * n + (i & 3); }

struct Unit { int pm, pn, kt0, nkt, part; };
struct Gemm { const bf16_t* A; const bf16_t* Bt; int M, N, K; };

struct StaticOrder {
    int nM, nN, nwg, G, c, nkt_full;
    __host__ __device__ void init(int M, int N, int G_, int c_) { nM = M / BM; nN = N / BM; nwg = nM * nN; G = G_; c = c_; }
    __host__ __device__ bool next(int i, Unit& u) const {
        const long L = (long)i * G + c; if (L >= nwg) return false;
        int wgid = (int)L; { const int q = nwg / NXCD, r = nwg % NXCD, xcd = wgid % NXCD, off = wgid / NXCD; wgid = (xcd < r ? xcd * (q + 1) : r * (q + 1) + (xcd - r) * q) + off; }
        const int nig = WGM * nN, gid = wgid / nig, fm = gid * WGM, gsz = (nM - fm) < WGM ? (nM - fm) : WGM;
        u.pm = fm + ((wgid % nig) % gsz); u.pn = (wgid % nig) / gsz; u.kt0 = 0; u.nkt = nkt_full; u.part = -1; return true;
    }
    __device__ __forceinline__ void a_ready(const Unit&) const {}
    __device__ __forceinline__ void done(const Unit&) const {}
};
__device__ __forceinline__ unsigned cvt_pk_bf16(float lo, float hi) { unsigned r; asm volatile("v_cvt_pk_bf16_f32 %0, %1, %2" : "=v"(r) : "v"(lo), "v"(hi)); return r; }
typedef float f32x2 __attribute__((ext_vector_type(2)));
template <class Epi, class Sched, bool ALIGN_EPI = false, bool SP2 = false>
__device__ __forceinline__ void gemm_phase(PG8_LAS unsigned char* lds, const Gemm g, const Sched& S, const Epi& E) {
    int tid_ = threadIdx.x; asm volatile("" : "+v"(tid_)); const int tid = tid_, wid = __builtin_amdgcn_readfirstlane(tid >> 6), lane = tid & 63, wr = wid >> 2, wc = wid & 3, fr = lane & 15, fq = lane >> 4;
    const int K = g.K;
    unsigned voffA[2], voffB[2];
#pragma unroll
    for (int i = 0; i < 2; ++i) { int R, C; stage_rc(tid * 16 + i * 8192, R, C); const int Rb = Epi::PERM ? ((R & ~31) + perm32(R & 31)) : R;
        voffA[i] = (unsigned)(R * K + C) * 2u; voffB[i] = (unsigned)(Rb * K + C) * 2u; }
    const size_t kstep = (size_t)(BK * 2);
    const size_t hstep = (size_t)HALF * K * 2;
    const size_t tstep = 2 * hstep;
    const unsigned ldsw = (unsigned)wid * 1024u;
    const int aoff = lds_byte(wr * 64 + fr, fq * 8), boff = lds_byte(wc * 32 + fr, fq * 8);
#define PG8_SA(b, h) (((b) * 2 + (h)) * HTB)
#define PG8_SB(b, h) ((4 + (b) * 2 + (h)) * HTB)
#define PG8_STAGE(bufoff, gbase, voff) do { _Pragma("unroll") for (int _i = 0; _i < 2; ++_i) \
        __builtin_amdgcn_global_load_lds((const unsigned*)((const char*)(gbase) + (voff)[_i]), (PG8_LAS unsigned*)(lds + (bufoff) + ldsw + _i * 8192), 16, 0, 0); } while (0)
#define PG8_LDA(dst, b, h) do { _Pragma("unroll") for (int m = 0; m < 4; ++m) _Pragma("unroll") for (int k = 0; k < 2; ++k) dst[m][k] = *(const PG8_LAS bf16x8*)(lds + PG8_SA(b, h) + aoff + m * 2048 + k * 1024); } while (0)
#define PG8_LDB(dst, b, h) do { _Pragma("unroll") for (int n = 0; n < 2; ++n) _Pragma("unroll") for (int k = 0; k < 2; ++k) dst[n][k] = *(const PG8_LAS bf16x8*)(lds + PG8_SB(b, h) + boff + n * 2048 + k * 1024); } while (0)
#define PG8_MMA(ai, bj, At, Bt) do { __builtin_amdgcn_s_setprio(1); _Pragma("unroll") for (int m = 0; m < 4; ++m) _Pragma("unroll") for (int n = 0; n < 2; ++n) _Pragma("unroll") for (int k = 0; k < 2; ++k) \
        acc[ai][bj][m][n] = __builtin_amdgcn_mfma_f32_16x16x32_bf16(Bt[n][k], At[m][k], acc[ai][bj][m][n], 0, 0, 0); __builtin_amdgcn_s_setprio(0); } while (0)
#define PG8_WAIT_V(n) asm volatile("s_waitcnt vmcnt(" #n ")" ::: "memory")
#define PG8_WAIT_L(n) asm volatile("s_waitcnt lgkmcnt(" #n ")" ::: "memory")
#define PG8_BAR __builtin_amdgcn_s_barrier()
#define PG8_SCHED __builtin_amdgcn_sched_barrier(0)
    Unit cur, nxt; int ui = 0;
    if (!S.next(0, cur)) return;
    f32x4 acc[2][2][4][2];
#pragma unroll
    for (int a = 0; a < 2; ++a)
#pragma unroll
        for (int b = 0; b < 2; ++b)
#pragma unroll
            for (int m = 0; m < 4; ++m)
#pragma unroll
                for (int n = 0; n < 2; ++n) acc[a][b][m][n] = (f32x4){0.f, 0.f, 0.f, 0.f};
    bf16x8 At[4][2], B0[2][2], B1[2][2];
    const char* cA = (const char*)g.A + (size_t)cur.pm * tstep + (size_t)cur.kt0 * (BK * 2); const char* cB = (const char*)g.Bt + (size_t)cur.pn * tstep + (size_t)cur.kt0 * (BK * 2);
    S.a_ready(cur);
    if constexpr (SP2) {
        PG8_STAGE(PG8_SB(0, 0), cB, voffB); PG8_STAGE(PG8_SB(0, 1), cB + hstep, voffB); PG8_STAGE(PG8_SA(0, 0), cA, voffA); PG8_STAGE(PG8_SA(0, 1), cA + hstep, voffA);
        if (wr == 1) PG8_BAR;
        PG8_WAIT_V(2); PG8_BAR;
        PG8_STAGE(PG8_SB(1, 0), cB + kstep, voffB); PG8_STAGE(PG8_SA(1, 0), cA + kstep, voffA); PG8_STAGE(PG8_SB(1, 1), cB + hstep + kstep, voffB);
        PG8_WAIT_V(6); PG8_BAR;
    } else {
        PG8_STAGE(PG8_SB(0, 0), cB, voffB); PG8_STAGE(PG8_SA(0, 0), cA, voffA); PG8_STAGE(PG8_SB(0, 1), cB + hstep, voffB); PG8_STAGE(PG8_SA(0, 1), cA + hstep, voffA);
        if (wr == 1) PG8_BAR;
        PG8_WAIT_V(4); PG8_BAR;
        PG8_STAGE(PG8_SB(1, 0), cB + kstep, voffB); PG8_STAGE(PG8_SA(1, 0), cA + kstep, voffA); PG8_STAGE(PG8_SB(1, 1), cB + hstep + kstep, voffB);
        PG8_WAIT_V(6); PG8_BAR;
    }
    for (;;) {
        const bool has_next = S.next(ui + 1, nxt);
        const char* nA = has_next ? (const char*)g.A + (size_t)nxt.pm * tstep + (size_t)nxt.kt0 * (BK * 2) : cA; const char* nB = has_next ? (const char*)g.Bt + (size_t)nxt.pn * tstep + (size_t)nxt.kt0 * (BK * 2) : cB;
        const int nt = cur.nkt;
        for (int t = 0; t < nt; t += 2) {
            const bool last = (t == nt - 2);
            const char* a1 = cA + (size_t)(t + 1) * kstep;
            const char* a2 = last ? nA : cA + (size_t)(t + 2) * kstep; const char* b2 = last ? nB : cB + (size_t)(t + 2) * kstep;
            const char* a3 = a2 + kstep; const char* b3 = b2 + kstep;
            if (last && has_next) S.a_ready(nxt);
            if constexpr (SP2) {
            PG8_LDB(B0, 0, 0); PG8_LDB(B1, 0, 1); PG8_SCHED; PG8_LDA(At, 0, 0); PG8_STAGE(PG8_SA(1, 1), a1 + hstep, voffA);
            PG8_WAIT_V(8); PG8_WAIT_L(0); PG8_BAR; PG8_MMA(0, 0, At, B0); PG8_MMA(0, 1, At, B1); PG8_BAR; PG8_SCHED;
            PG8_LDA(At, 0, 1); PG8_STAGE(PG8_SB(0, 0), b2, voffB); PG8_STAGE(PG8_SB(0, 1), b2 + hstep, voffB); PG8_STAGE(PG8_SA(0, 0), a2, voffA);
            PG8_WAIT_V(8); PG8_WAIT_L(0); PG8_BAR; PG8_MMA(1, 0, At, B0); PG8_MMA(1, 1, At, B1); PG8_BAR; PG8_SCHED;
            PG8_LDB(B0, 1, 0); PG8_LDB(B1, 1, 1); PG8_SCHED; PG8_LDA(At, 1, 0); PG8_STAGE(PG8_SA(0, 1), a2 + hstep, voffA);
            PG8_WAIT_V(8); PG8_WAIT_L(0); PG8_BAR; PG8_MMA(0, 0, At, B0); PG8_MMA(0, 1, At, B1); PG8_BAR; PG8_SCHED;
            PG8_LDA(At, 1, 1); PG8_STAGE(PG8_SB(1, 0), b3, voffB); PG8_STAGE(PG8_SB(1, 1), b3 + hstep, voffB); PG8_STAGE(PG8_SA(1, 0), a3, voffA);
            PG8_WAIT_V(8); PG8_WAIT_L(0); PG8_BAR; PG8_MMA(1, 0, At, B0); PG8_MMA(1, 1, At, B1); PG8_BAR; PG8_SCHED;
            } else {
            PG8_LDB(B0, 0, 0); PG8_SCHED; PG8_LDA(At, 0, 0); PG8_STAGE(PG8_SA(1, 1), a1 + hstep, voffA);
            PG8_WAIT_L(8); PG8_BAR; PG8_WAIT_L(0); PG8_MMA(0, 0, At, B0); PG8_BAR; PG8_SCHED;
            PG8_LDB(B1, 0, 1); PG8_STAGE(PG8_SB(0, 0), b2, voffB);
            PG8_BAR; PG8_WAIT_L(0); PG8_MMA(0, 1, At, B1); PG8_BAR;
            PG8_LDA(At, 0, 1); PG8_STAGE(PG8_SA(0, 0), a2, voffA);
            PG8_BAR; PG8_WAIT_L(0); PG8_MMA(1, 0, At, B0); PG8_BAR; PG8_SCHED;
            PG8_STAGE(PG8_SB(0, 1), b2 + hstep, voffB);
            PG8_WAIT_V(6); PG8_BAR; PG8_MMA(1, 1, At, B1); PG8_BAR;
            PG8_LDB(B0, 1, 0); PG8_SCHED; PG8_LDA(At, 1, 0); PG8_STAGE(PG8_SA(0, 1), a2 + hstep, voffA);
            PG8_WAIT_L(8); PG8_BAR; PG8_WAIT_L(0); PG8_MMA(0, 0, At, B0); PG8_BAR; PG8_SCHED;
            PG8_LDB(B1, 1, 1); PG8_STAGE(PG8_SB(1, 0), b3, voffB);
            PG8_BAR; PG8_WAIT_L(0); PG8_MMA(0, 1, At, B1); PG8_BAR;
            PG8_LDA(At, 1, 1); PG8_STAGE(PG8_SA(1, 0), a3, voffA);
            PG8_BAR; PG8_WAIT_L(0); PG8_MMA(1, 0, At, B0); PG8_BAR; PG8_SCHED;
            PG8_STAGE(PG8_SB(1, 1), b3 + hstep, voffB);
            PG8_WAIT_V(6); PG8_BAR; PG8_MMA(1, 1, At, B1); PG8_BAR;
            }
        }
        if constexpr (ALIGN_EPI) { if (wr == 0) PG8_BAR; }
        if constexpr (!Epi::AFTER_DRAIN) { E(acc, cur, wr, wc, fr, fq); S.done(cur); }
        if (!has_next) break;
#pragma unroll
        for (int a = 0; a < 2; ++a)
#pragma unroll
            for (int b = 0; b < 2; ++b)
#pragma unroll
                for (int m = 0; m < 4; ++m)
#pragma unroll
                    for (int n = 0; n < 2; ++n) acc[a][b][m][n] = (f32x4){0.f, 0.f, 0.f, 0.f};
        cur = nxt; cA = nA; cB = nB; ++ui;
        if constexpr (ALIGN_EPI) { if (wr == 1) PG8_BAR; }
    }
    PG8_WAIT_V(0);
    if constexpr (!ALIGN_EPI) { if (wr == 0) PG8_BAR; }
    PG8_BAR;
    if constexpr (Epi::AFTER_DRAIN) { E.fused(acc, cur, wr, wc, fr, fq, lds, wid, lane); S.done(cur); }
#undef PG8_SA
#undef PG8_SB
#undef PG8_STAGE
#undef PG8_LDA
#undef PG8_LDB
#undef PG8_MMA
#undef PG8_WAIT_V
#undef PG8_WAIT_L
#undef PG8_BAR
#undef PG8_SCHED
}
}

constexpr int DM = 1024, NBATCH = 8, SEQ = 2048, CTXL = 256, DFF = 2816, NHEAD = 8;
constexpr int TL = NBATCH * SEQ;
constexpr int TC = NBATCH * CTXL;
constexpr int TT = TL + TC;
constexpr int KVN = SEQ + CTXL;
constexpr int NMODW = 9 * DM;
constexpr float C2 = 0.125f * 1.4426950408889634f;

constexpr size_t MiB = (size_t)1 << 20;
constexpr size_t OFF_MOD = 0;
constexpr size_t OFF_ROPE = 1536 * 1024;
constexpr size_t OFF_BAR = 1792 * 1024;
constexpr size_t OFF_WSS = 3 * MiB;
constexpr size_t OFF_WGU = 4 * MiB;
constexpr size_t OFF_WDN = OFF_WGU + 88 * MiB;
constexpr size_t OFF_WINA = OFF_WDN + 44 * MiB;
constexpr size_t OFF_WOUTA = OFF_WINA + 12 * MiB;
constexpr size_t OFF_WINS = OFF_WOUTA + 4 * MiB;
constexpr size_t OFF_WOUTS = OFF_WINS + 8 * MiB;
constexpr size_t OFF_H = OFF_WOUTS + 4 * MiB;
constexpr size_t OFF_XN = OFF_H + 72 * MiB;
constexpr size_t OFF_BIG = OFF_XN + 36 * MiB;
constexpr size_t OFF_PART = OFF_BIG + 108 * MiB;
constexpr size_t OFF_SGST2 = OFF_PART + 64 * MiB;
constexpr size_t WS_NEED = OFF_SGST2 + 6 * MiB;
constexpr size_t SZ_TOK = (size_t)TT * DM * 2;

#define LAS __attribute__((address_space(3)))
typedef unsigned short bf16;
typedef unsigned v4u __attribute__((ext_vector_type(4)));
typedef unsigned v2u __attribute__((ext_vector_type(2)));
typedef float f32x4 __attribute__((ext_vector_type(4)));
typedef float f32x16 __attribute__((ext_vector_type(16)));
typedef short bf16x8 __attribute__((ext_vector_type(8)));
typedef float f32x2_t __attribute__((ext_vector_type(2)));
typedef __bf16 bf16x2_t __attribute__((ext_vector_type(2)));

__device__ __forceinline__ unsigned pk2(float lo, float hi) { f32x2_t v = {lo, hi}; bf16x2_t b = __builtin_convertvector(v, bf16x2_t); return __builtin_bit_cast(unsigned, b); }
__device__ __forceinline__ bf16 f2bf(float f) { return (bf16)(pk2(f, 0.f) & 0xffffu); }
__device__ __forceinline__ float bf2f(unsigned b) { return __uint_as_float(b << 16); }
__device__ __forceinline__ f32x4 ldh4(const bf16* p) { const v2u r = *(const v2u*)p; return (f32x4){bf2f(r.x & 0xffffu), bf2f(r.x >> 16), bf2f(r.y & 0xffffu), bf2f(r.y >> 16)}; }
__device__ __forceinline__ void sth4(bf16* p, f32x4 v) { v2u w; w.x = pk2(v[0], v[1]); w.y = pk2(v[2], v[3]); *(v2u*)p = w; }
__device__ __forceinline__ float wave_sum(float v) {
#pragma unroll
    for (int o = 1; o < 64; o <<= 1) v += __shfl_xor(v, o);
    return v;
}
__device__ __forceinline__ float xhalf_max(float m) { auto rr = __builtin_amdgcn_permlane32_swap(__float_as_uint(m), __float_as_uint(m), false, false); return fmaxf(__uint_as_float(rr[0]), __uint_as_float(rr[1])); }
__device__ __forceinline__ float xhalf_sum(float m) { auto rr = __builtin_amdgcn_permlane32_swap(__float_as_uint(m), __float_as_uint(m), false, false); return __uint_as_float(rr[0]) + __uint_as_float(rr[1]); }
__device__ __forceinline__ float max3f(float a, float b, float c) { float r; asm("v_max3_f32 %0, %1, %2, %3" : "=v"(r) : "v"(a), "v"(b), "v"(c)); return r; }
__device__ __forceinline__ float fast_exp2(float x) { return __builtin_amdgcn_exp2f(x); }
__device__ __forceinline__ float fast_rcp(float x) { return __builtin_amdgcn_rcpf(x); }
__device__ __forceinline__ float silu_f(float a) { return a * fast_rcp(1.0f + fast_exp2(-1.4426950408889634f * a)); }
__device__ __forceinline__ float gelu_tanh_f(float x) { const float u = x + 0.044715f * x * x * x; return x * fast_rcp(1.0f + fast_exp2(-2.302208198f * u)); }
__device__ __forceinline__ int crow(int i, int h) { return (i & 3) + 8 * (i >> 2) + 4 * h; }
#define MFMA32(a, b, c) __builtin_amdgcn_mfma_f32_32x32x16_bf16((a), (b), (c), 0, 0, 0)

using pg8::Unit;
struct SplitOrder {
    pg8::StaticOrder lat; int G, c, nsl, nkt;
    __device__ __forceinline__ void init(int nsl_, int nkt_, int G_, int c_) { lat.init(TL, DM, G_, c_); lat.nkt_full = nkt_; G = G_; c = c_; nsl = nsl_; nkt = nkt_; }
    __device__ __forceinline__ bool next(int i, Unit& u) const {
        const int nrl = (256 + G - 1) / G;
        if (i < nrl) { if (lat.next(i, u)) return true; }
        const int q = (i - nrl) * G + c;
        if (i < nrl || q >= 32 * nsl) return false;
        const int tctx = q / nsl, sl = q % nsl, pairs = nkt >> 1, base = pairs / nsl, rem = pairs % nsl;
        u.pm = 64 + (tctx >> 2); u.pn = tctx & 3; u.kt0 = 2 * (sl * base + (sl < rem ? sl : rem)); u.nkt = 2 * (base + (sl < rem ? 1 : 0)); u.part = q; return true;
    }
    __device__ __forceinline__ void a_ready(const Unit&) const {}
    __device__ __forceinline__ void done(const Unit&) const {}
};
struct EpiSwiGLU {
    static constexpr bool PERM = true, AFTER_DRAIN = false;
    bf16* O;
    __device__ __forceinline__ void operator()(const f32x4 (&acc)[2][2][4][2], const Unit& u, int wr, int wc, int fr, int fq) const {
        const int row0 = u.pm * 256 + wr * 64 + fr, col0 = u.pn * 128 + wc * 32 + 8 * fq;
#pragma unroll
        for (int ai = 0; ai < 2; ++ai)
#pragma unroll
            for (int m = 0; m < 4; ++m) {
                bf16* p = O + (size_t)(row0 + ai * 128 + m * 16) * DFF + col0;
                const f32x4 a0 = acc[ai][0][m][0], a1 = acc[ai][0][m][1], u0 = acc[ai][1][m][0], u1 = acc[ai][1][m][1];
                v4u w;
                w.x = pk2(silu_f(a0[0]) * u0[0], silu_f(a0[1]) * u0[1]); w.y = pk2(silu_f(a0[2]) * u0[2], silu_f(a0[3]) * u0[3]);
                w.z = pk2(silu_f(a1[0]) * u1[0], silu_f(a1[1]) * u1[1]); w.w = pk2(silu_f(a1[2]) * u1[2], silu_f(a1[3]) * u1[3]);
                *(v4u*)p = w;
            }
    }
};
struct EpiResid {
    static constexpr bool PERM = true, AFTER_DRAIN = false;
    unsigned char* ws; const float* gate; int half;
    __device__ __forceinline__ void operator()(const f32x4 (&acc)[2][2][4][2], const Unit& u, int wr, int wc, int fr, int fq) const {
        bf16* H = (bf16*)(ws + OFF_H); bf16* part = (bf16*)(ws + OFF_PART); const float coef = half ? 0.5f : 1.0f;
        if (u.part >= 0) {
            bf16* pp = part + (size_t)u.part * 65536 + (size_t)(wr * 64 + fr) * 256 + wc * 32 + 8 * fq;
#pragma unroll
            for (int ai = 0; ai < 2; ++ai)
#pragma unroll
                for (int m = 0; m < 4; ++m)
#pragma unroll
                    for (int bj = 0; bj < 2; ++bj) {
                        const f32x4 x0 = acc[ai][bj][m][0], x1 = acc[ai][bj][m][1];
                        v4u w; w.x = pk2(x0[0], x0[1]); w.y = pk2(x0[2], x0[3]); w.z = pk2(x1[0], x1[1]); w.w = pk2(x1[2], x1[3]);
                        *(v4u*)(pp + (size_t)(ai * 128 + m * 16) * 256 + bj * 128) = w;
                    }
            return;
        }
        const int b9 = u.pm < 64 ? (u.pm >> 3) : 8;
        const float* gp = gate + (size_t)b9 * NMODW;
        const int row0 = u.pm * 256 + wr * 64 + fr;
#pragma unroll
        for (int bj = 0; bj < 2; ++bj) {
            const int col = u.pn * 256 + bj * 128 + wc * 32 + 8 * fq;
            const f32x4 gv0 = *(const f32x4*)(gp + col) * coef, gv1 = *(const f32x4*)(gp + col + 4) * coef;
            v4u h[2][4];
#pragma unroll
            for (int ai = 0; ai < 2; ++ai)
#pragma unroll
                for (int m = 0; m < 4; ++m) h[ai][m] = *(const v4u*)(H + (size_t)(row0 + ai * 128 + m * 16) * DM + col);
#pragma unroll
            for (int ai = 0; ai < 2; ++ai)
#pragma unroll
                for (int m = 0; m < 4; ++m) {
                    const v4u r = h[ai][m];
                    const f32x4 h0 = (f32x4){bf2f(r.x & 0xffffu), bf2f(r.x >> 16), bf2f(r.y & 0xffffu), bf2f(r.y >> 16)};
                    const f32x4 h1 = (f32x4){bf2f(r.z & 0xffffu), bf2f(r.z >> 16), bf2f(r.w & 0xffffu), bf2f(r.w >> 16)};
                    const f32x4 y0 = h0 + gv0 * acc[ai][bj][m][0], y1 = h1 + gv1 * acc[ai][bj][m][1];
                    v4u w; w.x = pk2(y0[0], y0[1]); w.y = pk2(y0[2], y0[3]); w.z = pk2(y1[0], y1[1]); w.w = pk2(y1[2], y1[3]);
                    *(v4u*)(H + (size_t)(row0 + ai * 128 + m * 16) * DM + col) = w;
                }
        }
    }
};
constexpr int XP_OFF = 131072 + 2048, XP_WAVE = 16 * 144;
__device__ __forceinline__ void xpose_write(LAS unsigned char* xl, const f32x4& v, int m, int rpos, int fq) {
#pragma unroll
    for (int i = 0; i < 4; ++i) *(LAS bf16*)(xl + (4 * fq + i) * 144 + (16 * m + rpos) * 2) = f2bf(v[i]);
}
__device__ __forceinline__ void xpose_flush(LAS unsigned char* xl, int lane, bf16* gbase, size_t colstride) {
    asm volatile("s_waitcnt lgkmcnt(0)" ::: "memory");
    const int c = lane >> 2, q = lane & 3;
    const v4u a = *(const LAS v4u*)(xl + c * 144 + q * 32), b = *(const LAS v4u*)(xl + c * 144 + q * 32 + 16);
    asm volatile("s_waitcnt lgkmcnt(0)" ::: "memory");
    bf16* p = gbase + (size_t)c * colstride + 16 * q;
    *(v4u*)p = a; *(v4u*)(p + 8) = b;
}
struct EpiQKV {
    static constexpr bool PERM = false, AFTER_DRAIN = false;
    bf16* Q; bf16* K; bf16* Vt; const float* rope; LAS unsigned char* xp;
    __device__ __forceinline__ void operator()(const f32x4 (&acc)[2][2][4][2], const Unit& u, int wr, int wc, int fr, int fq) const {
        const int sect = u.pn >> 2, ct = (u.pn & 3) * 256;
        const bool latent = u.pm < 64;
        if (sect < 2) {
            bf16* base = sect == 0 ? Q : K; const float sc = sect == 0 ? C2 : 1.0f;
            const int axis = wc & 1;
            f32x4 csv[2][4], snv[2][4];
#pragma unroll
            for (int ai = 0; ai < 2; ++ai)
#pragma unroll
                for (int m = 0; m < 4; ++m) {
                    const int row = u.pm * 256 + ai * 128 + wr * 64 + m * 16 + fr;
                    csv[ai][m] = (f32x4){1.f, 1.f, 1.f, 1.f}; snv[ai][m] = (f32x4){0.f, 0.f, 0.f, 0.f};
                    if (latent) { const int s = row & 2047; const int pos = axis ? (s & 63) : (s >> 6); csv[ai][m] = *(const f32x4*)(rope + pos * 32 + 4 * fq); snv[ai][m] = *(const f32x4*)(rope + pos * 32 + 16 + 4 * fq); }
                }
#pragma unroll
            for (int ai = 0; ai < 2; ++ai)
#pragma unroll
                for (int m = 0; m < 4; ++m) {
                    const int row = u.pm * 256 + ai * 128 + wr * 64 + m * 16 + fr;
                    const f32x4 cs = csv[ai][m], sn = snv[ai][m];
#pragma unroll
                    for (int bj = 0; bj < 2; ++bj) {
                        const f32x4 x1 = acc[ai][bj][m][0], x2 = acc[ai][bj][m][1];
                        const f32x4 o1 = (x1 * cs - x2 * sn) * sc, o2 = (x2 * cs + x1 * sn) * sc;
                        bf16* p = base + (size_t)row * DM + ct + bj * 128 + wc * 32 + 8 * fq;
                        v4u w; w.x = pk2(o1[0], o1[1]); w.y = pk2(o1[2], o1[3]); w.z = pk2(o2[0], o2[1]); w.w = pk2(o2[2], o2[3]);
                        *(v4u*)p = w;
                    }
                }
        } else {
            const int swz = (fr & 3) | ((fr & 4) << 1) | ((fr & 8) >> 1);
            const int lane = fq * 16 + fr;
            LAS unsigned char* xl = xp + (wr * 4 + wc) * XP_WAVE;
#pragma unroll
            for (int ai = 0; ai < 2; ++ai) {
                const int rowblk = u.pm * 256 + ai * 128 + wr * 64;
                int b, kv0; if (latent) { b = rowblk >> 11; kv0 = rowblk & 2047; } else { const int rr = rowblk - TL; b = rr >> 8; kv0 = SEQ + (rr & 255); }
#pragma unroll
                for (int bj = 0; bj < 2; ++bj) {
                    const int hd = (u.pn - 8) * 2 + bj;
#pragma unroll
                    for (int n = 0; n < 2; ++n)
                    {
#pragma unroll
                        for (int m = 0; m < 4; ++m) xpose_write(xl, acc[ai][bj][m][n], m, swz, fq);
                        xpose_flush(xl, lane, Vt + ((size_t)(b * NHEAD + hd) * 128 + wc * 32 + n * 16) * KVN + kv0, (size_t)KVN);
                    }
                }
            }
        }
    }
};
struct EpiSG {
    static constexpr bool PERM = false, AFTER_DRAIN = false;
    bf16* ZU; bf16* ZVT; float* stats;
    __device__ __forceinline__ void operator()(const f32x4 (&acc)[2][2][4][2], const Unit& u, int wr, int wc, int fr, int fq) const {
        const int sect = u.pn >> 2, ct = (u.pn & 3) * 256;
#pragma unroll
        for (int ai = 0; ai < 2; ++ai)
#pragma unroll
            for (int m = 0; m < 4; ++m) {
                const int row = u.pm * 256 + ai * 128 + wr * 64 + m * 16 + fr;
                if (sect == 0) {
#pragma unroll
                    for (int bj = 0; bj < 2; ++bj)
#pragma unroll
                        for (int n = 0; n < 2; ++n) {
                            const f32x4 x = acc[ai][bj][m][n];
                            v2u w; w.x = pk2(gelu_tanh_f(x[0]), gelu_tanh_f(x[1])); w.y = pk2(gelu_tanh_f(x[2]), gelu_tanh_f(x[3]));
                            *(v2u*)(ZU + (size_t)row * DM + ct + bj * 128 + wc * 32 + n * 16 + 4 * fq) = w;
                        }
                } else {
                    const int chunk = row >> 7, s = row & 127;
                    float s1 = 0.f, s2 = 0.f;
#pragma unroll
                    for (int bj = 0; bj < 2; ++bj)
#pragma unroll
                        for (int n = 0; n < 2; ++n)
#pragma unroll
                            for (int i = 0; i < 4; ++i) {
                                const float z = gelu_tanh_f(acc[ai][bj][m][n][i]);
                                s1 += z; s2 += z * z;
                                const int c = ct + bj * 128 + wc * 32 + n * 16 + 4 * fq + i;
                                ZVT[((size_t)chunk * DM + c) * 128 + s] = f2bf(z);
                            }
                    s1 += __shfl_xor(s1, 16); s1 += __shfl_xor(s1, 32);
                    s2 += __shfl_xor(s2, 16); s2 += __shfl_xor(s2, 32);
                    if (fq == 0) { float* sp = stats + ((size_t)row * 16 + (u.pn - 4) * 4 + wc) * 2; sp[0] = s1; sp[1] = s2; }
                }
            }
    }
};

template <class T> __device__ __forceinline__ T* as_global(T* p) { return (T*)(__attribute__((address_space(1))) T*)p; }
#define GAS __attribute__((address_space(1)))
struct Args { GAS const float* in_[20]; GAS float* out_; GAS unsigned char* ws_; };
typedef __attribute__((address_space(4))) const Args CArgs;
struct ArgView { CArgs* p;
    __device__ __forceinline__ const float* in(int i) const { return (const float*)p->in_[i]; }
    __device__ __forceinline__ float* out() const { return (float*)p->out_; }
    __device__ __forceinline__ unsigned char* ws() const { return (unsigned char*)p->ws_; } };
enum { I_X = 0, I_C, I_CTX, I_CCTX, I_WMOD, I_BMOD, I_NORMG, I_WGU, I_WDN, I_DAIN, I_DAOUT, I_DALAM, I_DASUB, I_SGIN, I_SGLNG, I_SGLNB, I_SGWS, I_SGBS, I_SGOUT, I_FINALG };

__device__ __forceinline__ ArgView get_args() { CArgs* p = (CArgs*)__builtin_amdgcn_kernarg_segment_ptr(); asm volatile("" : "+s"(p)); ArgView v; v.p = p; return v; }
__device__ __forceinline__ void transpose_item(const float* W, int K, int N, bf16* WT, int k0, int n0, int drow0, LAS float* scr, int lane) {
    float rv[32];
#pragma unroll
    for (int i = 0; i < 32; ++i) rv[i] = W[(size_t)(k0 + 2 * i + (lane >> 5)) * N + n0 + (lane & 31)];
#pragma unroll
    for (int i = 0; i < 32; ++i) scr[(2 * i + (lane >> 5)) * 33 + (lane & 31)] = rv[i];
    asm volatile("s_waitcnt lgkmcnt(0)" ::: "memory");
    const int c = lane & 7;
#pragma unroll
    for (int j = 0; j < 4; ++j) { const int n = (lane >> 3) + 8 * j; const LAS float* s = scr + (8 * c) * 33 + n;
        v4u o; o.x = pk2(s[0 * 33], s[1 * 33]); o.y = pk2(s[2 * 33], s[3 * 33]); o.z = pk2(s[4 * 33], s[5 * 33]); o.w = pk2(s[6 * 33], s[7 * 33]);
        *(v4u*)(WT + (size_t)(drow0 + n) * K + k0 + 8 * c) = o; }
    asm volatile("s_waitcnt lgkmcnt(0)" ::: "memory");
}

__device__ __forceinline__ int conv_layer_count(int L) { return (L & 1) ? 9984 : 10496; }
__device__ __forceinline__ int conv_idle(int nwg, int G) { return (nwg % G) ? G - nwg % G : 0; }
__device__ __forceinline__ int conv_idle_phase(int l, int which, int G) {
    if (l > 2) return 0;
    if (which == 0) return conv_idle((TT / 256) * 22, G);
    if (which == 1) return conv_idle((TT / 256) * ((l & 1) ? 8 : 12), G);
    return conv_idle(((l < 2 ? TT : TL) / 256) * 22, G);
}
__device__ __forceinline__ int conv_idle_total(int l, int G) { return conv_idle_phase(l, 0, G) + conv_idle_phase(l, 1, G) + conv_idle_phase(l, 2, G); }
__device__ __forceinline__ void conv_layer_items(const ArgView& a, unsigned char* ws, int L, int first, int last, int w, int W, LAS float* scr, int lane) {
    constexpr int I_GU = 16 * 176, I_DN = 44 * 32, I_AIN = 16 * 96, I_SQ = 16 * 32, I_SIN = 16 * 64;
    const int j = L >> 1;
    for (int it = first + w; it < last; it += W) {
        if (it < 2 * I_GU) { const int mi = 2 * L + it / I_GU, r = it % I_GU, kb = r / 176, nb = r % 176; const int n0 = nb * 32; const int jj = n0 < DFF ? n0 : n0 - DFF; const int half = n0 < DFF ? 0 : 1;
            transpose_item(a.in(I_WGU) + (size_t)mi * DM * 2 * DFF, DM, 2 * DFF, (bf16*)(ws + OFF_WGU) + (size_t)mi * 2 * DFF * DM, kb * 64, n0, 256 * (jj >> 7) + 128 * half + (jj & 127), scr, lane); }
        else if (it < 2 * I_GU + 2 * I_DN) { const int q = it - 2 * I_GU, mi = 2 * L + q / I_DN, r = q % I_DN, kb = r / 32, nb = r % 32;
            transpose_item(a.in(I_WDN) + (size_t)mi * DFF * DM, DFF, DM, (bf16*)(ws + OFF_WDN) + (size_t)mi * DM * DFF, kb * 64, nb * 32, nb * 32, scr, lane); }
        else if ((L & 1) == 0) { const int q = it - 2 * I_GU - 2 * I_DN;
            if (q < I_AIN) { const int kb = q / 96, nb = q % 96;
                transpose_item(a.in(I_DAIN) + (size_t)j * DM * 3 * DM, DM, 3 * DM, (bf16*)(ws + OFF_WINA) + (size_t)j * 3 * DM * DM, kb * 64, nb * 32, nb * 32, scr, lane); }
            else { const int r = q - I_AIN, kb = r / 32, nb = r % 32;
                transpose_item(a.in(I_DAOUT) + (size_t)j * DM * DM, DM, DM, (bf16*)(ws + OFF_WOUTA) + (size_t)j * DM * DM, kb * 64, nb * 32, nb * 32, scr, lane); } }
        else { const int q = it - 2 * I_GU - 2 * I_DN;
            if (q < I_SIN) { const int kb = q / 64, nb = q % 64;
                transpose_item(a.in(I_SGIN) + (size_t)j * DM * 2 * DM, DM, 2 * DM, (bf16*)(ws + OFF_WINS) + (size_t)j * 2 * DM * DM, kb * 64, nb * 32, nb * 32, scr, lane); }
            else { const int r = q - I_SIN, kb = r / 32, nb = r % 32;
                transpose_item(a.in(I_SGOUT) + (size_t)j * DM * DM, DM, DM, (bf16*)(ws + OFF_WOUTS) + (size_t)j * DM * DM, kb * 64, nb * 32, nb * 32, scr, lane); } }
    }
}
__device__ __forceinline__ void prologue(LAS unsigned char* lds, int blk, int G, int tid) {
    const int lane = tid & 63, wave = tid >> 6;
    const ArgView a = get_args();
    unsigned char* ws = a.ws();
    {
        LAS float* sc = (LAS float*)lds; LAS float* red = sc + 9 * DM;
        for (int i = tid; i < 9 * DM; i += 512) { const int b = i >> 10, k = i & 1023; const float v = b < 8 ? a.in(I_C)[b * DM + k] : a.in(I_CCTX)[k]; sc[i] = v / (1.0f + __expf(-v)); }
        __syncthreads();
        float* MOD = (float*)(ws + OFF_MOD);
        LAS float* red4 = sc + 9 * DM;
        for (int it = blk; it < 4 * 36; it += G) {
            const int l = it / 36, n0 = (it % 36) * 256, kp = tid >> 6, ln = tid & 63;
            const float* wp = a.in(I_WMOD) + ((size_t)l * DM + kp * 128) * NMODW + n0 + 4 * ln;
            f32x4 a0 = {0.f, 0.f, 0.f, 0.f}, a1 = a0, a2 = a0, a3 = a0, a4 = a0, a5 = a0, a6 = a0, a7 = a0, a8 = a0;
            const LAS float* sp = sc + kp * 128;
#pragma unroll 2
            for (int kk = 0; kk < 128; kk += 4) {
                const f32x4 w0 = *(const f32x4*)(wp + (size_t)kk * NMODW), w1 = *(const f32x4*)(wp + (size_t)(kk + 1) * NMODW), w2 = *(const f32x4*)(wp + (size_t)(kk + 2) * NMODW), w3 = *(const f32x4*)(wp + (size_t)(kk + 3) * NMODW);
#define MOD_ACC(ab, b) do { const f32x4 s_ = *(const LAS f32x4*)(sp + (b) * DM + kk); ab += w0 * s_[0] + w1 * s_[1] + w2 * s_[2] + w3 * s_[3]; } while (0)
                MOD_ACC(a0, 0); MOD_ACC(a1, 1); MOD_ACC(a2, 2); MOD_ACC(a3, 3); MOD_ACC(a4, 4); MOD_ACC(a5, 5); MOD_ACC(a6, 6); MOD_ACC(a7, 7); MOD_ACC(a8, 8);
#undef MOD_ACC
            }
            LAS f32x4* rp = (LAS f32x4*)(red4 + (size_t)kp * 9 * 256) + ln;
            rp[0] = a0; rp[64] = a1; rp[128] = a2; rp[192] = a3; rp[256] = a4; rp[320] = a5; rp[384] = a6; rp[448] = a7; rp[512] = a8;
            __syncthreads();
            for (int o = tid; o < 9 * 256; o += 512) {
                const int b = o >> 8, cc = o & 255; float s = 0.f;
#pragma unroll
                for (int k8 = 0; k8 < 8; ++k8) s += red4[(k8 * 9 + b) * 256 + cc];
                MOD[(size_t)(l * 9 + b) * NMODW + n0 + cc] = s + a.in(I_BMOD)[l * NMODW + n0 + cc];
            }
            __syncthreads();
        }
    }
#ifdef PROBE_XMASK
    if (tid == 0) { LAS unsigned* pacc_ = (LAS unsigned*)(lds + 131072 + 1024); const unsigned t_ = (unsigned)__builtin_amdgcn_s_memrealtime(); pacc_[10] += t_ - pacc_[16]; pacc_[16] = t_; }
#endif
    if (blk == G - 1) {
        float* rope = (float*)(ws + OFF_ROPE);
        for (int idx = tid; idx < 64 * 16; idx += 512) {
            const int pos = idx >> 4, f = idx & 15;
            const float inv = exp2f(-(float)f * 0.8304820237218406f);
            const float ang = (float)pos * inv;
            const double x = (double)ang; const double kq = rint(x * 0.15915494309189535); const double r = x - kq * 6.283185307179586476925;
            const double r2 = r * r; double ts = r, tc = 1.0, ss = r, cc = 1.0;
            for (int n = 1; n <= 16; ++n) { tc *= -r2 / (double)((2 * n - 1) * (2 * n)); ts *= -r2 / (double)((2 * n) * (2 * n + 1)); cc += tc; ss += ts; }
            rope[pos * 32 + f] = (float)cc; rope[pos * 32 + 16 + f] = (float)ss;
        }
    }
    {
        const int gt = blk * 512 + tid, NT = G * 512;
        bf16* wss = (bf16*)(ws + OFF_WSS);
        for (int i = gt; i < 2 * 8 * 128 * 128; i += NT) wss[i] = f2bf(a.in(I_SGWS)[i]);
    }
    __syncthreads();
    {
        LAS float* scr = (LAS float*)(lds + wave * 16384);
        for (int L = 0; L < 4; ++L)
            if (L == 0 || conv_idle_total(L - 1, G) == 0) {
                if (G > 4 * 36 + 32) { if (blk >= 4 * 36) conv_layer_items(a, ws, L, 0, conv_layer_count(L), (blk - 4 * 36) * 8 + wave, (G - 4 * 36) * 8, scr, lane); }
                else conv_layer_items(a, ws, L, 0, conv_layer_count(L), blk * 8 + wave, G * 8, scr, lane);
            }
    }
#ifdef PROBE_XMASK
    __syncthreads();
    if (tid == 0) { LAS unsigned* pacc_ = (LAS unsigned*)(lds + 131072 + 1024); const unsigned t_ = (unsigned)__builtin_amdgcn_s_memrealtime(); pacc_[11] += t_ - pacc_[16]; pacc_[16] = t_; }
#endif
}

template <bool INIT>
__device__ __forceinline__ void norm_phase(const float* x_lat, const float* x_ctx, bf16* H, bf16* XN, const float* g, const float* modl, int ishift, int iscale, int Mrows, int gw, int NGW, int lane,
                                           const bf16* part, int nsl, const float* pgate, float pcoef) {
    const int rpw = (TL + NGW - 1) / NGW;
    f32x4 gs[4], sh[4]; int curb = -1;
    constexpr int R = 4;
    for (int i0 = 0; i0 < rpw; i0 += R) {
        f32x4 v[R][4]; float ss[R];
#pragma unroll
        for (int q = 0; q < R; ++q) {
            int row = gw * rpw + i0 + q; if (i0 + q >= rpw || row >= TL) row = gw * rpw < TL ? gw * rpw : 0;
#pragma unroll
            for (int j = 0; j < 4; ++j) v[q][j] = INIT ? ((const f32x4*)(x_lat + (size_t)row * DM))[lane + 64 * j] : ldh4(H + (size_t)row * DM + 4 * lane + 256 * j);
        }
#pragma unroll
        for (int q = 0; q < R; ++q) { float s = 0.f;
#pragma unroll
            for (int j = 0; j < 4; ++j) s += (v[q][j][0] * v[q][j][0] + v[q][j][1] * v[q][j][1]) + (v[q][j][2] * v[q][j][2] + v[q][j][3] * v[q][j][3]);
            ss[q] = s; }
#pragma unroll
        for (int o = 1; o < 64; o <<= 1) {
#pragma unroll
            for (int q = 0; q < R; ++q) ss[q] += __shfl_xor(ss[q], o);
        }
#pragma unroll
        for (int q = 0; q < R; ++q) {
            const int row = gw * rpw + i0 + q;
            if (i0 + q < rpw && row < TL) {
                const int b9 = row >> 11;
                if (b9 != curb) { curb = b9; const float* mp = modl + (size_t)b9 * NMODW;
#pragma unroll
                    for (int j = 0; j < 4; ++j) { const int col = 4 * lane + 256 * j; gs[j] = *(const f32x4*)(g + col) * (*(const f32x4*)(mp + iscale * DM + col) + 1.0f); sh[j] = *(const f32x4*)(mp + ishift * DM + col); } }
                const float rstd = 1.0f / sqrtf(ss[q] * (1.0f / DM) + 1e-6f);
#pragma unroll
                for (int j = 0; j < 4; ++j) {
                    const int col = 4 * lane + 256 * j;
                    const f32x4 y = (v[q][j] * rstd) * gs[j] + sh[j];
                    v2u w; w.x = pk2(y[0], y[1]); w.y = pk2(y[2], y[3]);
                    *(v2u*)(XN + (size_t)row * DM + col) = w;
                    if (INIT) sth4(H + (size_t)row * DM + col, v[q][j]);
                }
            }
        }
    }
    for (int row = TL + gw; row < Mrows; row += NGW) {
        f32x4 v[4];
#pragma unroll
        for (int j = 0; j < 4; ++j) v[j] = INIT ? ((const f32x4*)(x_ctx + (size_t)(row - TL) * DM))[lane + 64 * j] : ldh4(H + (size_t)row * DM + 4 * lane + 256 * j);
        if (nsl > 0) {
            const int rr = row - TL, pmc = rr >> 8, r = rr & 255;
#pragma unroll
            for (int j = 0; j < 4; ++j) {
                const bf16* pb = part + ((size_t)(pmc * 4 + j) * nsl) * 65536 + (size_t)r * 256 + 4 * lane;
                f32x4 pv[8];
#pragma unroll
                for (int sl = 0; sl < 8; ++sl) pv[sl] = sl < nsl ? ldh4(pb + (size_t)sl * 65536) : (f32x4){0.f, 0.f, 0.f, 0.f};
                const f32x4 sacc = ((pv[0] + pv[1]) + (pv[2] + pv[3])) + ((pv[4] + pv[5]) + (pv[6] + pv[7]));
                v[j] = v[j] + (*(const f32x4*)(pgate + 4 * lane + 256 * j) * pcoef) * sacc;
                sth4(H + (size_t)row * DM + 4 * lane + 256 * j, v[j]);
            }
        }
        float s = 0.f;
#pragma unroll
        for (int j = 0; j < 4; ++j) s += (v[j][0] * v[j][0] + v[j][1] * v[j][1]) + (v[j][2] * v[j][2] + v[j][3] * v[j][3]);
        s = wave_sum(s);
        const float rstd = 1.0f / sqrtf(s * (1.0f / DM) + 1e-6f);
        const float* mp = modl + (size_t)8 * NMODW;
#pragma unroll
        for (int j = 0; j < 4; ++j) {
            const int col = 4 * lane + 256 * j;
            const f32x4 gg = *(const f32x4*)(g + col), sc = *(const f32x4*)(mp + iscale * DM + col), s4 = *(const f32x4*)(mp + ishift * DM + col);
            const f32x4 y = (v[j] * rstd) * gg * (sc + 1.0f) + s4;
            v2u w; w.x = pk2(y[0], y[1]); w.y = pk2(y[2], y[3]);
            *(v2u*)(XN + (size_t)row * DM + col) = w;
            if (INIT) sth4(H + (size_t)row * DM + col, v[j]);
        }
    }
}
__device__ __forceinline__ void final_norm_phase(const bf16* H, float* out, const float* g, int gw, int NGW, int lane) {
    const int rpw = (TL + NGW - 1) / NGW;
    f32x4 gg[4];
#pragma unroll
    for (int j = 0; j < 4; ++j) gg[j] = *(const f32x4*)(g + 4 * lane + 256 * j);
    constexpr int R = 4;
    for (int i0 = 0; i0 < rpw; i0 += R) {
        f32x4 v[R][4]; float ss[R];
#pragma unroll
        for (int q = 0; q < R; ++q) {
            int row = gw * rpw + i0 + q; if (i0 + q >= rpw || row >= TL) row = gw * rpw < TL ? gw * rpw : 0;
#pragma unroll
            for (int j = 0; j < 4; ++j) v[q][j] = ldh4(H + (size_t)row * DM + 4 * lane + 256 * j);
        }
#pragma unroll
        for (int q = 0; q < R; ++q) { float s = 0.f;
#pragma unroll
            for (int j = 0; j < 4; ++j) s += (v[q][j][0] * v[q][j][0] + v[q][j][1] * v[q][j][1]) + (v[q][j][2] * v[q][j][2] + v[q][j][3] * v[q][j][3]);
            ss[q] = s; }
#pragma unroll
        for (int o = 1; o < 64; o <<= 1) {
#pragma unroll
            for (int q = 0; q < R; ++q) ss[q] += __shfl_xor(ss[q], o);
        }
#pragma unroll
        for (int q = 0; q < R; ++q) {
            const int row = gw * rpw + i0 + q;
            if (i0 + q < rpw && row < TL) {
                const float rstd = 1.0f / sqrtf(ss[q] * (1.0f / DM) + 1e-6f);
#pragma unroll
                for (int j = 0; j < 4; ++j) *(f32x4*)(out + (size_t)row * DM + 4 * lane + 256 * j) = (v[q][j] * rstd) * gg[j];
            }
        }
    }
}

constexpr int AT_KB = 64 * 256, AT_VB = 128 * 128, AT_K0 = 0, AT_V0 = 3 * AT_KB;
template <int VAR>
__device__ __forceinline__ void attn_phase(LAS unsigned char* lds, const bf16* Q, const bf16* K, const bf16* Vt, bf16* AO, const float* lam4, const float* subg, float lam_init, bool ctxq, int G, int blk, int tid) {
    const int lane = tid & 63, wave = __builtin_amdgcn_readfirstlane(tid >> 6), rg = wave & 3, r = wave >> 2, q32 = lane & 31, hi = lane >> 5;
    float lamv;
    { float x = 0.f, y = 0.f;
      for (int i = 0; i < 64; ++i) { x += lam4[i] * lam4[64 + i]; y += lam4[128 + i] * lam4[192 + i]; }
      lamv = __expf(x) - __expf(y) + lam_init; }
    const int nunits = 1024 + (ctxq ? 128 : 0);
    const int vcu = (G % 8 == 0) ? (blk % 8) * (G / 8) + blk / 8 : blk;
    for (int uidx = vcu; uidx < nunits; uidx += G) {
        int b, h, qrow0, t0, t1;
        if (uidx < 1024) { b = uidx >> 7; h = (uidx >> 4) & 7; qrow0 = b * SEQ + (uidx & 15) * 128; t0 = 0; t1 = 36; }
        else { const int v = uidx - 1024; b = v >> 4; h = (v >> 1) & 7; qrow0 = TL + b * CTXL + (v & 1) * 128; t0 = 32; t1 = 36; }
        bf16x8 qf[4];
        { const bf16* qp = Q + (size_t)(qrow0 + rg * 32 + q32) * DM + h * 128 + r * 64 + hi * 8;
#pragma unroll
          for (int d0 = 0; d0 < 4; ++d0) qf[d0] = *(const bf16x8*)(qp + d0 * 16);
#pragma unroll
          for (int d0 = 0; d0 < 4; ++d0) asm volatile("" : "+v"(qf[d0])); }
        f32x16 o[4];
#pragma unroll
        for (int db = 0; db < 4; ++db)
#pragma unroll
            for (int i = 0; i < 16; ++i) o[db][i] = 0.f;
        float mrun = 0.f, lrun = 0.f;
        f32x16 negm;
#pragma unroll
        for (int i = 0; i < 16; ++i) negm[i] = 0.f;
        const bf16* kbase = K + h * 128;
        const bf16* vbase = Vt + (size_t)(b * NHEAD + h) * 128 * KVN;
#define AT_ROWB(t) ((t) < 32 ? (size_t)b * SEQ + (size_t)(t) * 64 : (size_t)TL + (size_t)b * CTXL + (size_t)((t) - 32) * 64)
#define AT_DMA(t, kbuf, vbuf) do { const char* kp_ = (const char*)kbase + AT_ROWB(t) * (size_t)(DM * 2); const char* vp_ = (const char*)vbase + (size_t)(t) * 128; \
            _Pragma("unroll") for (int i_ = 0; i_ < 2; ++i_) { \
                const int krow_ = 8 * wave + 4 * i_ + (lane >> 4); \
                __builtin_amdgcn_global_load_lds((const unsigned*)(kp_ + (size_t)krow_ * (DM * 2) + (((lane & 15) ^ (krow_ & 15)) * 16)), (LAS unsigned*)(lds + AT_K0 + (kbuf) * AT_KB + wave * 2048 + i_ * 1024), 16, 0, 0); } \
            _Pragma("unroll") for (int i_ = 0; i_ < 2; ++i_) { \
                const int vrow_ = 16 * wave + 8 * i_ + (lane >> 3); \
                __builtin_amdgcn_global_load_lds((const unsigned*)(vp_ + (size_t)vrow_ * (KVN * 2) + (((lane & 7) ^ ((vrow_ >> 1) & 7)) * 16)), (LAS unsigned*)(lds + AT_V0 + (vbuf) * AT_VB + wave * 2048 + i_ * 1024), 16, 0, 0); } } while (0)
#define AT_SB() __builtin_amdgcn_sched_barrier(0)
        unsigned kfo[4], vfo[4];
#pragma unroll
        for (int i = 0; i < 4; ++i) { kfo[i] = (unsigned)(q32 * 256 + (((r * 8 + 2 * i + hi) ^ (q32 & 15)) * 16)); vfo[i] = (unsigned)(q32 * 128 + (((2 * i + hi) ^ ((q32 >> 1) & 7)) * 16)); }
#define AT_QK(S0, S1, buf) do { const LAS unsigned char* kb_ = lds + AT_K0 + (buf) * AT_KB; bf16x8 kf_[4]; \
            _Pragma("unroll") for (int d_ = 0; d_ < 2; ++d_) { kf_[2 * d_] = *(const LAS bf16x8*)(kb_ + kfo[d_]); kf_[2 * d_ + 1] = *(const LAS bf16x8*)(kb_ + 32 * 256 + kfo[d_]); } \
            AT_SB(); \
            S0 = MFMA32(kf_[0], qf[0], negm); S1 = MFMA32(kf_[1], qf[0], negm); \
            S0 = MFMA32(kf_[2], qf[1], S0); S1 = MFMA32(kf_[3], qf[1], S1); \
            AT_SB(); \
            _Pragma("unroll") for (int d_ = 0; d_ < 2; ++d_) { kf_[2 * d_] = *(const LAS bf16x8*)(kb_ + kfo[d_ + 2]); kf_[2 * d_ + 1] = *(const LAS bf16x8*)(kb_ + 32 * 256 + kfo[d_ + 2]); } \
            AT_SB(); \
            S0 = MFMA32(kf_[0], qf[2], S0); S1 = MFMA32(kf_[1], qf[2], S1); S0 = MFMA32(kf_[2], qf[3], S0); S1 = MFMA32(kf_[3], qf[3], S1); } while (0)
        bf16x8 va[4];
#pragma unroll
        for (int i = 0; i < 4; ++i) va[i] = (bf16x8){0, 0, 0, 0, 0, 0, 0, 0};
#define AT_PV_PRE(VB) do { const LAS unsigned char* vb = lds + AT_V0 + (VB) * AT_VB; \
            _Pragma("unroll") for (int ks = 0; ks < 4; ++ks) va[ks] = *(const LAS bf16x8*)(vb + vfo[ks]); } while (0)
#define AT_PV_RUN(PF, VB) do { const LAS unsigned char* vb = lds + AT_V0 + (VB) * AT_VB; bf16x8 vc[4], ve[4]; \
            _Pragma("unroll") for (int ks = 0; ks < 4; ++ks) vc[ks] = *(const LAS bf16x8*)(vb + 1 * 32 * 128 + vfo[ks]); \
            _Pragma("unroll") for (int ks = 0; ks < 4; ++ks) ve[ks] = *(const LAS bf16x8*)(vb + 2 * 32 * 128 + vfo[ks]); \
            AT_SB(); __builtin_amdgcn_s_setprio(1); \
            _Pragma("unroll") for (int ks = 0; ks < 4; ++ks) o[0] = MFMA32(va[ks], PF[ks], o[0]); \
            AT_SB(); \
            _Pragma("unroll") for (int ks = 0; ks < 4; ++ks) va[ks] = *(const LAS bf16x8*)(vb + 3 * 32 * 128 + vfo[ks]); \
            AT_SB(); \
            _Pragma("unroll") for (int ks = 0; ks < 4; ++ks) o[1] = MFMA32(vc[ks], PF[ks], o[1]); \
            AT_SB(); \
            _Pragma("unroll") for (int ks = 0; ks < 4; ++ks) o[2] = MFMA32(ve[ks], PF[ks], o[2]); \
            AT_SB(); \
            _Pragma("unroll") for (int ks = 0; ks < 4; ++ks) o[3] = MFMA32(va[ks], PF[ks], o[3]); \
            __builtin_amdgcn_s_setprio(0); \
            AT_SB(); } while (0)
#define AT_STEP(C0, C1, t) do { \
            if (!(VAR & 8)) { if ((t) + 2 < t1) AT_DMA((t) + 2, (kc + 2) % 3, (vc4 + 2) & 3); } \
            if (!(VAR & 2)) { if (r == 1 && (t) > t0) AT_PV_PRE((vc4 + 3) & 3); } \
            if (!(VAR & 4)) AT_QK(C0, C1, kc); else { C0 = negm; C1 = negm; }    \
            if (!(VAR & 2)) { if (r == 1 && (t) > t0) AT_PV_RUN(pfp, (vc4 + 3) & 3); if (r == 0) AT_PV_PRE(vc4); } \
            AT_SB(); \
            asm volatile("s_nop 15\n\ts_nop 7" : "+v"(C0), "+v"(C1));     \
            if (!(VAR & 1)) { \
            float rm, rb_; \
            rm = max3f(C0[0], C0[1], C1[0]); rb_ = max3f(C0[2], C0[3], C1[1]); rm = max3f(rm, C1[2], C1[3]); \
            _Pragma("unroll") for (int i = 4; i < 16; i += 4) { rm = max3f(rm, C0[i], C0[i + 1]); rb_ = max3f(rb_, C0[i + 2], C0[i + 3]); rm = max3f(rm, C1[i], C1[i + 1]); rb_ = max3f(rb_, C1[i + 2], C1[i + 3]); } \
            rm = xhalf_max(fmaxf(rm, rb_)); \
            if (__any(rm > 8.0f) || (t) == t0) { const float dl = (t) == t0 ? rm : fmaxf(rm, 0.f), alpha = fast_exp2(-dl); mrun += dl; lrun *= alpha; \
                _Pragma("unroll") for (int i = 0; i < 16; ++i) { C0[i] -= dl; C1[i] -= dl; negm[i] = -mrun; } \
                _Pragma("unroll") for (int db = 0; db < 4; ++db) _Pragma("unroll") for (int i = 0; i < 16; ++i) o[db][i] *= alpha; } \
            f32x2_t ps_ = (f32x2_t){0.f, 0.f}; \
            _Pragma("unroll") for (int i = 0; i < 16; i += 2) { C0[i] = fast_exp2(C0[i]); C0[i + 1] = fast_exp2(C0[i + 1]); C1[i] = fast_exp2(C1[i]); C1[i + 1] = fast_exp2(C1[i + 1]); \
                ps_ += (f32x2_t){C0[i], C0[i + 1]}; ps_ += (f32x2_t){C1[i], C1[i + 1]}; } \
            lrun += ps_[0] + ps_[1]; \
            } \
            { v4u w; \
              w.x = pk2(C0[0], C0[1]); w.y = pk2(C0[2], C0[3]); w.z = pk2(C0[4], C0[5]); w.w = pk2(C0[6], C0[7]); pfp[0] = __builtin_bit_cast(bf16x8, w); \
              w.x = pk2(C0[8], C0[9]); w.y = pk2(C0[10], C0[11]); w.z = pk2(C0[12], C0[13]); w.w = pk2(C0[14], C0[15]); pfp[1] = __builtin_bit_cast(bf16x8, w); \
              w.x = pk2(C1[0], C1[1]); w.y = pk2(C1[2], C1[3]); w.z = pk2(C1[4], C1[5]); w.w = pk2(C1[6], C1[7]); pfp[2] = __builtin_bit_cast(bf16x8, w); \
              w.x = pk2(C1[8], C1[9]); w.y = pk2(C1[10], C1[11]); w.z = pk2(C1[12], C1[13]); w.w = pk2(C1[14], C1[15]); pfp[3] = __builtin_bit_cast(bf16x8, w); } \
            AT_SB(); \
            if (!(VAR & 2)) { if (r == 0) AT_PV_RUN(pfp, vc4); } \
            if (!(VAR & 8) && (t) + 2 < t1) asm volatile("s_waitcnt vmcnt(4) lgkmcnt(0)" ::: "memory"); else asm volatile("s_waitcnt vmcnt(0) lgkmcnt(0)" ::: "memory"); \
            __builtin_amdgcn_s_barrier(); asm volatile("" ::: "memory"); \
            kc = (kc + 1) % 3; vc4 = (vc4 + 1) & 3; } while (0)
        bf16x8 pfp[4];
#pragma unroll
        for (int i = 0; i < 4; ++i) pfp[i] = (bf16x8){0, 0, 0, 0, 0, 0, 0, 0};
        int kc = 0, vc4 = 0;
        AT_DMA(t0, 0, 0); AT_DMA(t0 + 1, 1, 1);
        asm volatile("s_waitcnt vmcnt(4) lgkmcnt(0)" ::: "memory"); __builtin_amdgcn_s_barrier(); asm volatile("" ::: "memory");
        for (int t = t0; t < t1; ++t) {
            f32x16 sa0, sa1;
            AT_STEP(sa0, sa1, t);
        }
        if (!(VAR & 2)) { if (r == 1) { AT_PV_PRE((vc4 + 3) & 3); AT_PV_RUN(pfp, (vc4 + 3) & 3); } }
        __syncthreads();
#undef AT_PV_PRE
#undef AT_PV_RUN
#undef AT_ROWB
#undef AT_DMA
#undef AT_SB
#undef AT_QK
#undef AT_STEP
        lrun = xhalf_sum(lrun);
        const float inv = 1.0f / lrun;
        LAS float* xch = (LAS float*)lds + rg * 4096;
        if (r == 1) {
#pragma unroll
            for (int db = 0; db < 4; ++db)
#pragma unroll
                for (int i = 0; i < 16; ++i) xch[(db * 16 + i) * 64 + lane] = o[db][i] * inv;
        }
        __syncthreads();
        if (r == 0) {
            float ss = 0.f;
#pragma unroll
            for (int db = 0; db < 4; ++db)
#pragma unroll
                for (int i = 0; i < 16; ++i) { const float d = o[db][i] * inv - lamv * xch[(db * 16 + i) * 64 + lane]; o[db][i] = d; ss += d * d; }
            ss = xhalf_sum(ss);
            const float rn = (1.0f / sqrtf(ss * (1.0f / 128.0f) + 1e-6f)) * (1.0f - lam_init);
            bf16* op = AO + (size_t)(qrow0 + rg * 32 + q32) * DM + h * 128;
#pragma unroll
            for (int db = 0; db < 4; ++db)
#pragma unroll
                for (int i4 = 0; i4 < 4; ++i4) {
                    const int dcol = 32 * db + 8 * i4 + 4 * hi;
                    const f32x4 g4 = *(const f32x4*)(subg + dcol);
                    v2u w; w.x = pk2(o[db][4 * i4] * rn * g4[0], o[db][4 * i4 + 1] * rn * g4[1]); w.y = pk2(o[db][4 * i4 + 2] * rn * g4[2], o[db][4 * i4 + 3] * rn * g4[3]);
                    *(v2u*)(op + dcol) = w;
                }
        }
        __syncthreads();
    }
}

__device__ __forceinline__ void sgmix_phase(LAS unsigned char* lds, const bf16* ZU, const bf16* ZVT, const float* stats, const bf16* WS, const float* bs, const float* lng, const float* lnb, bf16* Gout, int nchunks, int G, int blk, int tid) {
    const int lane = tid & 63, wave = __builtin_amdgcn_readfirstlane(tid >> 6), q32 = lane & 31, hi = lane >> 5;
    const int vcu = (G % 8 == 0) ? (blk % 8) * (G / 8) + blk / 8 : blk;
    const int tb = wave >> 1, ch = wave & 1;
    int buf = 0;
    for (int u = vcu; u < nchunks * 8; u += G, buf ^= 1) {
        const int chunk = u >> 3, g = u & 7;
        LAS unsigned char* tile = lds + buf * 34816;
        LAS float* smu = (LAS float*)(lds + 69632 + buf * 1024); LAS float* srs = smu + 128;
        const bf16* wp = WS + ((size_t)g * 128 + tb * 32 + q32) * 128 + hi * 8;
        bf16x8 wf[8];
#pragma unroll
        for (int k = 0; k < 8; ++k) wf[k] = *(const bf16x8*)(wp + k * 16);
        const int t = tb * 32 + q32; const size_t row = (size_t)chunk * 128 + t;
        const float bias = bs[g * 128 + t];
        v2u ug[2][4];
#pragma unroll
        for (int cb = 0; cb < 2; ++cb)
#pragma unroll
            for (int i4 = 0; i4 < 4; ++i4) ug[cb][i4] = *(const v2u*)(ZU + row * DM + g * 128 + ch * 64 + cb * 32 + 8 * i4 + 4 * hi);
        v4u raw[4];
#pragma unroll
        for (int it = 0; it < 4; ++it) { const int idx = it * 512 + tid, c = idx >> 4, s8 = (idx & 15) * 8; raw[it] = *(const v4u*)(ZVT + ((size_t)chunk * DM + g * 128 + c) * 128 + s8); }
        {
            const int r = tid >> 2, part = tid & 3;
            const f32x4* sp = (const f32x4*)(stats + ((size_t)(chunk * 128 + r) * 16 + part * 4) * 2);
            const f32x4 a0 = sp[0], a1 = sp[1];
            float s1 = (a0[0] + a0[2]) + (a1[0] + a1[2]), s2 = (a0[1] + a0[3]) + (a1[1] + a1[3]);
            s1 += __shfl_xor(s1, 1); s2 += __shfl_xor(s2, 1); s1 += __shfl_xor(s1, 2); s2 += __shfl_xor(s2, 2);
            if (part == 0) { const float mu = s1 * (1.0f / DM); const float var = fmaxf(s2 * (1.0f / DM) - mu * mu, 0.f); smu[r] = mu; srs[r] = 1.0f / sqrtf(var + 1e-5f); }
        }
        __syncthreads();
#pragma unroll
        for (int it = 0; it < 4; ++it) {
            const int idx = it * 512 + tid, c = idx >> 4, s8 = (idx & 15) * 8;
            const float gg = lng[g * 128 + c], bb = lnb[g * 128 + c];
            float y[8];
#pragma unroll
            for (int j = 0; j < 4; ++j) { const unsigned wv = raw[it][j];
                y[2 * j] = (bf2f(wv & 0xffffu) - smu[s8 + 2 * j]) * srs[s8 + 2 * j] * gg + bb;
                y[2 * j + 1] = (bf2f(wv >> 16) - smu[s8 + 2 * j + 1]) * srs[s8 + 2 * j + 1] * gg + bb; }
            v4u w; w.x = pk2(y[0], y[1]); w.y = pk2(y[2], y[3]); w.z = pk2(y[4], y[5]); w.w = pk2(y[6], y[7]);
            *(LAS v4u*)(tile + c * 272 + s8 * 2) = w;
        }
        __syncthreads();
        f32x16 acc0, acc1;
#pragma unroll
        for (int i = 0; i < 16; ++i) { acc0[i] = 0.f; acc1[i] = 0.f; }
        const LAS unsigned char* bp = tile + (ch * 64 + q32) * 272 + hi * 16;
#pragma unroll
        for (int k = 0; k < 8; ++k) {
            const bf16x8 b0 = *(const LAS bf16x8*)(bp + k * 32), b1 = *(const LAS bf16x8*)(bp + 32 * 272 + k * 32);
            acc0 = MFMA32(b0, wf[k], acc0); acc1 = MFMA32(b1, wf[k], acc1);
        }
#pragma unroll
        for (int i4 = 0; i4 < 4; ++i4) {
            const int col = g * 128 + ch * 64 + 8 * i4 + 4 * hi;
            const f32x4 u0 = (f32x4){bf2f(ug[0][i4].x & 0xffffu), bf2f(ug[0][i4].x >> 16), bf2f(ug[0][i4].y & 0xffffu), bf2f(ug[0][i4].y >> 16)};
            const f32x4 u1 = (f32x4){bf2f(ug[1][i4].x & 0xffffu), bf2f(ug[1][i4].x >> 16), bf2f(ug[1][i4].y & 0xffffu), bf2f(ug[1][i4].y >> 16)};
            const f32x4 m0 = (f32x4){acc0[4 * i4], acc0[4 * i4 + 1], acc0[4 * i4 + 2], acc0[4 * i4 + 3]}, m1 = (f32x4){acc1[4 * i4], acc1[4 * i4 + 1], acc1[4 * i4 + 2], acc1[4 * i4 + 3]};
            sth4(Gout + row * DM + col, (m0 + bias) * u0);
            sth4(Gout + row * DM + col + 32, (m1 + bias) * u1);
        }
    }
    __syncthreads();
}

#define XB_TMO      128
#define XB_XCNT(j)  (256  + 64 * (j))
#define XB_XSUB(j)  (1280 + 64 * (j))
#define XB_XGEN(j)  (2304 + 64 * (j))
#define XB_TOP      3328
#define XB_TOPGEN   3392
#define XCD_BAR_WORDS 3456
#define XB_SPIN_CAP (1u << 18)

__device__ __forceinline__ unsigned xb_ld(unsigned* p)              { return __hip_atomic_load(p, __ATOMIC_RELAXED, __HIP_MEMORY_SCOPE_AGENT); }
__device__ __forceinline__ unsigned xb_add(unsigned* p, unsigned v) { return __hip_atomic_fetch_add(p, v, __ATOMIC_RELAXED, __HIP_MEMORY_SCOPE_AGENT); }
__device__ __forceinline__ unsigned xb_xcc_id() { return (unsigned)__builtin_amdgcn_s_getreg((3 << 11) | 20) & 0xFu; }
#define XB_SPIN(cond, bar) do { unsigned _sp = 0; while (cond) { __builtin_amdgcn_s_sleep(1); \
    if ((++_sp & 255u) == 0u) { if (xb_ld(&(bar)[XB_TMO])) break; if (_sp > XB_SPIN_CAP) { atomicAdd(&(bar)[XB_TMO], 1u); break; } } } } while (0)

struct XcdBarrier {
    unsigned* bar; unsigned x;
    volatile LAS unsigned* st;
};

__device__ __forceinline__ XcdBarrier xcd_barrier_post(unsigned* bar, volatile LAS unsigned* st) {
    XcdBarrier b; b.bar = bar; b.x = xb_xcc_id(); b.st = st;
    if (threadIdx.x == 0) (void)xb_add(&bar[XB_XCNT(b.x)], 1u);
    return b;
}
__device__ __forceinline__ void xcd_barrier_complete(unsigned* bar, unsigned x, unsigned& nloc, unsigned& nx) {
    const unsigned G = gridDim.x * gridDim.y * gridDim.z;
    unsigned sum, cnt, mine, sp = 0u;
    for (;;) {
        sum = 0u; cnt = 0u; mine = 0u;
#pragma unroll
        for (unsigned j = 0; j < 16; ++j) { const unsigned c = xb_ld(&bar[XB_XCNT(j)]); sum += c; cnt += (c > 0u) ? 1u : 0u; mine = (j == x) ? c : mine; }
        if (sum == G) break;
        __builtin_amdgcn_s_sleep(1);
        if ((++sp & 255u) == 0u) { if (xb_ld(&bar[XB_TMO])) break; if (sp > XB_SPIN_CAP) { atomicAdd(&bar[XB_TMO], 1u); break; } }
    }
    nloc = mine > 0u ? mine : 1u; nx = cnt > 0u ? cnt : 1u;
}

__device__ __forceinline__ void xcd_barrier(const XcdBarrier& b) {
    asm volatile("s_waitcnt vmcnt(0)" ::: "memory");
    __syncthreads();
    if (threadIdx.x == 0) {
        unsigned* bar = b.bar;
        __builtin_amdgcn_s_waitcnt(0);
        unsigned nloc = b.st[0], nx = b.st[1];
        if (nloc == 0u) { xcd_barrier_complete(bar, b.x, nloc, nx); b.st[0] = nloc; b.st[1] = nx; }
        const unsigned old = xb_add(&bar[XB_XSUB(b.x)], 1u);
        const unsigned gen = old / nloc;
        if (old + 1u == (gen + 1u) * nloc) {
            __builtin_amdgcn_fence(__ATOMIC_RELEASE, "agent");
            asm volatile("s_waitcnt vmcnt(0)" ::: "memory");
            const unsigned og = xb_add(&bar[XB_TOP], 1u);
            const unsigned tg = og / nx;
            if (og + 1u == (tg + 1u) * nx) xb_add(&bar[XB_TOPGEN], 1u);
            else XB_SPIN(xb_ld(&bar[XB_TOPGEN]) == tg, bar);
            __builtin_amdgcn_fence(__ATOMIC_ACQUIRE, "agent");
            xb_add(&bar[XB_XGEN(b.x)], 1u);
            asm volatile("s_waitcnt vmcnt(0)" ::: "memory");
        } else {
            XB_SPIN(xb_ld(&bar[XB_XGEN(b.x)]) == gen, bar);
            __builtin_amdgcn_fence(__ATOMIC_ACQUIRE, "agent");
            asm volatile("s_waitcnt vmcnt(0)" ::: "memory");
        }
    }
    __syncthreads();
}

constexpr int LDS_BYTES = 131072 + 2048 + 8 * XP_WAVE;
__global__ void __launch_bounds__(512, 2) hybrid_fwd(Args a) {
    extern __shared__ __attribute__((aligned(16))) unsigned char lds_raw[];
    LAS unsigned char* lds = (LAS unsigned char*)lds_raw;
    cg::grid_group grid = cg::this_grid();
    const int G = gridDim.x, blk = blockIdx.x;
    if (threadIdx.x < 4) ((LAS unsigned*)(lds + 131072 + 512))[threadIdx.x] = 0u;
    __syncthreads();
    (void)xcd_barrier_post((unsigned*)(get_args().ws() + OFF_BAR), (volatile LAS unsigned*)(lds + 131072 + 512));
#define GRID_BARRIER() do { XcdBarrier xb_; xb_.bar = (unsigned*)(get_args().ws() + OFF_BAR); xb_.x = (unsigned)__builtin_amdgcn_readfirstlane((int)xb_xcc_id()); xb_.st = (volatile LAS unsigned*)(lds + 131072 + 512); xcd_barrier(xb_); } while (0)

#ifdef PROBE_XMASK
    LAS unsigned* pacc = (LAS unsigned*)(lds + 131072 + 1024);
    if (threadIdx.x == 0) { for (int i = 0; i < 16; ++i) pacc[i] = 0u; const unsigned long long t = __builtin_amdgcn_s_memrealtime(); pacc[16] = (unsigned)t; }
#define PSTAMP(type) do { if (threadIdx.x == 0) { const unsigned t_ = (unsigned)__builtin_amdgcn_s_memrealtime(); pacc[(type)] += t_ - pacc[16]; pacc[16] = t_; } } while (0)
#else
#define PSTAMP(type) do {} while (0)
#endif
#ifndef DIS_PRO
    prologue(lds, blk, G, threadIdx.x);
#endif
    if (G == 0x7fffffff) grid.sync();
    GRID_BARRIER();
    PSTAMP(0);

    for (int ph = 0; ph < 41; ++ph) {
        int tid = threadIdx.x; asm volatile("" : "+v"(tid));
        const int lane = tid & 63, wave = __builtin_amdgcn_readfirstlane(tid >> 6);
        const int gw = blk * 8 + wave, NGW = G * 8;
        const ArgView a = get_args();
        unsigned char* ws = a.ws();
        bf16* H = (bf16*)(ws + OFF_H);
        bf16* XN = (bf16*)(ws + OFF_XN);
        bf16* BIG = (bf16*)(ws + OFF_BIG);
        const float* MOD = (const float*)(ws + OFF_MOD);
        if (ph == 40) { final_norm_phase(H, a.out(), a.in(I_FINALG), gw, NGW, lane);
#ifdef PROBE_XMASK
            GRID_BARRIER(); PSTAMP(9);
            if (blk == 0 && threadIdx.x == 0) {
                unsigned xt = 0, yt = 0;
                for (int i = 0; i < 16; ++i) { if ((PROBE_XMASK >> i) & 1) xt += pacc[i]; if ((PROBE_YMASK >> i) & 1) yt += pacc[i]; }
                const unsigned xus = xt / 100u, yq = (yt / 100u + 16u) / 32u;
                const unsigned long long spin = ((unsigned long long)xus + 2048ull * yq) * 100ull, t0 = __builtin_amdgcn_s_memrealtime();
                while (__builtin_amdgcn_s_memrealtime() - t0 < spin) __builtin_amdgcn_s_sleep(32);
            }
#endif
            break; }
        const int l = ph / 10, s = ph % 10, j = l >> 1;
        const bool attn_layer = (l & 1) == 0;
        const float* modl = MOD + (size_t)l * 9 * NMODW;
        int Mrows = TT; if (l == 3 || (l == 2 && s >= 6)) Mrows = TL;
        if (s == 0 || s == 3 || s == 7) {
            const int k = s == 0 ? 0 : (s == 3 ? 1 : 2);
            const bool init = (ph == 0);
#ifndef DIS_NORM
            int pl = l, pg = 2, pn = 0; float pc = 0.5f;
            if (k == 0) { pl = l - 1; pg = 8; pn = (l == 1 || l == 2) ? 8 : 0; }
            else if (k == 1) { pg = 2; pn = (l <= 2) ? 8 : 0; }
            else { pg = 5; pc = 1.0f; pn = (l <= 1) ? 4 : 0; }
            if (pl < 0) pl = 0;
            if (init) norm_phase<true>(a.in(I_X), a.in(I_CTX), H, XN, a.in(I_NORMG) + (size_t)(l * 3 + k) * DM, modl, 3 * k, 3 * k + 1, Mrows, gw, NGW, lane, (const bf16*)(ws + OFF_PART), 0, MOD, pc);
            else norm_phase<false>(nullptr, nullptr, H, XN, a.in(I_NORMG) + (size_t)(l * 3 + k) * DM, modl, 3 * k, 3 * k + 1, Mrows, gw, NGW, lane,
                       (const bf16*)(ws + OFF_PART), pn, MOD + (size_t)(pl * 9 + 8) * NMODW + pg * DM, pc);
#endif
        } else if (s == 1 || s == 8) {
            const int f = s == 1 ? 0 : 1;
            pg8::Gemm g{XN, (const bf16*)(ws + OFF_WGU) + (size_t)(l * 2 + f) * 2 * DFF * DM, Mrows, 2 * DFF, DM};
            pg8::StaticOrder S; S.init(Mrows, 2 * DFF, G, blk); S.nkt_full = DM / 64;
            EpiSwiGLU E{BIG};
#ifndef DIS_GU
            pg8::gemm_phase<EpiSwiGLU, pg8::StaticOrder, true, true>(lds, g, S, E);
#endif
        } else if (s == 2 || s == 9 || s == 6) {
            const bf16* A; const bf16* Bt; int Kd; int gidx; float coef;
            if (s == 6) { A = XN; Kd = DM; gidx = 5; coef = 1.0f; Bt = attn_layer ? (const bf16*)(ws + OFF_WOUTA) + (size_t)j * DM * DM : (const bf16*)(ws + OFF_WOUTS) + (size_t)j * DM * DM; }
            else { const int f = s == 2 ? 0 : 1; A = BIG; Kd = DFF; gidx = s == 2 ? 2 : 8; coef = 0.5f; Bt = (const bf16*)(ws + OFF_WDN) + (size_t)(l * 2 + f) * DM * DFF; }
            pg8::Gemm g{A, Bt, Mrows, DM, Kd};
            SplitOrder S; S.init(Mrows == TT ? (Kd == DFF ? 8 : 4) : 0, Kd / 64, G, blk);
            EpiResid E{ws, modl + gidx * DM, coef == 0.5f ? 1 : 0};
#ifndef DIS_RES
            pg8::gemm_phase<EpiResid, SplitOrder, true, true>(lds, g, S, E);
#endif
        } else if (s == 4) {
            if (attn_layer) {
                pg8::Gemm g{XN, (const bf16*)(ws + OFF_WINA) + (size_t)j * 3 * DM * DM, Mrows, 3 * DM, DM};
                pg8::StaticOrder S; S.init(Mrows, 3 * DM, G, blk); S.nkt_full = DM / 64;
                EpiQKV E{BIG, (bf16*)((unsigned char*)BIG + SZ_TOK), (bf16*)((unsigned char*)BIG + 2 * SZ_TOK), (const float*)(ws + OFF_ROPE), lds + XP_OFF};
#ifndef DIS_QKV
                pg8::gemm_phase<EpiQKV, pg8::StaticOrder, true, true>(lds, g, S, E);
#endif
            } else {
                pg8::Gemm g{XN, (const bf16*)(ws + OFF_WINS) + (size_t)j * 2 * DM * DM, Mrows, 2 * DM, DM};
                pg8::StaticOrder S; S.init(Mrows, 2 * DM, G, blk); S.nkt_full = DM / 64;
                EpiSG E{BIG, (bf16*)((unsigned char*)BIG + SZ_TOK), (float*)(ws + OFF_SGST2) + (size_t)j * TT * 32};
#ifndef DIS_SG
                pg8::gemm_phase<EpiSG, pg8::StaticOrder, true, true>(lds, g, S, E);
#endif
            }
        } else {
            if (attn_layer) {
                const float lam_init = 0.8f - 0.6f * __expf(-0.3f * (float)l);
#ifndef DIS_ATT
                attn_phase<0>(lds, BIG, (const bf16*)((unsigned char*)BIG + SZ_TOK), (const bf16*)((unsigned char*)BIG + 2 * SZ_TOK), XN, a.in(I_DALAM) + j * 256, a.in(I_DASUB) + j * 128, lam_init, l == 0, G, blk, tid);
#ifdef PROBE_ATT
                if (l == 0) attn_phase<PROBE_ATT>(lds, BIG, (const bf16*)((unsigned char*)BIG + SZ_TOK), (const bf16*)((unsigned char*)BIG + 2 * SZ_TOK), (bf16*)(ws + OFF_PART), a.in(I_DALAM) + j * 256, a.in(I_DASUB) + j * 128, lam_init, false, G, blk, tid);
#endif
#endif
            } else {
#ifndef DIS_MIX
                sgmix_phase(lds, BIG, (const bf16*)((unsigned char*)BIG + SZ_TOK), (const float*)(ws + OFF_SGST2) + (size_t)j * TT * 32, (const bf16*)(ws + OFF_WSS) + (size_t)j * 8 * 128 * 128,
                            a.in(I_SGBS) + j * 8 * 128, a.in(I_SGLNG) + j * DM, a.in(I_SGLNB) + j * DM, XN, Mrows / 128, G, blk, tid);
#endif
            }
        }
        if (l < 3 && (s == 1 || s == 4 || s == 8)) {
            const int which = s == 1 ? 0 : (s == 4 ? 1 : 2);
            const int nid = conv_idle_phase(l, which, G), tot_idle = conv_idle_total(l, G);
            const int nwg = which == 0 ? (TT / 256) * 22 : (which == 1 ? (TT / 256) * (attn_layer ? 12 : 8) : ((l < 2 ? TT : TL) / 256) * 22);
            const int rem = nwg % G;
            if (nid > 0 && blk >= rem) {
                const int L = l + 1, tot = conv_layer_count(L);
                const int before = which == 0 ? 0 : (which == 1 ? conv_idle_phase(l, 0, G) : conv_idle_phase(l, 0, G) + conv_idle_phase(l, 1, G));
                const int first = (int)((long long)tot * before / tot_idle), last = (int)((long long)tot * (before + nid) / tot_idle);
                conv_layer_items(a, ws, L, first, last, (blk - rem) * 8 + wave, nid * 8, (LAS float*)(lds + wave * 16384), lane);
            }
        }
        GRID_BARRIER();
#ifdef PROBE_SYNC3
        GRID_BARRIER(); GRID_BARRIER();
#endif
        PSTAMP(s == 0 || s == 3 || s == 7 ? 1 : (s == 1 || s == 8 ? 2 : (s == 2 || s == 9 ? 3 : (s == 6 ? 4 : (s == 4 ? (attn_layer ? 5 : 6) : (attn_layer ? 7 : 8))))));
    }
}

extern "C" void kernel_launch(void* const* d_in, const int* in_sizes, int n_in, void* d_out, int out_size, void* d_ws, size_t ws_size, hipStream_t stream) {
    static int grid = 0;
    if (grid == 0) {
        if (n_in != 20 || ws_size < WS_NEED || out_size != TL * DM) { fprintf(stderr, "kernel_launch: unexpected problem (n_in %d, ws %zu, out %d)\n", n_in, ws_size, out_size); grid = -1; return; }
        int dev = 0, cus = 0, per_cu = 0;
        if (hipGetDevice(&dev) != hipSuccess || hipDeviceGetAttribute(&cus, hipDeviceAttributeMultiprocessorCount, dev) != hipSuccess) { grid = -1; return; }
        if (hipFuncSetAttribute((const void*)hybrid_fwd, hipFuncAttributeMaxDynamicSharedMemorySize, LDS_BYTES) != hipSuccess) { fprintf(stderr, "kernel_launch: hipFuncSetAttribute failed\n"); grid = -1; return; }
        if (hipOccupancyMaxActiveBlocksPerMultiprocessor(&per_cu, (const void*)hybrid_fwd, 512, LDS_BYTES) != hipSuccess || per_cu < 1) { fprintf(stderr, "kernel_launch: occupancy query says %d\n", per_cu); per_cu = 1; }
        (void)hipGetLastError();
        grid = cus;
    }
    if (grid < 0) return;
    if (hipMemsetAsync((char*)d_ws + OFF_BAR, 0, 16384, stream) != hipSuccess) { fprintf(stderr, "kernel_launch: memset failed\n"); return; }
    Args a{};
    for (int i = 0; i < 20; ++i) a.in_[i] = (GAS const float*)d_in[i];
    a.out_ = (GAS float*)d_out; a.ws_ = (GAS unsigned char*)d_ws;
    void* params[] = {&a};
    hipError_t e = hipLaunchCooperativeKernel((const void*)hybrid_fwd, dim3(grid), dim3(512), params, LDS_BYTES, stream);
    if (e != hipSuccess) fprintf(stderr, "kernel_launch: cooperative launch failed: %s (grid %d)\n", hipGetErrorString(e), grid);
}
```

```cpp
#include <hip/hip_runtime.h>
#include <hip/hip_cooperative_groups.h>
#include <cstdio>
#include <cstdint>
namespace cg = cooperative_groups;
namespace pg8 {
#define PG8_LAS __attribute__((address_space(3)))
typedef unsigned short bf16_t;
typedef short bf16x8 __attribute__((ext_vector_type(8)));
typedef float f32x4 __attribute__((ext_vector_type(4)));
typedef unsigned u32x4 __attribute__((ext_vector_type(4)));
constexpr int BM = 256, BK = 64, HALF = 128, HTB = HALF * BK * 2  , STAGE_BYTES = 8 * HTB, NXCD = 8, WGM = 8;

__host__ __device__ __forceinline__ int lds_byte(int r, int c) { const int st = (r >> 4) * 2 + (c >> 5), rr = r & 15, cc = c & 31, ob = rr * 64 + cc * 2; return st * 1024 + (ob ^ (((ob >> 9) & 1) << 5)); }
__host__ __device__ __forceinline__ void stage_rc(int b, int& R, int& C) { const int st = b / 1024, sb = b % 1024, swz = sb ^ (((sb >> 9) & 1) << 5); R = (st >> 1) * 16 + swz / 64; C = (st & 1) * 32 + (swz % 64) / 2; }
__host__ __device__ __forceinline__ int perm32(int rho) { const int n = rho >> 4, i = rho & 15; return 8 * (i >> 2) + 4 * n + (i & 3); }

struct Unit { int pm, pn, kt0, nkt, part; };
struct Gemm { const bf16_t* A; const bf16_t* Bt; int M, N, K; };

struct StaticOrder {
    int nM, nN, nwg, G, c, nkt_full;
    __host__ __device__ void init(int M, int N, int G_, int c_) { nM = M / BM; nN = N / BM; nwg = nM * nN; G = G_; c = c_; }
    __host__ __device__ bool next(int i, Unit& u) const {
        const long L = (long)i * G + c; if (L >= nwg) return false;
        int wgid = (int)L; { const int q = nwg / NXCD, r = nwg % NXCD, xcd = wgid % NXCD, off = wgid / NXCD; wgid = (xcd < r ? xcd * (q + 1) : r * (q + 1) + (xcd - r) * q) + off; }
        const int nig = WGM * nN, gid = wgid / nig, fm = gid * WGM, gsz = (nM - fm) < WGM ? (nM - fm) : WGM;
        u.pm = fm + ((wgid % nig) % gsz); u.pn = (wgid % nig) / gsz; u.kt0 = 0; u.nkt = nkt_full; u.part = -1; return true;
    }
    __device__ __forceinline__ void a_ready(const Unit&) const {}
    __device__ __forceinline__ void done(const Unit&) const {}
};
__device__ __forceinline__ unsigned cvt_pk_bf16(float lo, float hi) { unsigned r; asm volatile("v_cvt_pk_bf16_f32 %0, %1, %2" : "=v"(r) : "v"(lo), "v"(hi)); return r; }
typedef float f32x2 __attribute__((ext_vector_type(2)));
template <class Epi, class Sched, bool ALIGN_EPI = false, bool SP2 = false>
__device__ __forceinline__ void gemm_phase(PG8_LAS unsigned char* lds, const Gemm g, const Sched& S, const Epi& E) {
    int tid_ = threadIdx.x; asm volatile("" : "+v"(tid_)); const int tid = tid_, wid = __builtin_amdgcn_readfirstlane(tid >> 6), lane = tid & 63, wr = wid >> 2, wc = wid & 3, fr = lane & 15, fq = lane >> 4;
    const int K = g.K;
    unsigned voffA[2], voffB[2];
#pragma unroll
    for (int i = 0; i < 2; ++i) { int R, C; stage_rc(tid * 16 + i * 8192, R, C); const int Rb = Epi::PERM ? ((R & ~31) + perm32(R & 31)) : R;
        voffA[i] = (unsigned)(R * K + C) * 2u; voffB[i] = (unsigned)(Rb * K + C) * 2u; }
    const size_t kstep = (size_t)(BK * 2);
    const size_t hstep = (size_t)HALF * K * 2;
    const size_t tstep = 2 * hstep;
    const unsigned ldsw = (unsigned)wid * 1024u;
    const int aoff = lds_byte(wr * 64 + fr, fq * 8), boff = lds_byte(wc * 32 + fr, fq * 8);
#define PG8_SA(b, h) (((b) * 2 + (h)) * HTB)
#define PG8_SB(b, h) ((4 + (b) * 2 + (h)) * HTB)
#define PG8_STAGE(bufoff, gbase, voff) do { _Pragma("unroll") for (int _i = 0; _i < 2; ++_i) \
        __builtin_amdgcn_global_load_lds((const unsigned*)((const char*)(gbase) + (voff)[_i]), (PG8_LAS unsigned*)(lds + (bufoff) + ldsw + _i * 8192), 16, 0, 0); } while (0)
#define PG8_LDA(dst, b, h) do { _Pragma("unroll") for (int m = 0; m < 4; ++m) _Pragma("unroll") for (int k = 0; k < 2; ++k) dst[m][k] = *(const PG8_LAS bf16x8*)(lds + PG8_SA(b, h) + aoff + m * 2048 + k * 1024); } while (0)
#define PG8_LDB(dst, b, h) do { _Pragma("unroll") for (int n = 0; n < 2; ++n) _Pragma("unroll") for (int k = 0; k < 2; ++k) dst[n][k] = *(const PG8_LAS bf16x8*)(lds + PG8_SB(b, h) + boff + n * 2048 + k * 1024); } while (0)
#define PG8_MMA(ai, bj, At, Bt) do { __builtin_amdgcn_s_setprio(1); _Pragma("unroll") for (int m = 0; m < 4; ++m) _Pragma("unroll") for (int n = 0; n < 2; ++n) _Pragma("unroll") for (int k = 0; k < 2; ++k) \
        acc[ai][bj][m][n] = __builtin_amdgcn_mfma_f32_16x16x32_bf16(Bt[n][k], At[m][k], acc[ai][bj][m][n], 0, 0, 0); __builtin_amdgcn_s_setprio(0); } while (0)
#define PG8_WAIT_V(n) asm volatile("s_waitcnt vmcnt(" #n ")" ::: "memory")
#define PG8_WAIT_L(n) asm volatile("s_waitcnt lgkmcnt(" #n ")" ::: "memory")
#define PG8_BAR __builtin_amdgcn_s_barrier()
#define PG8_SCHED __builtin_amdgcn_sched_barrier(0)
    Unit cur, nxt; int ui = 0;
    if (!S.next(0, cur)) return;
    f32x4 acc[2][2][4][2];
#pragma unroll
    for (int a = 0; a < 2; ++a)
#pragma unroll
        for (int b = 0; b < 2; ++b)
#pragma unroll
            for (int m = 0; m < 4; ++m)
#pragma unroll
                for (int n = 0; n < 2; ++n) acc[a][b][m][n] = (f32x4){0.f, 0.f, 0.f, 0.f};
    bf16x8 At[4][2], B0[2][2], B1[2][2];
    const char* cA = (const char*)g.A + (size_t)cur.pm * tstep + (size_t)cur.kt0 * (BK * 2); const char* cB = (const char*)g.Bt + (size_t)cur.pn * tstep + (size_t)cur.kt0 * (BK * 2);
    S.a_ready(cur);
    if constexpr (SP2) {
        PG8_STAGE(PG8_SB(0, 0), cB, voffB); PG8_STAGE(PG8_SB(0, 1), cB + hstep, voffB); PG8_STAGE(PG8_SA(0, 0), cA, voffA); PG8_STAGE(PG8_SA(0, 1), cA + hstep, voffA);
        if (wr == 1) PG8_BAR;
        PG8_WAIT_V(2); PG8_BAR;
        PG8_STAGE(PG8_SB(1, 0), cB + kstep, voffB); PG8_STAGE(PG8_SA(1, 0), cA + kstep, voffA); PG8_STAGE(PG8_SB(1, 1), cB + hstep + kstep, voffB);
        PG8_WAIT_V(6); PG8_BAR;
    } else {
        PG8_STAGE(PG8_SB(0, 0), cB, voffB); PG8_STAGE(PG8_SA(0, 0), cA, voffA); PG8_STAGE(PG8_SB(0, 1), cB + hstep, voffB); PG8_STAGE(PG8_SA(0, 1), cA + hstep, voffA);
        if (wr == 1) PG8_BAR;
        PG8_WAIT_V(4); PG8_BAR;
        PG8_STAGE(PG8_SB(1, 0), cB + kstep, voffB); PG8_STAGE(PG8_SA(1, 0), cA + kstep, voffA); PG8_STAGE(PG8_SB(1, 1), cB + hstep + kstep, voffB);
        PG8_WAIT_V(6); PG8_BAR;
    }
    for (;;) {
        const bool has_next = S.next(ui + 1, nxt);
        const char* nA = has_next ? (const char*)g.A + (size_t)nxt.pm * tstep + (size_t)nxt.kt0 * (BK * 2) : cA; const char* nB = has_next ? (const char*)g.Bt + (size_t)nxt.pn * tstep + (size_t)nxt.kt0 * (BK * 2) : cB;
        const int nt = cur.nkt;
        for (int t = 0; t < nt; t += 2) {
            const bool last = (t == nt - 2);
            const char* a1 = cA + (size_t)(t + 1) * kstep;
            const char* a2 = last ? nA : cA + (size_t)(t + 2) * kstep; const char* b2 = last ? nB : cB + (size_t)(t + 2) * kstep;
            const char* a3 = a2 + kstep; const char* b3 = b2 + kstep;
            if (last && has_next) S.a_ready(nxt);
            if constexpr (SP2) {
            PG8_LDB(B0, 0, 0); PG8_LDB(B1, 0, 1); PG8_SCHED; PG8_LDA(At, 0, 0); PG8_STAGE(PG8_SA(1, 1), a1 + hstep, voffA);
            PG8_WAIT_V(8); PG8_WAIT_L(0); PG8_BAR; PG8_MMA(0, 0, At, B0); PG8_MMA(0, 1, At, B1); PG8_BAR; PG8_SCHED;
            PG8_LDA(At, 0, 1); PG8_STAGE(PG8_SB(0, 0), b2, voffB); PG8_STAGE(PG8_SB(0, 1), b2 + hstep, voffB); PG8_STAGE(PG8_SA(0, 0), a2, voffA);
            PG8_WAIT_V(8); PG8_WAIT_L(0); PG8_BAR; PG8_MMA(1, 0, At, B0); PG8_MMA(1, 1, At, B1); PG8_BAR; PG8_SCHED;
            PG8_LDB(B0, 1, 0); PG8_LDB(B1, 1, 1); PG8_SCHED; PG8_LDA(At, 1, 0); PG8_STAGE(PG8_SA(0, 1), a2 + hstep, voffA);
            PG8_WAIT_V(8); PG8_WAIT_L(0); PG8_BAR; PG8_MMA(0, 0, At, B0); PG8_MMA(0, 1, At, B1); PG8_BAR; PG8_SCHED;
            PG8_LDA(At, 1, 1); PG8_STAGE(PG8_SB(1, 0), b3, voffB); PG8_STAGE(PG8_SB(1, 1), b3 + hstep, voffB); PG8_STAGE(PG8_SA(1, 0), a3, voffA);
            PG8_WAIT_V(8); PG8_WAIT_L(0); PG8_BAR; PG8_MMA(1, 0, At, B0); PG8_MMA(1, 1, At, B1); PG8_BAR; PG8_SCHED;
            } else {
            PG8_LDB(B0, 0, 0); PG8_SCHED; PG8_LDA(At, 0, 0); PG8_STAGE(PG8_SA(1, 1), a1 + hstep, voffA);
            PG8_WAIT_L(8); PG8_BAR; PG8_WAIT_L(0); PG8_MMA(0, 0, At, B0); PG8_BAR; PG8_SCHED;
            PG8_LDB(B1, 0, 1); PG8_STAGE(PG8_SB(0, 0), b2, voffB);
            PG8_BAR; PG8_WAIT_L(0); PG8_MMA(0, 1, At, B1); PG8_BAR;
            PG8_LDA(At, 0, 1); PG8_STAGE(PG8_SA(0, 0), a2, voffA);
            PG8_BAR; PG8_WAIT_L(0); PG8_MMA(1, 0, At, B0); PG8_BAR; PG8_SCHED;
            PG8_STAGE(PG8_SB(0, 1), b2 + hstep, voffB);
            PG8_WAIT_V(6); PG8_BAR; PG8_MMA(1, 1, At, B1); PG8_BAR;
            PG8_LDB(B0, 1, 0); PG8_SCHED; PG8_LDA(At, 1, 0); PG8_STAGE(PG8_SA(0, 1), a2 + hstep, voffA);
            PG8_WAIT_L(8); PG8_BAR; PG8_WAIT_L(0); PG8_MMA(0, 0, At, B0); PG8_BAR; PG8_SCHED;
            PG8_LDB(B1, 1, 1); PG8_STAGE(PG8_SB(1, 0), b3, voffB);
            PG8_BAR; PG8_WAIT_L(0); PG8_MMA(0, 1, At, B1); PG8_BAR;
            PG8_LDA(At, 1, 1); PG8_STAGE(PG8_SA(1, 0), a3, voffA);
            PG8_BAR; PG8_WAIT_L(0); PG8_MMA(1, 0, At, B0); PG8_BAR; PG8_SCHED;
            PG8_STAGE(PG8_SB(1, 1), b3 + hstep, voffB);
            PG8_WAIT_V(6); PG8_BAR; PG8_MMA(1, 1, At, B1); PG8_BAR;
            }
        }
        if constexpr (ALIGN_EPI) { if (wr == 0) PG8_BAR; }
        if constexpr (!Epi::AFTER_DRAIN) { E(acc, cur, wr, wc, fr, fq); S.done(cur); }
        if (!has_next) break;
#pragma unroll
        for (int a = 0; a < 2; ++a)
#pragma unroll
            for (int b = 0; b < 2; ++b)
#pragma unroll
                for (int m = 0; m < 4; ++m)
#pragma unroll
                    for (int n = 0; n < 2; ++n) acc[a][b][m][n] = (f32x4){0.f, 0.f, 0.f, 0.f};
        cur = nxt; cA = nA; cB = nB; ++ui;
        if constexpr (ALIGN_EPI) { if (wr == 1) PG8_BAR; }
    }
    PG8_WAIT_V(0);
    if constexpr (!ALIGN_EPI) { if (wr == 0) PG8_BAR; }
    PG8_BAR;
    if constexpr (Epi::AFTER_DRAIN) { E.fused(acc, cur, wr, wc, fr, fq, lds, wid, lane); S.done(cur); }
#undef PG8_SA
#undef PG8_SB
#undef PG8_STAGE
#undef PG8_LDA
#undef PG8_LDB
#undef PG8_MMA
#undef PG8_WAIT_V
#undef PG8_WAIT_L
#undef PG8_BAR
#undef PG8_SCHED
}
}

constexpr int DM = 1024, NBATCH = 8, SEQ = 2048, CTXL = 256, DFF = 2816, NHEAD = 8;
constexpr int TL = NBATCH * SEQ;
constexpr int TC = NBATCH * CTXL;
constexpr int TT = TL + TC;
constexpr int KVN = SEQ + CTXL;
constexpr int NMODW = 9 * DM;
constexpr float C2 = 0.125f * 1.4426950408889634f;

constexpr size_t MiB = (size_t)1 << 20;
constexpr size_t OFF_MOD = 0;
constexpr size_t OFF_ROPE = 1536 * 1024;
constexpr size_t OFF_BAR = 1792 * 1024;
constexpr size_t OFF_WSS = 3 * MiB;
constexpr size_t OFF_WGU = 4 * MiB;
constexpr size_t OFF_WDN = OFF_WGU + 88 * MiB;
constexpr size_t OFF_WINA = OFF_WDN + 44 * MiB;
constexpr size_t OFF_WOUTA = OFF_WINA + 12 * MiB;
constexpr size_t OFF_WINS = OFF_WOUTA + 4 * MiB;
constexpr size_t OFF_WOUTS = OFF_WINS + 8 * MiB;
constexpr size_t OFF_H = OFF_WOUTS + 4 * MiB;
constexpr size_t OFF_XN = OFF_H + 72 * MiB;
constexpr size_t OFF_BIG = OFF_XN + 36 * MiB;
constexpr size_t OFF_PART = OFF_BIG + 108 * MiB;
constexpr size_t OFF_SGST2 = OFF_PART + 64 * MiB;
constexpr size_t WS_NEED = OFF_SGST2 + 6 * MiB;
constexpr size_t SZ_TOK = (size_t)TT * DM * 2;

#define LAS __attribute__((address_space(3)))
typedef unsigned short bf16;
typedef unsigned v4u __attribute__((ext_vector_type(4)));
typedef unsigned v2u __attribute__((ext_vector_type(2)));
typedef float f32x4 __attribute__((ext_vector_type(4)));
typedef float f32x16 __attribute__((ext_vector_type(16)));
typedef short bf16x8 __attribute__((ext_vector_type(8)));
typedef float f32x2_t __attribute__((ext_vector_type(2)));
typedef __bf16 bf16x2_t __attribute__((ext_vector_type(2)));

__device__ __forceinline__ unsigned pk2(float lo, float hi) { f32x2_t v = {lo, hi}; bf16x2_t b = __builtin_convertvector(v, bf16x2_t); return __builtin_bit_cast(unsigned, b); }
__device__ __forceinline__ bf16 f2bf(float f) { return (bf16)(pk2(f, 0.f) & 0xffffu); }
__device__ __forceinline__ float bf2f(unsigned b) { return __uint_as_float(b << 16); }
__device__ __forceinline__ f32x4 ldh4(const bf16* p) { const v2u r = *(const v2u*)p; return (f32x4){bf2f(r.x & 0xffffu), bf2f(r.x >> 16), bf2f(r.y & 0xffffu), bf2f(r.y >> 16)}; }
__device__ __forceinline__ void sth4(bf16* p, f32x4 v) { v2u w; w.x = pk2(v[0], v[1]); w.y = pk2(v[2], v[3]); *(v2u*)p = w; }
__device__ __forceinline__ float wave_sum(float v) {
#pragma unroll
    for (int o = 1; o < 64; o <<= 1) v += __shfl_xor(v, o);
    return v;
}
__device__ __forceinline__ float xhalf_max(float m) { auto rr = __builtin_amdgcn_permlane32_swap(__float_as_uint(m), __float_as_uint(m), false, false); return fmaxf(__uint_as_float(rr[0]), __uint_as_float(rr[1])); }
__device__ __forceinline__ float xhalf_sum(float m) { auto rr = __builtin_amdgcn_permlane32_swap(__float_as_uint(m), __float_as_uint(m), false, false); return __uint_as_float(rr[0]) + __uint_as_float(rr[1]); }
__device__ __forceinline__ float max3f(float a, float b, float c) { float r; asm("v_max3_f32 %0, %1, %2, %3" : "=v"(r) : "v"(a), "v"(b), "v"(c)); return r; }
__device__ __forceinline__ float fast_exp2(float x) { return __builtin_amdgcn_exp2f(x); }
__device__ __forceinline__ float fast_rcp(float x) { return __builtin_amdgcn_rcpf(x); }
__device__ __forceinline__ float silu_f(float a) { return a * fast_rcp(1.0f + fast_exp2(-1.4426950408889634f * a)); }
__device__ __forceinline__ float gelu_tanh_f(float x) { const float u = x + 0.044715f * x * x * x; return x * fast_rcp(1.0f + fast_exp2(-2.302208198f * u)); }
__device__ __forceinline__ int crow(int i, int h) { return (i & 3) + 8 * (i >> 2) + 4 * h; }
#define MFMA32(a, b, c) __builtin_amdgcn_mfma_f32_32x32x16_bf16((a), (b), (c), 0, 0, 0)

using pg8::Unit;
struct SplitOrder {
    pg8::StaticOrder lat; int G, c, nsl, nkt;
    __device__ __forceinline__ void init(int nsl_, int nkt_, int G_, int c_) { lat.init(TL, DM, G_, c_); lat.nkt_full = nkt_; G = G_; c = c_; nsl = nsl_; nkt = nkt_; }
    __device__ __forceinline__ bool next(int i, Unit& u) const {
        const int nrl = (256 + G - 1) / G;
        if (i < nrl) { if (lat.next(i, u)) return true; }
        const int q = (i - nrl) * G + c;
        if (i < nrl || q >= 32 * nsl) return false;
        const int tctx = q / nsl, sl = q % nsl, pairs = nkt >> 1, base = pairs / nsl, rem = pairs % nsl;
        u.pm = 64 + (tctx >> 2); u.pn = tctx & 3; u.kt0 = 2 * (sl * base + (sl < rem ? sl : rem)); u.nkt = 2 * (base + (sl < rem ? 1 : 0)); u.part = q; return true;
    }
    __device__ __forceinline__ void a_ready(const Unit&) const {}
    __device__ __forceinline__ void done(const Unit&) const {}
};
struct EpiSwiGLU {
    static constexpr bool PERM = true, AFTER_DRAIN = false;
    bf16* O;
    __device__ __forceinline__ void operator()(const f32x4 (&acc)[2][2][4][2], const Unit& u, int wr, int wc, int fr, int fq) const {
        const int row0 = u.pm * 256 + wr * 64 + fr, col0 = u.pn * 128 + wc * 32 + 8 * fq;
#pragma unroll
        for (int ai = 0; ai < 2; ++ai)
#pragma unroll
            for (int m = 0; m < 4; ++m) {
                bf16* p = O + (size_t)(row0 + ai * 128 + m * 16) * DFF + col0;
                const f32x4 a0 = acc[ai][0][m][0], a1 = acc[ai][0][m][1], u0 = acc[ai][1][m][0], u1 = acc[ai][1][m][1];
                v4u w;
                w.x = pk2(silu_f(a0[0]) * u0[0], silu_f(a0[1]) * u0[1]); w.y = pk2(silu_f(a0[2]) * u0[2], silu_f(a0[3]) * u0[3]);
                w.z = pk2(silu_f(a1[0]) * u1[0], silu_f(a1[1]) * u1[1]); w.w = pk2(silu_f(a1[2]) * u1[2], silu_f(a1[3]) * u1[3]);
                *(v4u*)p = w;
            }
    }
};
struct EpiResid {
    static constexpr bool PERM = true, AFTER_DRAIN = false;
    unsigned char* ws; const float* gate; int half;
    __device__ __forceinline__ void operator()(const f32x4 (&acc)[2][2][4][2], const Unit& u, int wr, int wc, int fr, int fq) const {
        bf16* H = (bf16*)(ws + OFF_H); bf16* part = (bf16*)(ws + OFF_PART); const float coef = half ? 0.5f : 1.0f;
        if (u.part >= 0) {
            bf16* pp = part + (size_t)u.part * 65536 + (size_t)(wr * 64 + fr) * 256 + wc * 32 + 8 * fq;
#pragma unroll
            for (int ai = 0; ai < 2; ++ai)
#pragma unroll
                for (int m = 0; m < 4; ++m)
#pragma unroll
                    for (int bj = 0; bj < 2; ++bj) {
                        const f32x4 x0 = acc[ai][bj][m][0], x1 = acc[ai][bj][m][1];
                        v4u w; w.x = pk2(x0[0], x0[1]); w.y = pk2(x0[2], x0[3]); w.z = pk2(x1[0], x1[1]); w.w = pk2(x1[2], x1[3]);
                        *(v4u*)(pp + (size_t)(ai * 128 + m * 16) * 256 + bj * 128) = w;
                    }
            return;
        }
        const int b9 = u.pm < 64 ? (u.pm >> 3) : 8;
        const float* gp = gate + (size_t)b9 * NMODW;
        const int row0 = u.pm * 256 + wr * 64 + fr;
#pragma unroll
        for (int bj = 0; bj < 2; ++bj) {
            const int col = u.pn * 256 + bj * 128 + wc * 32 + 8 * fq;
            const f32x4 gv0 = *(const f32x4*)(gp + col) * coef, gv1 = *(const f32x4*)(gp + col + 4) * coef;
            v4u h[2][4];
#pragma unroll
            for (int ai = 0; ai < 2; ++ai)
#pragma unroll
                for (int m = 0; m < 4; ++m) h[ai][m] = *(const v4u*)(H + (size_t)(row0 + ai * 128 + m * 16) * DM + col);
#pragma unroll
            for (int ai = 0; ai < 2; ++ai)
#pragma unroll
                for (int m = 0; m < 4; ++m) {
                    const v4u r = h[ai][m];
                    const f32x4 h0 = (f32x4){bf2f(r.x & 0xffffu), bf2f(r.x >> 16), bf2f(r.y & 0xffffu), bf2f(r.y >> 16)};
                    const f32x4 h1 = (f32x4){bf2f(r.z & 0xffffu), bf2f(r.z >> 16), bf2f(r.w & 0xffffu), bf2f(r.w >> 16)};
                    const f32x4 y0 = h0 + gv0 * acc[ai][bj][m][0], y1 = h1 + gv1 * acc[ai][bj][m][1];
                    v4u w; w.x = pk2(y0[0], y0[1]); w.y = pk2(y0[2], y0[3]); w.z = pk2(y1[0], y1[1]); w.w = pk2(y1[2], y1[3]);
                    *(v4u*)(H + (size_t)(row0 + ai * 128 + m * 16) * DM + col) = w;
                }
        }
    }
};
constexpr int XP_OFF = 131072 + 2048, XP_WAVE = 16 * 144;
__device__ __forceinline__ void xpose_write(LAS unsigned char* xl, const f32x4& v, int m, int rpos, int fq) {
#pragma unroll
    for (int i = 0; i < 4; ++i) *(LAS bf16*)(xl + (4 * fq + i) * 144 + (16 * m + rpos) * 2) = f2bf(v[i]);
}
__device__ __forceinline__ void xpose_flush(LAS unsigned char* xl, int lane, bf16* gbase, size_t colstride) {
    asm volatile("s_waitcnt lgkmcnt(0)" ::: "memory");
    const int c = lane >> 2, q = lane & 3;
    const v4u a = *(const LAS v4u*)(xl + c * 144 + q * 32), b = *(const LAS v4u*)(xl + c * 144 + q * 32 + 16);
    asm volatile("s_waitcnt lgkmcnt(0)" ::: "memory");
    bf16* p = gbase + (size_t)c * colstride + 16 * q;
    *(v4u*)p = a; *(v4u*)(p + 8) = b;
}
struct EpiQKV {
    static constexpr bool PERM = false, AFTER_DRAIN = false;
    bf16* Q; bf16* K; bf16* Vt; const float* rope; LAS unsigned char* xp;
    __device__ __forceinline__ void operator()(const f32x4 (&acc)[2][2][4][2], const Unit& u, int wr, int wc, int fr, int fq) const {
        const int sect = u.pn >> 2, ct = (u.pn & 3) * 256;
        const bool latent = u.pm < 64;
        if (sect < 2) {
            bf16* base = sect == 0 ? Q : K; const float sc = sect == 0 ? C2 : 1.0f;
            const int axis = wc & 1;
            f32x4 csv[2][4], snv[2][4];
#pragma unroll
            for (int ai = 0; ai < 2; ++ai)
#pragma unroll
                for (int m = 0; m < 4; ++m) {
                    const int row = u.pm * 256 + ai * 128 + wr * 64 + m * 16 + fr;
                    csv[ai][m] = (f32x4){1.f, 1.f, 1.f, 1.f}; snv[ai][m] = (f32x4){0.f, 0.f, 0.f, 0.f};
                    if (latent) { const int s = row & 2047; const int pos = axis ? (s & 63) : (s >> 6); csv[ai][m] = *(const f32x4*)(rope + pos * 32 + 4 * fq); snv[ai][m] = *(const f32x4*)(rope + pos * 32 + 16 + 4 * fq); }
                }
#pragma unroll
            for (int ai = 0; ai < 2; ++ai)
#pragma unroll
                for (int m = 0; m < 4; ++m) {
                    const int row = u.pm * 256 + ai * 128 + wr * 64 + m * 16 + fr;
                    const f32x4 cs = csv[ai][m], sn = snv[ai][m];
#pragma unroll
                    for (int bj = 0; bj < 2; ++bj) {
                        const f32x4 x1 = acc[ai][bj][m][0], x2 = acc[ai][bj][m][1];
                        const f32x4 o1 = (x1 * cs - x2 * sn) * sc, o2 = (x2 * cs + x1 * sn) * sc;
                        bf16* p = base + (size_t)row * DM + ct + bj * 128 + wc * 32 + 8 * fq;
                        v4u w; w.x = pk2(o1[0], o1[1]); w.y = pk2(o1[2], o1[3]); w.z = pk2(o2[0], o2[1]); w.w = pk2(o2[2], o2[3]);
                        *(v4u*)p = w;
                    }
                }
        } else {
            const int swz = (fr & 3) | ((fr & 4) << 1) | ((fr & 8) >> 1);
            const int lane = fq * 16 + fr;
            LAS unsigned char* xl = xp + (wr * 4 + wc) * XP_WAVE;
#pragma unroll
            for (int ai = 0; ai < 2; ++ai) {
                const int rowblk = u.pm * 256 + ai * 128 + wr * 64;
                int b, kv0; if (latent) { b = rowblk >> 11; kv0 = rowblk & 2047; } else { const int rr = rowblk - TL; b = rr >> 8; kv0 = SEQ + (rr & 255); }
#pragma unroll
                for (int bj = 0; bj < 2; ++bj) {
                    const int hd = (u.pn - 8) * 2 + bj;
#pragma unroll
                    for (int n = 0; n < 2; ++n)
                    {
#pragma unroll
                        for (int m = 0; m < 4; ++m) xpose_write(xl, acc[ai][bj][m][n], m, swz, fq);
                        xpose_flush(xl, lane, Vt + ((size_t)(b * NHEAD + hd) * 128 + wc * 32 + n * 16) * KVN + kv0, (size_t)KVN);
                    }
                }
            }
        }
    }
};
struct EpiSG {
    static constexpr bool PERM = false, AFTER_DRAIN = false;
    bf16* ZU; bf16* ZVT; float* stats; LAS unsigned char* xp;
    __device__ __forceinline__ void operator()(const f32x4 (&acc_c)[2][2][4][2], const Unit& u, int wr, int wc, int fr, int fq) const {
        f32x4 (&acc)[2][2][4][2] = const_cast<f32x4 (&)[2][2][4][2]>(acc_c);
#pragma unroll
        for (int ai = 0; ai < 2; ++ai)
#pragma unroll
            for (int bj = 0; bj < 2; ++bj)
#pragma unroll
                for (int m = 0; m < 4; ++m)
#pragma unroll
                    for (int n = 0; n < 2; ++n)
#pragma unroll
                        for (int i = 0; i < 4; ++i) acc[ai][bj][m][n][i] = gelu_tanh_f(acc[ai][bj][m][n][i]);
        const int sect = u.pn >> 2, ct = (u.pn & 3) * 256;
        if (sect == 0) {
#pragma unroll
            for (int ai = 0; ai < 2; ++ai)
#pragma unroll
                for (int m = 0; m < 4; ++m) {
                    const int row = u.pm * 256 + ai * 128 + wr * 64 + m * 16 + fr;
#pragma unroll
                    for (int bj = 0; bj < 2; ++bj)
#pragma unroll
                        for (int n = 0; n < 2; ++n) {
                            const f32x4 x = acc[ai][bj][m][n];
                            v2u w; w.x = pk2(x[0], x[1]); w.y = pk2(x[2], x[3]);
                            *(v2u*)(ZU + (size_t)row * DM + ct + bj * 128 + wc * 32 + n * 16 + 4 * fq) = w;
                        }
                }
        } else {
            const int lane = fq * 16 + fr;
            LAS unsigned char* xl = xp + (wr * 4 + wc) * XP_WAVE;
#pragma unroll
            for (int ai = 0; ai < 2; ++ai) {
                const int rowblk = u.pm * 256 + ai * 128 + wr * 64;
                const int chunk = rowblk >> 7, s0 = rowblk & 127;
#pragma unroll
                for (int m = 0; m < 4; ++m) {
                    float a1 = 0.f, a2 = 0.f;
#pragma unroll
                    for (int bj = 0; bj < 2; ++bj)
#pragma unroll
                        for (int n = 0; n < 2; ++n)
#pragma unroll
                            for (int i = 0; i < 4; ++i) { const float z = acc[ai][bj][m][n][i]; a1 += z; a2 += z * z; }
                    a1 += __shfl_xor(a1, 16); a1 += __shfl_xor(a1, 32); a2 += __shfl_xor(a2, 16); a2 += __shfl_xor(a2, 32);
                    if (fq == 0) { float* sp = stats + ((size_t)(rowblk + m * 16 + fr) * 16 + (u.pn - 4) * 4 + wc) * 2; sp[0] = a1; sp[1] = a2; }
                }
#pragma unroll
                for (int bj = 0; bj < 2; ++bj)
#pragma unroll
                    for (int n = 0; n < 2; ++n) {
#pragma unroll
                        for (int m = 0; m < 4; ++m) xpose_write(xl, acc[ai][bj][m][n], m, fr, fq);
                        xpose_flush(xl, lane, ZVT + ((size_t)chunk * DM + ct + bj * 128 + wc * 32 + n * 16) * 128 + s0, (size_t)128);
                    }
            }
        }
    }
};

template <class T> __device__ __forceinline__ T* as_global(T* p) { return (T*)(__attribute__((address_space(1))) T*)p; }
#define GAS __attribute__((address_space(1)))
struct Args { GAS const float* in_[20]; GAS float* out_; GAS unsigned char* ws_; };
typedef __attribute__((address_space(4))) const Args CArgs;
struct ArgView { CArgs* p;
    __device__ __forceinline__ const float* in(int i) const { return (const float*)p->in_[i]; }
    __device__ __forceinline__ float* out() const { return (float*)p->out_; }
    __device__ __forceinline__ unsigned char* ws() const { return (unsigned char*)p->ws_; } };
enum { I_X = 0, I_C, I_CTX, I_CCTX, I_WMOD, I_BMOD, I_NORMG, I_WGU, I_WDN, I_DAIN, I_DAOUT, I_DALAM, I_DASUB, I_SGIN, I_SGLNG, I_SGLNB, I_SGWS, I_SGBS, I_SGOUT, I_FINALG };

__device__ __forceinline__ ArgView get_args() { CArgs* p = (CArgs*)__builtin_amdgcn_kernarg_segment_ptr(); asm volatile("" : "+s"(p)); ArgView v; v.p = p; return v; }
__device__ __forceinline__ void transpose_item(const float* W, int K, int N, bf16* WT, int k0, int n0, int drow0, LAS float* scr, int lane) {
    float rv[32];
#pragma unroll
    for (int i = 0; i < 32; ++i) rv[i] = W[(size_t)(k0 + 2 * i + (lane >> 5)) * N + n0 + (lane & 31)];
#pragma unroll
    for (int i = 0; i < 32; ++i) scr[(2 * i + (lane >> 5)) * 33 + (lane & 31)] = rv[i];
    asm volatile("s_waitcnt lgkmcnt(0)" ::: "memory");
    const int c = lane & 7;
#pragma unroll
    for (int j = 0; j < 4; ++j) { const int n = (lane >> 3) + 8 * j; const LAS float* s = scr + (8 * c) * 33 + n;
        v4u o; o.x = pk2(s[0 * 33], s[1 * 33]); o.y = pk2(s[2 * 33], s[3 * 33]); o.z = pk2(s[4 * 33], s[5 * 33]); o.w = pk2(s[6 * 33], s[7 * 33]);
        *(v4u*)(WT + (size_t)(drow0 + n) * K + k0 + 8 * c) = o; }
    asm volatile("s_waitcnt lgkmcnt(0)" ::: "memory");
}

__device__ __forceinline__ int conv_layer_count(int L) { return (L & 1) ? 9984 : 10496; }
__device__ __forceinline__ int conv_idle(int nwg, int G) { return (nwg % G) ? G - nwg % G : 0; }
__device__ __forceinline__ int conv_idle_phase(int l, int which, int G) {
    if (l > 2) return 0;
    if (which == 0) return conv_idle((TT / 256) * 22, G);
    if (which == 1) return conv_idle((TT / 256) * ((l & 1) ? 8 : 12), G);
    return conv_idle(((l < 2 ? TT : TL) / 256) * 22, G);
}
__device__ __forceinline__ int conv_idle_total(int l, int G) { return conv_idle_phase(l, 0, G) + conv_idle_phase(l, 1, G) + conv_idle_phase(l, 2, G); }
__device__ __forceinline__ void conv_layer_items(const ArgView& a, unsigned char* ws, int L, int first, int last, int w, int W, LAS float* scr, int lane) {
    constexpr int I_GU = 16 * 176, I_DN = 44 * 32, I_AIN = 16 * 96, I_SQ = 16 * 32, I_SIN = 16 * 64;
    const int j = L >> 1;
    for (int it = first + w; it < last; it += W) {
        if (it < 2 * I_GU) { const int mi = 2 * L + it / I_GU, r = it % I_GU, kb = r / 176, nb = r % 176; const int n0 = nb * 32; const int jj = n0 < DFF ? n0 : n0 - DFF; const int half = n0 < DFF ? 0 : 1;
            transpose_item(a.in(I_WGU) + (size_t)mi * DM * 2 * DFF, DM, 2 * DFF, (bf16*)(ws + OFF_WGU) + (size_t)mi * 2 * DFF * DM, kb * 64, n0, 256 * (jj >> 7) + 128 * half + (jj & 127), scr, lane); }
        else if (it < 2 * I_GU + 2 * I_DN) { const int q = it - 2 * I_GU, mi = 2 * L + q / I_DN, r = q % I_DN, kb = r / 32, nb = r % 32;
            transpose_item(a.in(I_WDN) + (size_t)mi * DFF * DM, DFF, DM, (bf16*)(ws + OFF_WDN) + (size_t)mi * DM * DFF, kb * 64, nb * 32, nb * 32, scr, lane); }
        else if ((L & 1) == 0) { const int q = it - 2 * I_GU - 2 * I_DN;
            if (q < I_AIN) { const int kb = q / 96, nb = q % 96;
                transpose_item(a.in(I_DAIN) + (size_t)j * DM * 3 * DM, DM, 3 * DM, (bf16*)(ws + OFF_WINA) + (size_t)j * 3 * DM * DM, kb * 64, nb * 32, nb * 32, scr, lane); }
            else { const int r = q - I_AIN, kb = r / 32, nb = r % 32;
                transpose_item(a.in(I_DAOUT) + (size_t)j * DM * DM, DM, DM, (bf16*)(ws + OFF_WOUTA) + (size_t)j * DM * DM, kb * 64, nb * 32, nb * 32, scr, lane); } }
        else { const int q = it - 2 * I_GU - 2 * I_DN;
            if (q < I_SIN) { const int kb = q / 64, nb = q % 64;
                transpose_item(a.in(I_SGIN) + (size_t)j * DM * 2 * DM, DM, 2 * DM, (bf16*)(ws + OFF_WINS) + (size_t)j * 2 * DM * DM, kb * 64, nb * 32, nb * 32, scr, lane); }
            else { const int r = q - I_SIN, kb = r / 32, nb = r % 32;
                transpose_item(a.in(I_SGOUT) + (size_t)j * DM * DM, DM, DM, (bf16*)(ws + OFF_WOUTS) + (size_t)j * DM * DM, kb * 64, nb * 32, nb * 32, scr, lane); } }
    }
}
__device__ __forceinline__ void prologue(LAS unsigned char* lds, int blk, int G, int tid) {
    const int lane = tid & 63, wave = tid >> 6;
    const ArgView a = get_args();
    unsigned char* ws = a.ws();
    {
        LAS float* sc = (LAS float*)lds; LAS float* red = sc + 9 * DM;
        for (int i = tid; i < 9 * DM; i += 512) { const int b = i >> 10, k = i & 1023; const float v = b < 8 ? a.in(I_C)[b * DM + k] : a.in(I_CCTX)[k]; sc[i] = v / (1.0f + __expf(-v)); }
        __syncthreads();
        float* MOD = (float*)(ws + OFF_MOD);
        LAS float* red4 = sc + 9 * DM;
        for (int it = blk; it < 4 * 36; it += G) {
            const int l = it / 36, n0 = (it % 36) * 256, kp = tid >> 6, ln = tid & 63;
            const float* wp = a.in(I_WMOD) + ((size_t)l * DM + kp * 128) * NMODW + n0 + 4 * ln;
            f32x4 a0 = {0.f, 0.f, 0.f, 0.f}, a1 = a0, a2 = a0, a3 = a0, a4 = a0, a5 = a0, a6 = a0, a7 = a0, a8 = a0;
            const LAS float* sp = sc + kp * 128;
#pragma unroll 2
            for (int kk = 0; kk < 128; kk += 4) {
                const f32x4 w0 = *(const f32x4*)(wp + (size_t)kk * NMODW), w1 = *(const f32x4*)(wp + (size_t)(kk + 1) * NMODW), w2 = *(const f32x4*)(wp + (size_t)(kk + 2) * NMODW), w3 = *(const f32x4*)(wp + (size_t)(kk + 3) * NMODW);
#define MOD_ACC(ab, b) do { const f32x4 s_ = *(const LAS f32x4*)(sp + (b) * DM + kk); ab += w0 * s_[0] + w1 * s_[1] + w2 * s_[2] + w3 * s_[3]; } while (0)
                MOD_ACC(a0, 0); MOD_ACC(a1, 1); MOD_ACC(a2, 2); MOD_ACC(a3, 3); MOD_ACC(a4, 4); MOD_ACC(a5, 5); MOD_ACC(a6, 6); MOD_ACC(a7, 7); MOD_ACC(a8, 8);
#undef MOD_ACC
            }
            LAS f32x4* rp = (LAS f32x4*)(red4 + (size_t)kp * 9 * 256) + ln;
            rp[0] = a0; rp[64] = a1; rp[128] = a2; rp[192] = a3; rp[256] = a4; rp[320] = a5; rp[384] = a6; rp[448] = a7; rp[512] = a8;
            __syncthreads();
            for (int o = tid; o < 9 * 256; o += 512) {
                const int b = o >> 8, cc = o & 255; float s = 0.f;
#pragma unroll
                for (int k8 = 0; k8 < 8; ++k8) s += red4[(k8 * 9 + b) * 256 + cc];
                MOD[(size_t)(l * 9 + b) * NMODW + n0 + cc] = s + a.in(I_BMOD)[l * NMODW + n0 + cc];
            }
            __syncthreads();
        }
    }
#ifdef PROBE_XMASK
    if (tid == 0) { LAS unsigned* pacc_ = (LAS unsigned*)(lds + 131072 + 1024); const unsigned t_ = (unsigned)__builtin_amdgcn_s_memrealtime(); pacc_[10] += t_ - pacc_[16]; pacc_[16] = t_; }
#endif
    if (blk == G - 1) {
        float* rope = (float*)(ws + OFF_ROPE);
        for (int idx = tid; idx < 64 * 16; idx += 512) {
            const int pos = idx >> 4, f = idx & 15;
            const float inv = exp2f(-(float)f * 0.8304820237218406f);
            const float ang = (float)pos * inv;
            const double x = (double)ang; const double kq = rint(x * 0.15915494309189535); const double r = x - kq * 6.283185307179586476925;
            const double r2 = r * r; double ts = r, tc = 1.0, ss = r, cc = 1.0;
            for (int n = 1; n <= 16; ++n) { tc *= -r2 / (double)((2 * n - 1) * (2 * n)); ts *= -r2 / (double)((2 * n) * (2 * n + 1)); cc += tc; ss += ts; }
            rope[pos * 32 + f] = (float)cc; rope[pos * 32 + 16 + f] = (float)ss;
        }
    }
    {
        const int gt = blk * 512 + tid, NT = G * 512;
        bf16* wss = (bf16*)(ws + OFF_WSS);
        for (int i = gt; i < 2 * 8 * 128 * 128; i += NT) wss[i] = f2bf(a.in(I_SGWS)[i]);
    }
    __syncthreads();
    {
        LAS float* scr = (LAS float*)(lds + wave * 16384);
        for (int L = 0; L < 4; ++L)
            if (L == 0 || conv_idle_total(L - 1, G) == 0) {
                if (G > 4 * 36 + 32) { if (blk >= 4 * 36) conv_layer_items(a, ws, L, 0, conv_layer_count(L), (blk - 4 * 36) * 8 + wave, (G - 4 * 36) * 8, scr, lane); }
                else conv_layer_items(a, ws, L, 0, conv_layer_count(L), blk * 8 + wave, G * 8, scr, lane);
            }
    }
#ifdef PROBE_XMASK
    __syncthreads();
    if (tid == 0) { LAS unsigned* pacc_ = (LAS unsigned*)(lds + 131072 + 1024); const unsigned t_ = (unsigned)__builtin_amdgcn_s_memrealtime(); pacc_[11] += t_ - pacc_[16]; pacc_[16] = t_; }
#endif
}

template <bool INIT>
__device__ __forceinline__ void norm_phase(const float* x_lat, const float* x_ctx, bf16* H, bf16* XN, const float* g, const float* modl, int ishift, int iscale, int Mrows, int gw, int NGW, int lane,
                                           const bf16* part, int nsl, const float* pgate, float pcoef) {
    const int rpw = (TL + NGW - 1) / NGW;
    f32x4 gs[4], sh[4]; int curb = -1;
    constexpr int R = 4;
    for (int i0 = 0; i0 < rpw; i0 += R) {
        f32x4 v[R][4]; float ss[R];
#pragma unroll
        for (int q = 0; q < R; ++q) {
            int row = gw * rpw + i0 + q; if (i0 + q >= rpw || row >= TL) row = gw * rpw < TL ? gw * rpw : 0;
#pragma unroll
            for (int j = 0; j < 4; ++j) v[q][j] = INIT ? ((const f32x4*)(x_lat + (size_t)row * DM))[lane + 64 * j] : ldh4(H + (size_t)row * DM + 4 * lane + 256 * j);
        }
#pragma unroll
        for (int q = 0; q < R; ++q) { float s = 0.f;
#pragma unroll
            for (int j = 0; j < 4; ++j) s += (v[q][j][0] * v[q][j][0] + v[q][j][1] * v[q][j][1]) + (v[q][j][2] * v[q][j][2] + v[q][j][3] * v[q][j][3]);
            ss[q] = s; }
#pragma unroll
        for (int o = 1; o < 64; o <<= 1) {
#pragma unroll
            for (int q = 0; q < R; ++q) ss[q] += __shfl_xor(ss[q], o);
        }
#pragma unroll
        for (int q = 0; q < R; ++q) {
            const int row = gw * rpw + i0 + q;
            if (i0 + q < rpw && row < TL) {
                const int b9 = row >> 11;
                if (b9 != curb) { curb = b9; const float* mp = modl + (size_t)b9 * NMODW;
#pragma unroll
                    for (int j = 0; j < 4; ++j) { const int col = 4 * lane + 256 * j; gs[j] = *(const f32x4*)(g + col) * (*(const f32x4*)(mp + iscale * DM + col) + 1.0f); sh[j] = *(const f32x4*)(mp + ishift * DM + col); } }
                const float rstd = 1.0f / sqrtf(ss[q] * (1.0f / DM) + 1e-6f);
#pragma unroll
                for (int j = 0; j < 4; ++j) {
                    const int col = 4 * lane + 256 * j;
                    const f32x4 y = (v[q][j] * rstd) * gs[j] + sh[j];
                    v2u w; w.x = pk2(y[0], y[1]); w.y = pk2(y[2], y[3]);
                    *(v2u*)(XN + (size_t)row * DM + col) = w;
                    if (INIT) sth4(H + (size_t)row * DM + col, v[q][j]);
                }
            }
        }
    }
    for (int row = TL + gw; row < Mrows; row += NGW) {
        f32x4 v[4];
#pragma unroll
        for (int j = 0; j < 4; ++j) v[j] = INIT ? ((const f32x4*)(x_ctx + (size_t)(row - TL) * DM))[lane + 64 * j] : ldh4(H + (size_t)row * DM + 4 * lane + 256 * j);
        if (nsl > 0) {
            const int rr = row - TL, pmc = rr >> 8, r = rr & 255;
#pragma unroll
            for (int j = 0; j < 4; ++j) {
                const bf16* pb = part + ((size_t)(pmc * 4 + j) * nsl) * 65536 + (size_t)r * 256 + 4 * lane;
                f32x4 pv[8];
#pragma unroll
                for (int sl = 0; sl < 8; ++sl) pv[sl] = sl < nsl ? ldh4(pb + (size_t)sl * 65536) : (f32x4){0.f, 0.f, 0.f, 0.f};
                const f32x4 sacc = ((pv[0] + pv[1]) + (pv[2] + pv[3])) + ((pv[4] + pv[5]) + (pv[6] + pv[7]));
                v[j] = v[j] + (*(const f32x4*)(pgate + 4 * lane + 256 * j) * pcoef) * sacc;
                sth4(H + (size_t)row * DM + 4 * lane + 256 * j, v[j]);
            }
        }
        float s = 0.f;
#pragma unroll
        for (int j = 0; j < 4; ++j) s += (v[j][0] * v[j][0] + v[j][1] * v[j][1]) + (v[j][2] * v[j][2] + v[j][3] * v[j][3]);
        s = wave_sum(s);
        const float rstd = 1.0f / sqrtf(s * (1.0f / DM) + 1e-6f);
        const float* mp = modl + (size_t)8 * NMODW;
#pragma unroll
        for (int j = 0; j < 4; ++j) {
            const int col = 4 * lane + 256 * j;
            const f32x4 gg = *(const f32x4*)(g + col), sc = *(const f32x4*)(mp + iscale * DM + col), s4 = *(const f32x4*)(mp + ishift * DM + col);
            const f32x4 y = (v[j] * rstd) * gg * (sc + 1.0f) + s4;
            v2u w; w.x = pk2(y[0], y[1]); w.y = pk2(y[2], y[3]);
            *(v2u*)(XN + (size_t)row * DM + col) = w;
            if (INIT) sth4(H + (size_t)row * DM + col, v[j]);
        }
    }
}
__device__ __forceinline__ void final_norm_phase(const bf16* H, float* out, const float* g, int gw, int NGW, int lane) {
    const int rpw = (TL + NGW - 1) / NGW;
    f32x4 gg[4];
#pragma unroll
    for (int j = 0; j < 4; ++j) gg[j] = *(const f32x4*)(g + 4 * lane + 256 * j);
    constexpr int R = 4;
    for (int i0 = 0; i0 < rpw; i0 += R) {
        f32x4 v[R][4]; float ss[R];
#pragma unroll
        for (int q = 0; q < R; ++q) {
            int row = gw * rpw + i0 + q; if (i0 + q >= rpw || row >= TL) row = gw * rpw < TL ? gw * rpw : 0;
#pragma unroll
            for (int j = 0; j < 4; ++j) v[q][j] = ldh4(H + (size_t)row * DM + 4 * lane + 256 * j);
        }
#pragma unroll
        for (int q = 0; q < R; ++q) { float s = 0.f;
#pragma unroll
            for (int j = 0; j < 4; ++j) s += (v[q][j][0] * v[q][j][0] + v[q][j][1] * v[q][j][1]) + (v[q][j][2] * v[q][j][2] + v[q][j][3] * v[q][j][3]);
            ss[q] = s; }
#pragma unroll
        for (int o = 1; o < 64; o <<= 1) {
#pragma unroll
            for (int q = 0; q < R; ++q) ss[q] += __shfl_xor(ss[q], o);
        }
#pragma unroll
        for (int q = 0; q < R; ++q) {
            const int row = gw * rpw + i0 + q;
            if (i0 + q < rpw && row < TL) {
                const float rstd = 1.0f / sqrtf(ss[q] * (1.0f / DM) + 1e-6f);
#pragma unroll
                for (int j = 0; j < 4; ++j) *(f32x4*)(out + (size_t)row * DM + 4 * lane + 256 * j) = (v[q][j] * rstd) * gg[j];
            }
        }
    }
}

constexpr int AT_KB = 64 * 256, AT_VB = 128 * 128, AT_K0 = 0, AT_V0 = 3 * AT_KB;
template <int VAR>
__device__ __forceinline__ void attn_phase(LAS unsigned char* lds, const bf16* Q, const bf16* K, const bf16* Vt, bf16* AO, const float* lam4, const float* subg, float lam_init, bool ctxq, int G, int blk, int tid) {
    const int lane = tid & 63, wave = __builtin_amdgcn_readfirstlane(tid >> 6), rg = wave & 3, r = wave >> 2, q32 = lane & 31, hi = lane >> 5;
    float lamv;
    { float x = 0.f, y = 0.f;
      for (int i = 0; i < 64; ++i) { x += lam4[i] * lam4[64 + i]; y += lam4[128 + i] * lam4[192 + i]; }
      lamv = __expf(x) - __expf(y) + lam_init; }
    const int nunits = 1024 + (ctxq ? 128 : 0);
    const int vcu = (G % 8 == 0) ? (blk % 8) * (G / 8) + blk / 8 : blk;
    for (int uidx = vcu; uidx < nunits; uidx += G) {
        int b, h, qrow0, t0, t1;
        if (uidx < 1024) { b = uidx >> 7; h = (uidx >> 4) & 7; qrow0 = b * SEQ + (uidx & 15) * 128; t0 = 0; t1 = 36; }
        else { const int v = uidx - 1024; b = v >> 4; h = (v >> 1) & 7; qrow0 = TL + b * CTXL + (v & 1) * 128; t0 = 32; t1 = 36; }
        bf16x8 qf[4];
        { const bf16* qp = Q + (size_t)(qrow0 + rg * 32 + q32) * DM + h * 128 + r * 64 + hi * 8;
#pragma unroll
          for (int d0 = 0; d0 < 4; ++d0) qf[d0] = *(const bf16x8*)(qp + d0 * 16);
#pragma unroll
          for (int d0 = 0; d0 < 4; ++d0) asm volatile("" : "+v"(qf[d0])); }
        f32x16 o[4];
#pragma unroll
        for (int db = 0; db < 4; ++db)
#pragma unroll
            for (int i = 0; i < 16; ++i) o[db][i] = 0.f;
        float mrun = 0.f, lrun = 0.f;
        f32x16 negm;
#pragma unroll
        for (int i = 0; i < 16; ++i) negm[i] = 0.f;
        const bf16* kbase = K + h * 128;
        const bf16* vbase = Vt + (size_t)(b * NHEAD + h) * 128 * KVN;
#define AT_ROWB(t) ((t) < 32 ? (size_t)b * SEQ + (size_t)(t) * 64 : (size_t)TL + (size_t)b * CTXL + (size_t)((t) - 32) * 64)
#define AT_DMA(t, kbuf, vbuf) do { const char* kp_ = (const char*)kbase + AT_ROWB(t) * (size_t)(DM * 2); const char* vp_ = (const char*)vbase + (size_t)(t) * 128; \
            _Pragma("unroll") for (int i_ = 0; i_ < 2; ++i_) { \
                const int krow_ = 8 * wave + 4 * i_ + (lane >> 4); \
                __builtin_amdgcn_global_load_lds((const unsigned*)(kp_ + (size_t)krow_ * (DM * 2) + (((lane & 15) ^ (krow_ & 15)) * 16)), (LAS unsigned*)(lds + AT_K0 + (kbuf) * AT_KB + wave * 2048 + i_ * 1024), 16, 0, 0); } \
            _Pragma("unroll") for (int i_ = 0; i_ < 2; ++i_) { \
                const int vrow_ = 16 * wave + 8 * i_ + (lane >> 3); \
                __builtin_amdgcn_global_load_lds((const unsigned*)(vp_ + (size_t)vrow_ * (KVN * 2) + (((lane & 7) ^ ((vrow_ >> 1) & 7)) * 16)), (LAS unsigned*)(lds + AT_V0 + (vbuf) * AT_VB + wave * 2048 + i_ * 1024), 16, 0, 0); } } while (0)
#define AT_SB() __builtin_amdgcn_sched_barrier(0)
        unsigned kfo[4], vfo[4];
#pragma unroll
        for (int i = 0; i < 4; ++i) { kfo[i] = (unsigned)(q32 * 256 + (((r * 8 + 2 * i + hi) ^ (q32 & 15)) * 16)); vfo[i] = (unsigned)(q32 * 128 + (((2 * i + hi) ^ ((q32 >> 1) & 7)) * 16)); }
#define AT_QK(S0, S1, buf) do { const LAS unsigned char* kb_ = lds + AT_K0 + (buf) * AT_KB; bf16x8 kf_[4]; \
            _Pragma("unroll") for (int d_ = 0; d_ < 2; ++d_) { kf_[2 * d_] = *(const LAS bf16x8*)(kb_ + kfo[d_]); kf_[2 * d_ + 1] = *(const LAS bf16x8*)(kb_ + 32 * 256 + kfo[d_]); } \
            AT_SB(); \
            S0 = MFMA32(kf_[0], qf[0], negm); S1 = MFMA32(kf_[1], qf[0], negm); \
            S0 = MFMA32(kf_[2], qf[1], S0); S1 = MFMA32(kf_[3], qf[1], S1); \
            AT_SB(); \
            _Pragma("unroll") for (int d_ = 0; d_ < 2; ++d_) { kf_[2 * d_] = *(const LAS bf16x8*)(kb_ + kfo[d_ + 2]); kf_[2 * d_ + 1] = *(const LAS bf16x8*)(kb_ + 32 * 256 + kfo[d_ + 2]); } \
            AT_SB(); \
            S0 = MFMA32(kf_[0], qf[2], S0); S1 = MFMA32(kf_[1], qf[2], S1); S0 = MFMA32(kf_[2], qf[3], S0); S1 = MFMA32(kf_[3], qf[3], S1); } while (0)
        bf16x8 va[4];
#pragma unroll
        for (int i = 0; i < 4; ++i) va[i] = (bf16x8){0, 0, 0, 0, 0, 0, 0, 0};
#define AT_PV_PRE(VB) do { const LAS unsigned char* vb = lds + AT_V0 + (VB) * AT_VB; \
            _Pragma("unroll") for (int ks = 0; ks < 4; ++ks) va[ks] = *(const LAS bf16x8*)(vb + vfo[ks]); } while (0)
#define AT_PV_RUN(PF, VB) do { const LAS unsigned char* vb = lds + AT_V0 + (VB) * AT_VB; bf16x8 vc[4], ve[4]; \
            _Pragma("unroll") for (int ks = 0; ks < 4; ++ks) vc[ks] = *(const LAS bf16x8*)(vb + 1 * 32 * 128 + vfo[ks]); \
            _Pragma("unroll") for (int ks = 0; ks < 4; ++ks) ve[ks] = *(const LAS bf16x8*)(vb + 2 * 32 * 128 + vfo[ks]); \
            AT_SB(); __builtin_amdgcn_s_setprio(1); \
            _Pragma("unroll") for (int ks = 0; ks < 4; ++ks) o[0] = MFMA32(va[ks], PF[ks], o[0]); \
            AT_SB(); \
            _Pragma("unroll") for (int ks = 0; ks < 4; ++ks) va[ks] = *(const LAS bf16x8*)(vb + 3 * 32 * 128 + vfo[ks]); \
            AT_SB(); \
            _Pragma("unroll") for (int ks = 0; ks < 4; ++ks) o[1] = MFMA32(vc[ks], PF[ks], o[1]); \
            AT_SB(); \
            _Pragma("unroll") for (int ks = 0; ks < 4; ++ks) o[2] = MFMA32(ve[ks], PF[ks], o[2]); \
            AT_SB(); \
            _Pragma("unroll") for (int ks = 0; ks < 4; ++ks) o[3] = MFMA32(va[ks], PF[ks], o[3]); \
            __builtin_amdgcn_s_setprio(0); \
            AT_SB(); } while (0)
#define AT_STEP(C0, C1, t) do { \
            if (!(VAR & 8)) { if ((t) + 2 < t1) AT_DMA((t) + 2, (kc + 2) % 3, (vc4 + 2) & 3); } \
            if (!(VAR & 2)) { if (r == 1 && (t) > t0) AT_PV_PRE((vc4 + 3) & 3); } \
            if (!(VAR & 4)) AT_QK(C0, C1, kc); else { C0 = negm; C1 = negm; }    \
            if (!(VAR & 2)) { if (r == 1 && (t) > t0) AT_PV_RUN(pfp, (vc4 + 3) & 3); if (r == 0) AT_PV_PRE(vc4); } \
            AT_SB(); \
            asm volatile("s_nop 15\n\ts_nop 7" : "+v"(C0), "+v"(C1));     \
            if (!(VAR & 1)) { \
            float rm, rb_; \
            rm = max3f(C0[0], C0[1], C1[0]); rb_ = max3f(C0[2], C0[3], C1[1]); rm = max3f(rm, C1[2], C1[3]); \
            _Pragma("unroll") for (int i = 4; i < 16; i += 4) { rm = max3f(rm, C0[i], C0[i + 1]); rb_ = max3f(rb_, C0[i + 2], C0[i + 3]); rm = max3f(rm, C1[i], C1[i + 1]); rb_ = max3f(rb_, C1[i + 2], C1[i + 3]); } \
            rm = xhalf_max(fmaxf(rm, rb_)); \
            if (__any(rm > 8.0f) || (t) == t0) { const float dl = (t) == t0 ? rm : fmaxf(rm, 0.f), alpha = fast_exp2(-dl); mrun += dl; lrun *= alpha; \
                _Pragma("unroll") for (int i = 0; i < 16; ++i) { C0[i] -= dl; C1[i] -= dl; negm[i] = -mrun; } \
                _Pragma("unroll") for (int db = 0; db < 4; ++db) _Pragma("unroll") for (int i = 0; i < 16; ++i) o[db][i] *= alpha; } \
            f32x2_t ps_ = (f32x2_t){0.f, 0.f}; \
            _Pragma("unroll") for (int i = 0; i < 16; i += 2) { C0[i] = fast_exp2(C0[i]); C0[i + 1] = fast_exp2(C0[i + 1]); C1[i] = fast_exp2(C1[i]); C1[i + 1] = fast_exp2(C1[i + 1]); \
                ps_ += (f32x2_t){C0[i], C0[i + 1]}; ps_ += (f32x2_t){C1[i], C1[i + 1]}; } \
            lrun += ps_[0] + ps_[1]; \
            } \
            { v4u w; \
              w.x = pk2(C0[0], C0[1]); w.y = pk2(C0[2], C0[3]); w.z = pk2(C0[4], C0[5]); w.w = pk2(C0[6], C0[7]); pfp[0] = __builtin_bit_cast(bf16x8, w); \
              w.x = pk2(C0[8], C0[9]); w.y = pk2(C0[10], C0[11]); w.z = pk2(C0[12], C0[13]); w.w = pk2(C0[14], C0[15]); pfp[1] = __builtin_bit_cast(bf16x8, w); \
              w.x = pk2(C1[0], C1[1]); w.y = pk2(C1[2], C1[3]); w.z = pk2(C1[4], C1[5]); w.w = pk2(C1[6], C1[7]); pfp[2] = __builtin_bit_cast(bf16x8, w); \
              w.x = pk2(C1[8], C1[9]); w.y = pk2(C1[10], C1[11]); w.z = pk2(C1[12], C1[13]); w.w = pk2(C1[14], C1[15]); pfp[3] = __builtin_bit_cast(bf16x8, w); } \
            AT_SB(); \
            if (!(VAR & 2)) { if (r == 0) AT_PV_RUN(pfp, vc4); } \
            if (!(VAR & 8) && (t) + 2 < t1) asm volatile("s_waitcnt vmcnt(4) lgkmcnt(0)" ::: "memory"); else asm volatile("s_waitcnt vmcnt(0) lgkmcnt(0)" ::: "memory"); \
            __builtin_amdgcn_s_barrier(); asm volatile("" ::: "memory"); \
            kc = (kc + 1) % 3; vc4 = (vc4 + 1) & 3; } while (0)
        bf16x8 pfp[4];
#pragma unroll
        for (int i = 0; i < 4; ++i) pfp[i] = (bf16x8){0, 0, 0, 0, 0, 0, 0, 0};
        int kc = 0, vc4 = 0;
        AT_DMA(t0, 0, 0); AT_DMA(t0 + 1, 1, 1);
        asm volatile("s_waitcnt vmcnt(4) lgkmcnt(0)" ::: "memory"); __builtin_amdgcn_s_barrier(); asm volatile("" ::: "memory");
        for (int t = t0; t < t1; ++t) {
            f32x16 sa0, sa1;
            AT_STEP(sa0, sa1, t);
        }
        if (!(VAR & 2)) { if (r == 1) { AT_PV_PRE((vc4 + 3) & 3); AT_PV_RUN(pfp, (vc4 + 3) & 3); } }
        __syncthreads();
#undef AT_PV_PRE
#undef AT_PV_RUN
#undef AT_ROWB
#undef AT_DMA
#undef AT_SB
#undef AT_QK
#undef AT_STEP
        lrun = xhalf_sum(lrun);
        const float inv = 1.0f / lrun;
        LAS float* xch = (LAS float*)lds + rg * 4096;
        if (r == 1) {
#pragma unroll
            for (int db = 0; db < 4; ++db)
#pragma unroll
                for (int i = 0; i < 16; ++i) xch[(db * 16 + i) * 64 + lane] = o[db][i] * inv;
        }
        __syncthreads();
        if (r == 0) {
            float ss = 0.f;
#pragma unroll
            for (int db = 0; db < 4; ++db)
#pragma unroll
                for (int i = 0; i < 16; ++i) { const float d = o[db][i] * inv - lamv * xch[(db * 16 + i) * 64 + lane]; o[db][i] = d; ss += d * d; }
            ss = xhalf_sum(ss);
            const float rn = (1.0f / sqrtf(ss * (1.0f / 128.0f) + 1e-6f)) * (1.0f - lam_init);
            bf16* op = AO + (size_t)(qrow0 + rg * 32 + q32) * DM + h * 128;
#pragma unroll
            for (int db = 0; db < 4; ++db)
#pragma unroll
                for (int i4 = 0; i4 < 4; ++i4) {
                    const int dcol = 32 * db + 8 * i4 + 4 * hi;
                    const f32x4 g4 = *(const f32x4*)(subg + dcol);
                    v2u w; w.x = pk2(o[db][4 * i4] * rn * g4[0], o[db][4 * i4 + 1] * rn * g4[1]); w.y = pk2(o[db][4 * i4 + 2] * rn * g4[2], o[db][4 * i4 + 3] * rn * g4[3]);
                    *(v2u*)(op + dcol) = w;
                }
        }
        __syncthreads();
    }
}

__device__ __forceinline__ void sgmix_phase(LAS unsigned char* lds, const bf16* ZU, const bf16* ZVT, const float* stats, const bf16* WS, const float* bs, const float* lng, const float* lnb, bf16* Gout, int nchunks, int G, int blk, int tid) {
    const int lane = tid & 63, wave = __builtin_amdgcn_readfirstlane(tid >> 6), q32 = lane & 31, hi = lane >> 5;
    const int vcu = (G % 8 == 0) ? (blk % 8) * (G / 8) + blk / 8 : blk;
    const int tb = wave >> 1, ch = wave & 1;
    int buf = 0;
    for (int u = vcu; u < nchunks * 8; u += G, buf ^= 1) {
        const int chunk = u >> 3, g = u & 7;
        LAS unsigned char* tile = lds + buf * 34816;
        LAS float* smu = (LAS float*)(lds + 69632 + buf * 1024); LAS float* srs = smu + 128;
        const bf16* wp = WS + ((size_t)g * 128 + tb * 32 + q32) * 128 + hi * 8;
        bf16x8 wf[8];
#pragma unroll
        for (int k = 0; k < 8; ++k) wf[k] = *(const bf16x8*)(wp + k * 16);
        const int t = tb * 32 + q32; const size_t row = (size_t)chunk * 128 + t;
        const float bias = bs[g * 128 + t];
        v2u ug[2][4];
#pragma unroll
        for (int cb = 0; cb < 2; ++cb)
#pragma unroll
            for (int i4 = 0; i4 < 4; ++i4) ug[cb][i4] = *(const v2u*)(ZU + row * DM + g * 128 + ch * 64 + cb * 32 + 8 * i4 + 4 * hi);
        v4u raw[4];
#pragma unroll
        for (int it = 0; it < 4; ++it) { const int idx = it * 512 + tid, c = idx >> 4, s8 = (idx & 15) * 8; raw[it] = *(const v4u*)(ZVT + ((size_t)chunk * DM + g * 128 + c) * 128 + s8); }
        {
            const int r = tid >> 2, part = tid & 3;
            const f32x4* sp = (const f32x4*)(stats + ((size_t)(chunk * 128 + r) * 16 + part * 4) * 2);
            const f32x4 a0 = sp[0], a1 = sp[1];
            float s1 = (a0[0] + a0[2]) + (a1[0] + a1[2]), s2 = (a0[1] + a0[3]) + (a1[1] + a1[3]);
            s1 += __shfl_xor(s1, 1); s2 += __shfl_xor(s2, 1); s1 += __shfl_xor(s1, 2); s2 += __shfl_xor(s2, 2);
            if (part == 0) { const float mu = s1 * (1.0f / DM); const float var = fmaxf(s2 * (1.0f / DM) - mu * mu, 0.f); smu[r] = mu; srs[r] = 1.0f / sqrtf(var + 1e-5f); }
        }
        __syncthreads();
#pragma unroll
        for (int it = 0; it < 4; ++it) {
            const int idx = it * 512 + tid, c = idx >> 4, s8 = (idx & 15) * 8;
            const float gg = lng[g * 128 + c], bb = lnb[g * 128 + c];
            float y[8];
#pragma unroll
            for (int j = 0; j < 4; ++j) { const unsigned wv = raw[it][j];
                y[2 * j] = (bf2f(wv & 0xffffu) - smu[s8 + 2 * j]) * srs[s8 + 2 * j] * gg + bb;
                y[2 * j + 1] = (bf2f(wv >> 16) - smu[s8 + 2 * j + 1]) * srs[s8 + 2 * j + 1] * gg + bb; }
            v4u w; w.x = pk2(y[0], y[1]); w.y = pk2(y[2], y[3]); w.z = pk2(y[4], y[5]); w.w = pk2(y[6], y[7]);
            *(LAS v4u*)(tile + c * 272 + s8 * 2) = w;
        }
        __syncthreads();
        f32x16 acc0, acc1;
#pragma unroll
        for (int i = 0; i < 16; ++i) { acc0[i] = 0.f; acc1[i] = 0.f; }
        const LAS unsigned char* bp = tile + (ch * 64 + q32) * 272 + hi * 16;
#pragma unroll
        for (int k = 0; k < 8; ++k) {
            const bf16x8 b0 = *(const LAS bf16x8*)(bp + k * 32), b1 = *(const LAS bf16x8*)(bp + 32 * 272 + k * 32);
            acc0 = MFMA32(b0, wf[k], acc0); acc1 = MFMA32(b1, wf[k], acc1);
        }
#pragma unroll
        for (int i4 = 0; i4 < 4; ++i4) {
            const int col = g * 128 + ch * 64 + 8 * i4 + 4 * hi;
            const f32x4 u0 = (f32x4){bf2f(ug[0][i4].x & 0xffffu), bf2f(ug[0][i4].x >> 16), bf2f(ug[0][i4].y & 0xffffu), bf2f(ug[0][i4].y >> 16)};
            const f32x4 u1 = (f32x4){bf2f(ug[1][i4].x & 0xffffu), bf2f(ug[1][i4].x >> 16), bf2f(ug[1][i4].y & 0xffffu), bf2f(ug[1][i4].y >> 16)};
            const f32x4 m0 = (f32x4){acc0[4 * i4], acc0[4 * i4 + 1], acc0[4 * i4 + 2], acc0[4 * i4 + 3]}, m1 = (f32x4){acc1[4 * i4], acc1[4 * i4 + 1], acc1[4 * i4 + 2], acc1[4 * i4 + 3]};
            sth4(Gout + row * DM + col, (m0 + bias) * u0);
            sth4(Gout + row * DM + col + 32, (m1 + bias) * u1);
        }
    }
    __syncthreads();
}

#define XB_TMO      128
#define XB_XCNT(j)  (256  + 64 * (j))
#define XB_XSUB(j)  (1280 + 64 * (j))
#define XB_XGEN(j)  (2304 + 64 * (j))
#define XB_TOP      3328
#define XB_TOPGEN   3392
#define XCD_BAR_WORDS 3456
#define XB_SPIN_CAP (1u << 18)

__device__ __forceinline__ unsigned xb_ld(unsigned* p)              { return __hip_atomic_load(p, __ATOMIC_RELAXED, __HIP_MEMORY_SCOPE_AGENT); }
__device__ __forceinline__ unsigned xb_add(unsigned* p, unsigned v) { return __hip_atomic_fetch_add(p, v, __ATOMIC_RELAXED, __HIP_MEMORY_SCOPE_AGENT); }
__device__ __forceinline__ unsigned xb_xcc_id() { return (unsigned)__builtin_amdgcn_s_getreg((3 << 11) | 20) & 0xFu; }
#define XB_SPIN(cond, bar) do { unsigned _sp = 0; while (cond) { __builtin_amdgcn_s_sleep(1); \
    if ((++_sp & 255u) == 0u) { if (xb_ld(&(bar)[XB_TMO])) break; if (_sp > XB_SPIN_CAP) { atomicAdd(&(bar)[XB_TMO], 1u); break; } } } } while (0)

struct XcdBarrier {
    unsigned* bar; unsigned x;
    volatile LAS unsigned* st;
};

__device__ __forceinline__ XcdBarrier xcd_barrier_post(unsigned* bar, volatile LAS unsigned* st) {
    XcdBarrier b; b.bar = bar; b.x = xb_xcc_id(); b.st = st;
    if (threadIdx.x == 0) (void)xb_add(&bar[XB_XCNT(b.x)], 1u);
    return b;
}
__device__ __forceinline__ void xcd_barrier_complete(unsigned* bar, unsigned x, unsigned& nloc, unsigned& nx) {
    const unsigned G = gridDim.x * gridDim.y * gridDim.z;
    unsigned sum, cnt, mine, sp = 0u;
    for (;;) {
        sum = 0u; cnt = 0u; mine = 0u;
#pragma unroll
        for (unsigned j = 0; j < 16; ++j) { const unsigned c = xb_ld(&bar[XB_XCNT(j)]); sum += c; cnt += (c > 0u) ? 1u : 0u; mine = (j == x) ? c : mine; }
        if (sum == G) break;
        __builtin_amdgcn_s_sleep(1);
        if ((++sp & 255u) == 0u) { if (xb_ld(&bar[XB_TMO])) break; if (sp > XB_SPIN_CAP) { atomicAdd(&bar[XB_TMO], 1u); break; } }
    }
    nloc = mine > 0u ? mine : 1u; nx = cnt > 0u ? cnt : 1u;
}

__device__ __forceinline__ void xcd_barrier(const XcdBarrier& b) {
    asm volatile("s_waitcnt vmcnt(0)" ::: "memory");
    __syncthreads();
    if (threadIdx.x == 0) {
        unsigned* bar = b.bar;
        __builtin_amdgcn_s_waitcnt(0);
        unsigned nloc = b.st[0], nx = b.st[1];
        if (nloc == 0u) { xcd_barrier_complete(bar, b.x, nloc, nx); b.st[0] = nloc; b.st[1] = nx; }
        const unsigned old = xb_add(&bar[XB_XSUB(b.x)], 1u);
        const unsigned gen = old / nloc;
        if (old + 1u == (gen + 1u) * nloc) {
            __builtin_amdgcn_fence(__ATOMIC_RELEASE, "agent");
            asm volatile("s_waitcnt vmcnt(0)" ::: "memory");
            const unsigned og = xb_add(&bar[XB_TOP], 1u);
            const unsigned tg = og / nx;
            if (og + 1u == (tg + 1u) * nx) xb_add(&bar[XB_TOPGEN], 1u);
            else XB_SPIN(xb_ld(&bar[XB_TOPGEN]) == tg, bar);
            __builtin_amdgcn_fence(__ATOMIC_ACQUIRE, "agent");
            xb_add(&bar[XB_XGEN(b.x)], 1u);
            asm volatile("s_waitcnt vmcnt(0)" ::: "memory");
        } else {
            XB_SPIN(xb_ld(&bar[XB_XGEN(b.x)]) == gen, bar);
            __builtin_amdgcn_fence(__ATOMIC_ACQUIRE, "agent");
            asm volatile("s_waitcnt vmcnt(0)" ::: "memory");
        }
    }
    __syncthreads();
}

constexpr int LDS_BYTES = 131072 + 2048 + 8 * XP_WAVE;
__global__ void __launch_bounds__(512, 2) hybrid_fwd(Args a) {
    extern __shared__ __attribute__((aligned(16))) unsigned char lds_raw[];
    LAS unsigned char* lds = (LAS unsigned char*)lds_raw;
    cg::grid_group grid = cg::this_grid();
    const int G = gridDim.x, blk = blockIdx.x;
    if (threadIdx.x < 4) ((LAS unsigned*)(lds + 131072 + 512))[threadIdx.x] = 0u;
    __syncthreads();
    (void)xcd_barrier_post((unsigned*)(get_args().ws() + OFF_BAR), (volatile LAS unsigned*)(lds + 131072 + 512));
#define GRID_BARRIER() do { XcdBarrier xb_; xb_.bar = (unsigned*)(get_args().ws() + OFF_BAR); xb_.x = (unsigned)__builtin_amdgcn_readfirstlane((int)xb_xcc_id()); xb_.st = (volatile LAS unsigned*)(lds + 131072 + 512); xcd_barrier(xb_); } while (0)

#ifdef PROBE_XMASK
    LAS unsigned* pacc = (LAS unsigned*)(lds + 131072 + 1024);
    if (threadIdx.x == 0) { for (int i = 0; i < 16; ++i) pacc[i] = 0u; const unsigned long long t = __builtin_amdgcn_s_memrealtime(); pacc[16] = (unsigned)t; }
#define PSTAMP(type) do { if (threadIdx.x == 0) { const unsigned t_ = (unsigned)__builtin_amdgcn_s_memrealtime(); pacc[(type)] += t_ - pacc[16]; pacc[16] = t_; } } while (0)
#else
#define PSTAMP(type) do {} while (0)
#endif
#ifndef DIS_PRO
    prologue(lds, blk, G, threadIdx.x);
#endif
    if (G == 0x7fffffff) grid.sync();
    GRID_BARRIER();
    PSTAMP(0);

    for (int ph = 0; ph < 41; ++ph) {
        int tid = threadIdx.x; asm volatile("" : "+v"(tid));
        const int lane = tid & 63, wave = __builtin_amdgcn_readfirstlane(tid >> 6);
        const int gw = blk * 8 + wave, NGW = G * 8;
        const ArgView a = get_args();
        unsigned char* ws = a.ws();
        bf16* H = (bf16*)(ws + OFF_H);
        bf16* XN = (bf16*)(ws + OFF_XN);
        bf16* BIG = (bf16*)(ws + OFF_BIG);
        const float* MOD = (const float*)(ws + OFF_MOD);
        if (ph == 40) { final_norm_phase(H, a.out(), a.in(I_FINALG), gw, NGW, lane);
#ifdef PROBE_XMASK
            GRID_BARRIER(); PSTAMP(9);
            if (blk == 0 && threadIdx.x == 0) {
                unsigned xt = 0, yt = 0;
                for (int i = 0; i < 16; ++i) { if ((PROBE_XMASK >> i) & 1) xt += pacc[i]; if ((PROBE_YMASK >> i) & 1) yt += pacc[i]; }
                const unsigned xus = xt / 100u, yq = (yt / 100u + 16u) / 32u;
                const unsigned long long spin = ((unsigned long long)xus + 2048ull * yq) * 100ull, t0 = __builtin_amdgcn_s_memrealtime();
                while (__builtin_amdgcn_s_memrealtime() - t0 < spin) __builtin_amdgcn_s_sleep(32);
            }
#endif
            break; }
        const int l = ph / 10, s = ph % 10, j = l >> 1;
        const bool attn_layer = (l & 1) == 0;
        const float* modl = MOD + (size_t)l * 9 * NMODW;
        int Mrows = TT; if (l == 3 || (l == 2 && s >= 6)) Mrows = TL;
        if (s == 0 || s == 3 || s == 7) {
            const int k = s == 0 ? 0 : (s == 3 ? 1 : 2);
            const bool init = (ph == 0);
#ifndef DIS_NORM
            int pl = l, pg = 2, pn = 0; float pc = 0.5f;
            if (k == 0) { pl = l - 1; pg = 8; pn = (l == 1 || l == 2) ? 8 : 0; }
            else if (k == 1) { pg = 2; pn = (l <= 2) ? 8 : 0; }
            else { pg = 5; pc = 1.0f; pn = (l <= 1) ? 4 : 0; }
            if (pl < 0) pl = 0;
            if (init) norm_phase<true>(a.in(I_X), a.in(I_CTX), H, XN, a.in(I_NORMG) + (size_t)(l * 3 + k) * DM, modl, 3 * k, 3 * k + 1, Mrows, gw, NGW, lane, (const bf16*)(ws + OFF_PART), 0, MOD, pc);
            else norm_phase<false>(nullptr, nullptr, H, XN, a.in(I_NORMG) + (size_t)(l * 3 + k) * DM, modl, 3 * k, 3 * k + 1, Mrows, gw, NGW, lane,
                       (const bf16*)(ws + OFF_PART), pn, MOD + (size_t)(pl * 9 + 8) * NMODW + pg * DM, pc);
#endif
        } else if (s == 1 || s == 8) {
            const int f = s == 1 ? 0 : 1;
            pg8::Gemm g{XN, (const bf16*)(ws + OFF_WGU) + (size_t)(l * 2 + f) * 2 * DFF * DM, Mrows, 2 * DFF, DM};
            pg8::StaticOrder S; S.init(Mrows, 2 * DFF, G, blk); S.nkt_full = DM / 64;
            EpiSwiGLU E{BIG};
#ifndef DIS_GU
            pg8::gemm_phase<EpiSwiGLU, pg8::StaticOrder, true, true>(lds, g, S, E);
#endif
        } else if (s == 2 || s == 9 || s == 6) {
            const bf16* A; const bf16* Bt; int Kd; int gidx; float coef;
            if (s == 6) { A = XN; Kd = DM; gidx = 5; coef = 1.0f; Bt = attn_layer ? (const bf16*)(ws + OFF_WOUTA) + (size_t)j * DM * DM : (const bf16*)(ws + OFF_WOUTS) + (size_t)j * DM * DM; }
            else { const int f = s == 2 ? 0 : 1; A = BIG; Kd = DFF; gidx = s == 2 ? 2 : 8; coef = 0.5f; Bt = (const bf16*)(ws + OFF_WDN) + (size_t)(l * 2 + f) * DM * DFF; }
            pg8::Gemm g{A, Bt, Mrows, DM, Kd};
            SplitOrder S; S.init(Mrows == TT ? (Kd == DFF ? 8 : 4) : 0, Kd / 64, G, blk);
            EpiResid E{ws, modl + gidx * DM, coef == 0.5f ? 1 : 0};
#ifndef DIS_RES
            pg8::gemm_phase<EpiResid, SplitOrder, true, true>(lds, g, S, E);
#endif
        } else if (s == 4) {
            if (attn_layer) {
                pg8::Gemm g{XN, (const bf16*)(ws + OFF_WINA) + (size_t)j * 3 * DM * DM, Mrows, 3 * DM, DM};
                pg8::StaticOrder S; S.init(Mrows, 3 * DM, G, blk); S.nkt_full = DM / 64;
                EpiQKV E{BIG, (bf16*)((unsigned char*)BIG + SZ_TOK), (bf16*)((unsigned char*)BIG + 2 * SZ_TOK), (const float*)(ws + OFF_ROPE), lds + XP_OFF};
#ifndef DIS_QKV
                pg8::gemm_phase<EpiQKV, pg8::StaticOrder, true, true>(lds, g, S, E);
#endif
            } else {
                pg8::Gemm g{XN, (const bf16*)(ws + OFF_WINS) + (size_t)j * 2 * DM * DM, Mrows, 2 * DM, DM};
                pg8::StaticOrder S; S.init(Mrows, 2 * DM, G, blk); S.nkt_full = DM / 64;
                EpiSG E{BIG, (bf16*)((unsigned char*)BIG + SZ_TOK), (float*)(ws + OFF_SGST2) + (size_t)j * TT * 32, lds + XP_OFF};
#ifndef DIS_SG
                pg8::gemm_phase<EpiSG, pg8::StaticOrder, true, true>(lds, g, S, E);
#endif
            }
        } else {
            if (attn_layer) {
                const float lam_init = 0.8f - 0.6f * __expf(-0.3f * (float)l);
#ifndef DIS_ATT
                attn_phase<0>(lds, BIG, (const bf16*)((unsigned char*)BIG + SZ_TOK), (const bf16*)((unsigned char*)BIG + 2 * SZ_TOK), XN, a.in(I_DALAM) + j * 256, a.in(I_DASUB) + j * 128, lam_init, l == 0, G, blk, tid);
#ifdef PROBE_ATT
                if (l == 0) attn_phase<PROBE_ATT>(lds, BIG, (const bf16*)((unsigned char*)BIG + SZ_TOK), (const bf16*)((unsigned char*)BIG + 2 * SZ_TOK), (bf16*)(ws + OFF_PART), a.in(I_DALAM) + j * 256, a.in(I_DASUB) + j * 128, lam_init, false, G, blk, tid);
#endif
#endif
            } else {
#ifndef DIS_MIX
                sgmix_phase(lds, BIG, (const bf16*)((unsigned char*)BIG + SZ_TOK), (const float*)(ws + OFF_SGST2) + (size_t)j * TT * 32, (const bf16*)(ws + OFF_WSS) + (size_t)j * 8 * 128 * 128,
                            a.in(I_SGBS) + j * 8 * 128, a.in(I_SGLNG) + j * DM, a.in(I_SGLNB) + j * DM, XN, Mrows / 128, G, blk, tid);
#endif
            }
        }
        if (l < 3 && (s == 1 || s == 4 || s == 8)) {
            const int which = s == 1 ? 0 : (s == 4 ? 1 : 2);
            const int nid = conv_idle_phase(l, which, G), tot_idle = conv_idle_total(l, G);
            const int nwg = which == 0 ? (TT / 256) * 22 : (which == 1 ? (TT / 256) * (attn_layer ? 12 : 8) : ((l < 2 ? TT : TL) / 256) * 22);
            const int rem = nwg % G;
            if (nid > 0 && blk >= rem) {
                const int L = l + 1, tot = conv_layer_count(L);
                const int before = which == 0 ? 0 : (which == 1 ? conv_idle_phase(l, 0, G) : conv_idle_phase(l, 0, G) + conv_idle_phase(l, 1, G));
                const int first = (int)((long long)tot * before / tot_idle), last = (int)((long long)tot * (before + nid) / tot_idle);
                conv_layer_items(a, ws, L, first, last, (blk - rem) * 8 + wave, nid * 8, (LAS float*)(lds + wave * 16384), lane);
            }
        }
        GRID_BARRIER();
#ifdef PROBE_SYNC3
        GRID_BARRIER(); GRID_BARRIER();
#endif
        PSTAMP(s == 0 || s == 3 || s == 7 ? 1 : (s == 1 || s == 8 ? 2 : (s == 2 || s == 9 ? 3 : (s == 6 ? 4 : (s == 4 ? (attn_layer ? 5 : 6) : (attn_layer ? 7 : 8))))));
    }
}

extern "C" void kernel_launch(void* const* d_in, const int* in_sizes, int n_in, void* d_out, int out_size, void* d_ws, size_t ws_size, hipStream_t stream) {
    static int grid = 0;
    if (grid == 0) {
        if (n_in != 20 || ws_size < WS_NEED || out_size != TL * DM) { fprintf(stderr, "kernel_launch: unexpected problem (n_in %d, ws %zu, out %d)\n", n_in, ws_size, out_size); grid = -1; return; }
        int dev = 0, cus = 0, per_cu = 0;
        if (hipGetDevice(&dev) != hipSuccess || hipDeviceGetAttribute(&cus, hipDeviceAttributeMultiprocessorCount, dev) != hipSuccess) { grid = -1; return; }
        if (hipFuncSetAttribute((const void*)hybrid_fwd, hipFuncAttributeMaxDynamicSharedMemorySize, LDS_BYTES) != hipSuccess) { fprintf(stderr, "kernel_launch: hipFuncSetAttribute failed\n"); grid = -1; return; }
        if (hipOccupancyMaxActiveBlocksPerMultiprocessor(&per_cu, (const void*)hybrid_fwd, 512, LDS_BYTES) != hipSuccess || per_cu < 1) { fprintf(stderr, "kernel_launch: occupancy query says %d\n", per_cu); per_cu = 1; }
        (void)hipGetLastError();
        grid = cus;
    }
    if (grid < 0) return;
    if (hipMemsetAsync((char*)d_ws + OFF_BAR, 0, 16384, stream) != hipSuccess) { fprintf(stderr, "kernel_launch: memset failed\n"); return; }
    Args a{};
    for (int i = 0; i < 20; ++i) a.in_[i] = (GAS const float*)d_in[i];
    a.out_ = (GAS float*)d_out; a.ws_ = (GAS unsigned char*)d_ws;
    void* params[] = {&a};
    hipError_t e = hipLaunchCooperativeKernel((const void*)hybrid_fwd, dim3(grid), dim3(512), params, LDS_BYTES, stream);
    if (e != hipSuccess) fprintf(stderr, "kernel_launch: cooperative launch failed: %s (grid %d)\n", hipGetErrorString(e), grid);
}
```

```cpp
#include <hip/hip_runtime.h>
#include <hip/hip_cooperative_groups.h>
#include <cstdio>
#include <cstdint>
namespace cg = cooperative_groups;
namespace pg8 {
#define PG8_LAS __attribute__((address_space(3)))
typedef unsigned short bf16_t;
typedef short bf16x8 __attribute__((ext_vector_type(8)));
typedef float f32x4 __attribute__((ext_vector_type(4)));
typedef unsigned u32x4 __attribute__((ext_vector_type(4)));
constexpr int BM = 256, BK = 64, HALF = 128, HTB = HALF * BK * 2  , STAGE_BYTES = 8 * HTB, NXCD = 8, WGM = 8;

__host__ __device__ __forceinline__ int lds_byte(int r, int c) { const int st = (r >> 4) * 2 + (c >> 5), rr = r & 15, cc = c & 31, ob = rr * 64 + cc * 2; return st * 1024 + (ob ^ (((ob >> 9) & 1) << 5)); }
__host__ __device__ __forceinline__ void stage_rc(int b, int& R, int& C) { const int st = b / 1024, sb = b % 1024, swz = sb ^ (((sb >> 9) & 1) << 5); R = (st >> 1) * 16 + swz / 64; C = (st & 1) * 32 + (swz % 64) / 2; }
__host__ __device__ __forceinline__ int perm32(int rho) { const int n = rho >> 4, i = rho & 15; return 8 * (i >> 2) + 4 * n + (i & 3); }

struct Unit { int pm, pn, kt0, nkt, part; };
struct Gemm { const bf16_t* A; const bf16_t* Bt; int M, N, K; };

struct StaticOrder {
    int nM, nN, nwg, G, c, nkt_full;
    __host__ __device__ void init(int M, int N, int G_, int c_) { nM = M / BM; nN = N / BM; nwg = nM * nN; G = G_; c = c_; }
    __host__ __device__ bool next(int i, Unit& u) const {
        const long L = (long)i * G + c; if (L >= nwg) return false;
        int wgid = (int)L; { const int q = nwg / NXCD, r = nwg % NXCD, xcd = wgid % NXCD, off = wgid / NXCD; wgid = (xcd < r ? xcd * (q + 1) : r * (q + 1) + (xcd - r) * q) + off; }
        const int nig = WGM * nN, gid = wgid / nig, fm = gid * WGM, gsz = (nM - fm) < WGM ? (nM - fm) : WGM;
        u.pm = fm + ((wgid % nig) % gsz); u.pn = (wgid % nig) / gsz; u.kt0 = 0; u.nkt = nkt_full; u.part = -1; return true;
    }
    __device__ __forceinline__ void a_ready(const Unit&) const {}
    __device__ __forceinline__ void done(const Unit&) const {}
};
__device__ __forceinline__ unsigned cvt_pk_bf16(float lo, float hi) { unsigned r; asm volatile("v_cvt_pk_bf16_f32 %0, %1, %2" : "=v"(r) : "v"(lo), "v"(hi)); return r; }
typedef float f32x2 __attribute__((ext_vector_type(2)));
template <class Epi, class Sched, bool ALIGN_EPI = false, bool SP2 = false>
__device__ __forceinline__ void gemm_phase(PG8_LAS unsigned char* lds, const Gemm g, const Sched& S, const Epi& E) {
    int tid_ = threadIdx.x; asm volatile("" : "+v"(tid_)); const int tid = tid_, wid = __builtin_amdgcn_readfirstlane(tid >> 6), lane = tid & 63, wr = wid >> 2, wc = wid & 3, fr = lane & 15, fq = lane >> 4;
    const int K = g.K;
    unsigned voffA[2], voffB[2];
#pragma unroll
    for (int i = 0; i < 2; ++i) { int R, C; stage_rc(tid * 16 + i * 8192, R, C); const int Rb = Epi::PERM ? ((R & ~31) + perm32(R & 31)) : R;
        voffA[i] = (unsigned)(R * K + C) * 2u; voffB[i] = (unsigned)(Rb * K + C) * 2u; }
    const size_t kstep = (size_t)(BK * 2);
    const size_t hstep = (size_t)HALF * K * 2;
    const size_t tstep = 2 * hstep;
    const unsigned ldsw = (unsigned)wid * 1024u;
    const int aoff = lds_byte(wr * 64 + fr, fq * 8), boff = lds_byte(wc * 32 + fr, fq * 8);
#define PG8_SA(b, h) (((b) * 2 + (h)) * HTB)
#define PG8_SB(b, h) ((4 + (b) * 2 + (h)) * HTB)
#define PG8_STAGE(bufoff, gbase, voff) do { _Pragma("unroll") for (int _i = 0; _i < 2; ++_i) \
        __builtin_amdgcn_global_load_lds((const unsigned*)((const char*)(gbase) + (voff)[_i]), (PG8_LAS unsigned*)(lds + (bufoff) + ldsw + _i * 8192), 16, 0, 0); } while (0)
#define PG8_LDA(dst, b, h) do { _Pragma("unroll") for (int m = 0; m < 4; ++m) _Pragma("unroll") for (int k = 0; k < 2; ++k) dst[m][k] = *(const PG8_LAS bf16x8*)(lds + PG8_SA(b, h) + aoff + m * 2048 + k * 1024); } while (0)
#define PG8_LDB(dst, b, h) do { _Pragma("unroll") for (int n = 0; n < 2; ++n) _Pragma("unroll") for (int k = 0; k < 2; ++k) dst[n][k] = *(const PG8_LAS bf16x8*)(lds + PG8_SB(b, h) + boff + n * 2048 + k * 1024); } while (0)
#define PG8_MMA(ai, bj, At, Bt) do { __builtin_amdgcn_s_setprio(1); _Pragma("unroll") for (int m = 0; m < 4; ++m) _Pragma("unroll") for (int n = 0; n < 2; ++n) _Pragma("unroll") for (int k = 0; k < 2; ++k) \
        acc[ai][bj][m][n] = __builtin_amdgcn_mfma_f32_16x16x32_bf16(Bt[n][k], At[m][k], acc[ai][bj][m][n], 0, 0, 0); __builtin_amdgcn_s_setprio(0); } while (0)
#define PG8_WAIT_V(n) asm volatile("s_waitcnt vmcnt(" #n ")" ::: "memory")
#define PG8_WAIT_L(n) asm volatile("s_waitcnt lgkmcnt(" #n ")" ::: "memory")
#define PG8_BAR __builtin_amdgcn_s_barrier()
#define PG8_SCHED __builtin_amdgcn_sched_barrier(0)
    Unit cur, nxt; int ui = 0;
    if (!S.next(0, cur)) return;
    f32x4 acc[2][2][4][2];
#pragma unroll
    for (int a = 0; a < 2; ++a)
#pragma unroll
        for (int b = 0; b < 2; ++b)
#pragma unroll
            for (int m = 0; m < 4; ++m)
#pragma unroll
                for (int n = 0; n < 2; ++n) acc[a][b][m][n] = (f32x4){0.f, 0.f, 0.f, 0.f};
    bf16x8 At[4][2], B0[2][2], B1[2][2];
    const char* cA = (const char*)g.A + (size_t)cur.pm * tstep + (size_t)cur.kt0 * (BK * 2); const char* cB = (const char*)g.Bt + (size_t)cur.pn * tstep + (size_t)cur.kt0 * (BK * 2);
    S.a_ready(cur);
    if constexpr (SP2) {
        PG8_STAGE(PG8_SB(0, 0), cB, voffB); PG8_STAGE(PG8_SB(0, 1), cB + hstep, voffB); PG8_STAGE(PG8_SA(0, 0), cA, voffA); PG8_STAGE(PG8_SA(0, 1), cA + hstep, voffA);
        if (wr == 1) PG8_BAR;
        PG8_WAIT_V(2); PG8_BAR;
        PG8_STAGE(PG8_SB(1, 0), cB + kstep, voffB); PG8_STAGE(PG8_SA(1, 0), cA + kstep, voffA); PG8_STAGE(PG8_SB(1, 1), cB + hstep + kstep, voffB);
        PG8_WAIT_V(6); PG8_BAR;
    } else {
        PG8_STAGE(PG8_SB(0, 0), cB, voffB); PG8_STAGE(PG8_SA(0, 0), cA, voffA); PG8_STAGE(PG8_SB(0, 1), cB + hstep, voffB); PG8_STAGE(PG8_SA(0, 1), cA + hstep, voffA);
        if (wr == 1) PG8_BAR;
        PG8_WAIT_V(4); PG8_BAR;
        PG8_STAGE(PG8_SB(1, 0), cB + kstep, voffB); PG8_STAGE(PG8_SA(1, 0), cA + kstep, voffA); PG8_STAGE(PG8_SB(1, 1), cB + hstep + kstep, voffB);
        PG8_WAIT_V(6); PG8_BAR;
    }
    for (;;) {
        const bool has_next = S.next(ui + 1, nxt);
        const char* nA = has_next ? (const char*)g.A + (size_t)nxt.pm * tstep + (size_t)nxt.kt0 * (BK * 2) : cA; const char* nB = has_next ? (const char*)g.Bt + (size_t)nxt.pn * tstep + (size_t)nxt.kt0 * (BK * 2) : cB;
        const int nt = cur.nkt;
        for (int t = 0; t < nt; t += 2) {
            const bool last = (t == nt - 2);
            const char* a1 = cA + (size_t)(t + 1) * kstep;
            const char* a2 = last ? nA : cA + (size_t)(t + 2) * kstep; const char* b2 = last ? nB : cB + (size_t)(t + 2) * kstep;
            const char* a3 = a2 + kstep; const char* b3 = b2 + kstep;
            if (last && has_next) S.a_ready(nxt);
            if constexpr (SP2) {
            PG8_LDB(B0, 0, 0); PG8_LDB(B1, 0, 1); PG8_SCHED; PG8_LDA(At, 0, 0); PG8_STAGE(PG8_SA(1, 1), a1 + hstep, voffA);
            PG8_WAIT_V(8); PG8_WAIT_L(0); PG8_BAR; PG8_MMA(0, 0, At, B0); PG8_MMA(0, 1, At, B1); PG8_BAR; PG8_SCHED;
            PG8_LDA(At, 0, 1); PG8_STAGE(PG8_SB(0, 0), b2, voffB); PG8_STAGE(PG8_SB(0, 1), b2 + hstep, voffB); PG8_STAGE(PG8_SA(0, 0), a2, voffA);
            PG8_WAIT_V(8); PG8_WAIT_L(0); PG8_BAR; PG8_MMA(1, 0, At, B0); PG8_MMA(1, 1, At, B1); PG8_BAR; PG8_SCHED;
            PG8_LDB(B0, 1, 0); PG8_LDB(B1, 1, 1); PG8_SCHED; PG8_LDA(At, 1, 0); PG8_STAGE(PG8_SA(0, 1), a2 + hstep, voffA);
            PG8_WAIT_V(8); PG8_WAIT_L(0); PG8_BAR; PG8_MMA(0, 0, At, B0); PG8_MMA(0, 1, At, B1); PG8_BAR; PG8_SCHED;
            PG8_LDA(At, 1, 1); PG8_STAGE(PG8_SB(1, 0), b3, voffB); PG8_STAGE(PG8_SB(1, 1), b3 + hstep, voffB); PG8_STAGE(PG8_SA(1, 0), a3, voffA);
            PG8_WAIT_V(8); PG8_WAIT_L(0); PG8_BAR; PG8_MMA(1, 0, At, B0); PG8_MMA(1, 1, At, B1); PG8_BAR; PG8_SCHED;
            } else {
            PG8_LDB(B0, 0, 0); PG8_SCHED; PG8_LDA(At, 0, 0); PG8_STAGE(PG8_SA(1, 1), a1 + hstep, voffA);
            PG8_WAIT_L(8); PG8_BAR; PG8_WAIT_L(0); PG8_MMA(0, 0, At, B0); PG8_BAR; PG8_SCHED;
            PG8_LDB(B1, 0, 1); PG8_STAGE(PG8_SB(0, 0), b2, voffB);
            PG8_BAR; PG8_WAIT_L(0); PG8_MMA(0, 1, At, B1); PG8_BAR;
            PG8_LDA(At, 0, 1); PG8_STAGE(PG8_SA(0, 0), a2, voffA);
            PG8_BAR; PG8_WAIT_L(0); PG8_MMA(1, 0, At, B0); PG8_BAR; PG8_SCHED;
            PG8_STAGE(PG8_SB(0, 1), b2 + hstep, voffB);
            PG8_WAIT_V(6); PG8_BAR; PG8_MMA(1, 1, At, B1); PG8_BAR;
            PG8_LDB(B0, 1, 0); PG8_SCHED; PG8_LDA(At, 1, 0); PG8_STAGE(PG8_SA(0, 1), a2 + hstep, voffA);
            PG8_WAIT_L(8); PG8_BAR; PG8_WAIT_L(0); PG8_MMA(0, 0, At, B0); PG8_BAR; PG8_SCHED;
            PG8_LDB(B1, 1, 1); PG8_STAGE(PG8_SB(1, 0), b3, voffB);
            PG8_BAR; PG8_WAIT_L(0); PG8_MMA(0, 1, At, B1); PG8_BAR;
            PG8_LDA(At, 1, 1); PG8_STAGE(PG8_SA(1, 0), a3, voffA);
            PG8_BAR; PG8_WAIT_L(0); PG8_MMA(1, 0, At, B0); PG8_BAR; PG8_SCHED;
            PG8_STAGE(PG8_SB(1, 1), b3 + hstep, voffB);
            PG8_WAIT_V(6); PG8_BAR; PG8_MMA(1, 1, At, B1); PG8_BAR;
            }
        }
        if constexpr (ALIGN_EPI) { if (wr == 0) PG8_BAR; }
        if constexpr (!Epi::AFTER_DRAIN) { E(acc, cur, wr, wc, fr, fq); S.done(cur); }
        if (!has_next) break;
#pragma unroll
        for (int a = 0; a < 2; ++a)
#pragma unroll
            for (int b = 0; b < 2; ++b)
#pragma unroll
                for (int m = 0; m < 4; ++m)
#pragma unroll
                    for (int n = 0; n < 2; ++n) acc[a][b][m][n] = (f32x4){0.f, 0.f, 0.f, 0.f};
        cur = nxt; cA = nA; cB = nB; ++ui;
        if constexpr (ALIGN_EPI) { if (wr == 1) PG8_BAR; }
    }
    PG8_WAIT_V(0);
    if constexpr (!ALIGN_EPI) { if (wr == 0) PG8_BAR; }
    PG8_BAR;
    if constexpr (Epi::AFTER_DRAIN) { E.fused(acc, cur, wr, wc, fr, fq, lds, wid, lane); S.done(cur); }
#undef PG8_SA
#undef PG8_SB
#undef PG8_STAGE
#undef PG8_LDA
#undef PG8_LDB
#undef PG8_MMA
#undef PG8_WAIT_V
#undef PG8_WAIT_L
#undef PG8_BAR
#undef PG8_SCHED
}
}

constexpr int DM = 1024, NBATCH = 8, SEQ = 2048, CTXL = 256, DFF = 2816, NHEAD = 8;
constexpr int TL = NBATCH * SEQ;
constexpr int TC = NBATCH * CTXL;
constexpr int TT = TL + TC;
constexpr int KVN = SEQ + CTXL;
constexpr int NMODW = 9 * DM;
constexpr float C2 = 0.125f * 1.4426950408889634f;

constexpr size_t MiB = (size_t)1 << 20;
constexpr size_t OFF_MOD = 0;
constexpr size_t OFF_ROPE = 1536 * 1024;
constexpr size_t OFF_BAR = 1792 * 1024;
constexpr size_t OFF_WSS = 3 * MiB;
constexpr size_t OFF_WGU = 4 * MiB;
constexpr size_t OFF_WDN = OFF_WGU + 88 * MiB;
constexpr size_t OFF_WINA = OFF_WDN + 44 * MiB;
constexpr size_t OFF_WOUTA = OFF_WINA + 12 * MiB;
constexpr size_t OFF_WINS = OFF_WOUTA + 4 * MiB;
constexpr size_t OFF_WOUTS = OFF_WINS + 8 * MiB;
constexpr size_t OFF_H = OFF_WOUTS + 4 * MiB;
constexpr size_t OFF_XN = OFF_H + 72 * MiB;
constexpr size_t OFF_BIG = OFF_XN + 36 * MiB;
constexpr size_t OFF_PART = OFF_BIG + 108 * MiB;
constexpr size_t OFF_SGST2 = OFF_PART + 64 * MiB;
constexpr size_t WS_NEED = OFF_SGST2 + 6 * MiB;
constexpr size_t SZ_TOK = (size_t)TT * DM * 2;

#define LAS __attribute__((address_space(3)))
typedef unsigned short bf16;
typedef unsigned v4u __attribute__((ext_vector_type(4)));
typedef unsigned v2u __attribute__((ext_vector_type(2)));
typedef float f32x4 __attribute__((ext_vector_type(4)));
typedef float f32x16 __attribute__((ext_vector_type(16)));
typedef short bf16x8 __attribute__((ext_vector_type(8)));
typedef float f32x2_t __attribute__((ext_vector_type(2)));
typedef __bf16 bf16x2_t __attribute__((ext_vector_type(2)));

__device__ __forceinline__ unsigned pk2(float lo, float hi) { f32x2_t v = {lo, hi}; bf16x2_t b = __builtin_convertvector(v, bf16x2_t); return __builtin_bit_cast(unsigned, b); }
__device__ __forceinline__ bf16 f2bf(float f) { return (bf16)(pk2(f, 0.f) & 0xffffu); }
__device__ __forceinline__ float bf2f(unsigned b) { return __uint_as_float(b << 16); }
__device__ __forceinline__ f32x4 ldh4(const bf16* p) { const v2u r = *(const v2u*)p; return (f32x4){bf2f(r.x & 0xffffu), bf2f(r.x >> 16), bf2f(r.y & 0xffffu), bf2f(r.y >> 16)}; }
__device__ __forceinline__ void sth4(bf16* p, f32x4 v) { v2u w; w.x = pk2(v[0], v[1]); w.y = pk2(v[2], v[3]); *(v2u*)p = w; }
__device__ __forceinline__ float wave_sum(float v) {
#pragma unroll
    for (int o = 1; o < 64; o <<= 1) v += __shfl_xor(v, o);
    return v;
}
__device__ __forceinline__ float xhalf_max(float m) { auto rr = __builtin_amdgcn_permlane32_swap(__float_as_uint(m), __float_as_uint(m), false, false); return fmaxf(__uint_as_float(rr[0]), __uint_as_float(rr[1])); }
__device__ __forceinline__ float xhalf_sum(float m) { auto rr = __builtin_amdgcn_permlane32_swap(__float_as_uint(m), __float_as_uint(m), false, false); return __uint_as_float(rr[0]) + __uint_as_float(rr[1]); }
__device__ __forceinline__ float max3f(float a, float b, float c) { float r; asm("v_max3_f32 %0, %1, %2, %3" : "=v"(r) : "v"(a), "v"(b), "v"(c)); return r; }
__device__ __forceinline__ float fast_exp2(float x) { return __builtin_amdgcn_exp2f(x); }
__device__ __forceinline__ float fast_rcp(float x) { return __builtin_amdgcn_rcpf(x); }
__device__ __forceinline__ float silu_f(float a) { return a * fast_rcp(1.0f + fast_exp2(-1.4426950408889634f * a)); }
__device__ __forceinline__ float gelu_tanh_f(float x) { const float u = x + 0.044715f * x * x * x; return x * fast_rcp(1.0f + fast_exp2(-2.302208198f * u)); }
__device__ __forceinline__ int crow(int i, int h) { return (i & 3) + 8 * (i >> 2) + 4 * h; }
#define MFMA32(a, b, c) __builtin_amdgcn_mfma_f32_32x32x16_bf16((a), (b), (c), 0, 0, 0)

using pg8::Unit;
struct SplitOrder {
    pg8::StaticOrder lat; int G, c, nsl, nkt;
    __device__ __forceinline__ void init(int nsl_, int nkt_, int G_, int c_) { lat.init(TL, DM, G_, c_); lat.nkt_full = nkt_; G = G_; c = c_; nsl = nsl_; nkt = nkt_; }
    __device__ __forceinline__ bool next(int i, Unit& u) const {
        const int nrl = (256 + G - 1) / G;
        const bool swp = (nrl == 1) && (c & 1) && (c < 32 * nsl);
        if (swp) { if (i == 1) return lat.next(0, u); if (i > 1) return false; }
        else if (i < nrl) { if (lat.next(i, u)) return true; }
        const int q = swp ? c : (i - nrl) * G + c;
        if ((!swp && i < nrl) || q >= 32 * nsl) return false;
        const int tctx = q / nsl, sl = q % nsl, pairs = nkt >> 1, base = pairs / nsl, rem = pairs % nsl;
        u.pm = 64 + (tctx >> 2); u.pn = tctx & 3; u.kt0 = 2 * (sl * base + (sl < rem ? sl : rem)); u.nkt = 2 * (base + (sl < rem ? 1 : 0)); u.part = q; return true;
    }
    __device__ __forceinline__ void a_ready(const Unit&) const {}
    __device__ __forceinline__ void done(const Unit&) const {}
};
struct EpiSwiGLU {
    static constexpr bool PERM = true, AFTER_DRAIN = false;
    bf16* O;
    __device__ __forceinline__ void operator()(const f32x4 (&acc)[2][2][4][2], const Unit& u, int wr, int wc, int fr, int fq) const {
        const int row0 = u.pm * 256 + wr * 64 + fr, col0 = u.pn * 128 + wc * 32 + 8 * fq;
#pragma unroll
        for (int ai = 0; ai < 2; ++ai)
#pragma unroll
            for (int m = 0; m < 4; ++m) {
                bf16* p = O + (size_t)(row0 + ai * 128 + m * 16) * DFF + col0;
                const f32x4 a0 = acc[ai][0][m][0], a1 = acc[ai][0][m][1], u0 = acc[ai][1][m][0], u1 = acc[ai][1][m][1];
                v4u w;
                w.x = pk2(silu_f(a0[0]) * u0[0], silu_f(a0[1]) * u0[1]); w.y = pk2(silu_f(a0[2]) * u0[2], silu_f(a0[3]) * u0[3]);
                w.z = pk2(silu_f(a1[0]) * u1[0], silu_f(a1[1]) * u1[1]); w.w = pk2(silu_f(a1[2]) * u1[2], silu_f(a1[3]) * u1[3]);
                *(v4u*)p = w;
            }
    }
};
struct EpiResid {
    static constexpr bool PERM = true, AFTER_DRAIN = false;
    unsigned char* ws; const float* gate; int half;
    __device__ __forceinline__ void operator()(const f32x4 (&acc)[2][2][4][2], const Unit& u, int wr, int wc, int fr, int fq) const {
        bf16* H = (bf16*)(ws + OFF_H); bf16* part = (bf16*)(ws + OFF_PART); const float coef = half ? 0.5f : 1.0f;
        if (u.part >= 0) {
            bf16* pp = part + (size_t)u.part * 65536 + (size_t)(wr * 64 + fr) * 256 + wc * 32 + 8 * fq;
#pragma unroll
            for (int ai = 0; ai < 2; ++ai)
#pragma unroll
                for (int m = 0; m < 4; ++m)
#pragma unroll
                    for (int bj = 0; bj < 2; ++bj) {
                        const f32x4 x0 = acc[ai][bj][m][0], x1 = acc[ai][bj][m][1];
                        v4u w; w.x = pk2(x0[0], x0[1]); w.y = pk2(x0[2], x0[3]); w.z = pk2(x1[0], x1[1]); w.w = pk2(x1[2], x1[3]);
                        *(v4u*)(pp + (size_t)(ai * 128 + m * 16) * 256 + bj * 128) = w;
                    }
            return;
        }
        const int b9 = u.pm < 64 ? (u.pm >> 3) : 8;
        const float* gp = gate + (size_t)b9 * NMODW;
        const int row0 = u.pm * 256 + wr * 64 + fr;
#pragma unroll
        for (int bj = 0; bj < 2; ++bj) {
            const int col = u.pn * 256 + bj * 128 + wc * 32 + 8 * fq;
            const f32x4 gv0 = *(const f32x4*)(gp + col) * coef, gv1 = *(const f32x4*)(gp + col + 4) * coef;
            v4u h[2][4];
#pragma unroll
            for (int ai = 0; ai < 2; ++ai)
#pragma unroll
                for (int m = 0; m < 4; ++m) h[ai][m] = *(const v4u*)(H + (size_t)(row0 + ai * 128 + m * 16) * DM + col);
#pragma unroll
            for (int ai = 0; ai < 2; ++ai)
#pragma unroll
                for (int m = 0; m < 4; ++m) {
                    const v4u r = h[ai][m];
                    const f32x4 h0 = (f32x4){bf2f(r.x & 0xffffu), bf2f(r.x >> 16), bf2f(r.y & 0xffffu), bf2f(r.y >> 16)};
                    const f32x4 h1 = (f32x4){bf2f(r.z & 0xffffu), bf2f(r.z >> 16), bf2f(r.w & 0xffffu), bf2f(r.w >> 16)};
                    const f32x4 y0 = h0 + gv0 * acc[ai][bj][m][0], y1 = h1 + gv1 * acc[ai][bj][m][1];
                    v4u w; w.x = pk2(y0[0], y0[1]); w.y = pk2(y0[2], y0[3]); w.z = pk2(y1[0], y1[1]); w.w = pk2(y1[2], y1[3]);
                    *(v4u*)(H + (size_t)(row0 + ai * 128 + m * 16) * DM + col) = w;
                }
        }
    }
};
struct EpiQKV {
    static constexpr bool PERM = false, AFTER_DRAIN = false;
    bf16* Q; bf16* K; bf16* Vt; const float* rope;
    __device__ __forceinline__ void operator()(const f32x4 (&acc)[2][2][4][2], const Unit& u, int wr, int wc, int fr, int fq) const {
        const int sect = u.pn >> 2, ct = (u.pn & 3) * 256;
        const bool latent = u.pm < 64;
        if (sect < 2) {
            bf16* base = sect == 0 ? Q : K; const float sc = sect == 0 ? C2 : 1.0f;
            const int axis = wc & 1;
            f32x4 csv[2][4], snv[2][4];
#pragma unroll
            for (int ai = 0; ai < 2; ++ai)
#pragma unroll
                for (int m = 0; m < 4; ++m) {
                    const int row = u.pm * 256 + ai * 128 + wr * 64 + m * 16 + fr;
                    csv[ai][m] = (f32x4){1.f, 1.f, 1.f, 1.f}; snv[ai][m] = (f32x4){0.f, 0.f, 0.f, 0.f};
                    if (latent) { const int s = row & 2047; const int pos = axis ? (s & 63) : (s >> 6); csv[ai][m] = *(const f32x4*)(rope + pos * 32 + 4 * fq); snv[ai][m] = *(const f32x4*)(rope + pos * 32 + 16 + 4 * fq); }
                }
#pragma unroll
            for (int ai = 0; ai < 2; ++ai)
#pragma unroll
                for (int m = 0; m < 4; ++m) {
                    const int row = u.pm * 256 + ai * 128 + wr * 64 + m * 16 + fr;
                    const f32x4 cs = csv[ai][m], sn = snv[ai][m];
#pragma unroll
                    for (int bj = 0; bj < 2; ++bj) {
                        const f32x4 x1 = acc[ai][bj][m][0], x2 = acc[ai][bj][m][1];
                        const f32x4 o1 = (x1 * cs - x2 * sn) * sc, o2 = (x2 * cs + x1 * sn) * sc;
                        bf16* p = base + (size_t)row * DM + ct + bj * 128 + wc * 32 + 4 * fq;
                        v2u w1, w2; w1.x = pk2(o1[0], o1[1]); w1.y = pk2(o1[2], o1[3]); w2.x = pk2(o2[0], o2[1]); w2.y = pk2(o2[2], o2[3]);
                        *(v2u*)p = w1; *(v2u*)(p + 16) = w2;
                    }
                }
        } else {
            const int swz = (fr & 3) | ((fr & 4) << 1) | ((fr & 8) >> 1);
#pragma unroll
            for (int ai = 0; ai < 2; ++ai)
#pragma unroll
                for (int m = 0; m < 4; ++m) {
                    const int row = u.pm * 256 + ai * 128 + wr * 64 + m * 16 + fr;
                    int b, kv; if (latent) { b = row >> 11; kv = row & 2047; } else { const int rr = row - TL; b = rr >> 8; kv = SEQ + (rr & 255); }
                    const int kvpos = (kv & ~15) | swz;
#pragma unroll
                    for (int bj = 0; bj < 2; ++bj) {
                        const int hd = (u.pn - 8) * 2 + bj;
                        bf16* vb = Vt + ((size_t)(b * NHEAD + hd) * 128 + wc * 32 + 4 * fq) * KVN + kvpos;
#pragma unroll
                        for (int n = 0; n < 2; ++n)
#pragma unroll
                            for (int i = 0; i < 4; ++i) vb[(size_t)(n * 16 + i) * KVN] = f2bf(acc[ai][bj][m][n][i]);
                    }
                }
        }
    }
};
struct EpiSG {
    static constexpr bool PERM = false, AFTER_DRAIN = false;
    bf16* ZU; bf16* ZVT; float* stats;
    __device__ __forceinline__ void operator()(const f32x4 (&acc)[2][2][4][2], const Unit& u, int wr, int wc, int fr, int fq) const {
        const int sect = u.pn >> 2, ct = (u.pn & 3) * 256;
#pragma unroll
        for (int ai = 0; ai < 2; ++ai)
#pragma unroll
            for (int m = 0; m < 4; ++m) {
                const int row = u.pm * 256 + ai * 128 + wr * 64 + m * 16 + fr;
                if (sect == 0) {
#pragma unroll
                    for (int bj = 0; bj < 2; ++bj)
#pragma unroll
                        for (int n = 0; n < 2; ++n) {
                            const f32x4 x = acc[ai][bj][m][n];
                            v2u w; w.x = pk2(gelu_tanh_f(x[0]), gelu_tanh_f(x[1])); w.y = pk2(gelu_tanh_f(x[2]), gelu_tanh_f(x[3]));
                            *(v2u*)(ZU + (size_t)row * DM + ct + bj * 128 + wc * 32 + n * 16 + 4 * fq) = w;
                        }
                } else {
                    const int chunk = row >> 7, s = row & 127;
                    float s1 = 0.f, s2 = 0.f;
#pragma unroll
                    for (int bj = 0; bj < 2; ++bj)
#pragma unroll
                        for (int n = 0; n < 2; ++n)
#pragma unroll
                            for (int i = 0; i < 4; ++i) {
                                const float z = gelu_tanh_f(acc[ai][bj][m][n][i]);
                                s1 += z; s2 += z * z;
                                const int c = ct + bj * 128 + wc * 32 + n * 16 + 4 * fq + i;
                                ZVT[((size_t)chunk * DM + c) * 128 + s] = f2bf(z);
                            }
                    s1 += __shfl_xor(s1, 16); s1 += __shfl_xor(s1, 32);
                    s2 += __shfl_xor(s2, 16); s2 += __shfl_xor(s2, 32);
                    if (fq == 0) { float* sp = stats + ((size_t)row * 16 + (u.pn - 4) * 4 + wc) * 2; sp[0] = s1; sp[1] = s2; }
                }
            }
    }
};

template <class T> __device__ __forceinline__ T* as_global(T* p) { return (T*)(__attribute__((address_space(1))) T*)p; }
#define GAS __attribute__((address_space(1)))
struct Args { GAS const float* in_[20]; GAS float* out_; GAS unsigned char* ws_; };
typedef __attribute__((address_space(4))) const Args CArgs;
struct ArgView { CArgs* p;
    __device__ __forceinline__ const float* in(int i) const { return (const float*)p->in_[i]; }
    __device__ __forceinline__ float* out() const { return (float*)p->out_; }
    __device__ __forceinline__ unsigned char* ws() const { return (unsigned char*)p->ws_; } };
enum { I_X = 0, I_C, I_CTX, I_CCTX, I_WMOD, I_BMOD, I_NORMG, I_WGU, I_WDN, I_DAIN, I_DAOUT, I_DALAM, I_DASUB, I_SGIN, I_SGLNG, I_SGLNB, I_SGWS, I_SGBS, I_SGOUT, I_FINALG };

__device__ __forceinline__ ArgView get_args() { CArgs* p = (CArgs*)__builtin_amdgcn_kernarg_segment_ptr(); asm volatile("" : "+s"(p)); ArgView v; v.p = p; return v; }
__device__ __forceinline__ void transpose_item(const float* W, int K, int N, bf16* WT, int k0, int n0, int drow0, LAS float* scr, int lane) {
    float rv[32];
#pragma unroll
    for (int i = 0; i < 32; ++i) rv[i] = W[(size_t)(k0 + 2 * i + (lane >> 5)) * N + n0 + (lane & 31)];
#pragma unroll
    for (int i = 0; i < 32; ++i) scr[(2 * i + (lane >> 5)) * 33 + (lane & 31)] = rv[i];
    asm volatile("s_waitcnt lgkmcnt(0)" ::: "memory");
    const int c = lane & 7;
#pragma unroll
    for (int j = 0; j < 4; ++j) { const int n = (lane >> 3) + 8 * j; const LAS float* s = scr + (8 * c) * 33 + n;
        v4u o; o.x = pk2(s[0 * 33], s[1 * 33]); o.y = pk2(s[2 * 33], s[3 * 33]); o.z = pk2(s[4 * 33], s[5 * 33]); o.w = pk2(s[6 * 33], s[7 * 33]);
        *(v4u*)(WT + (size_t)(drow0 + n) * K + k0 + 8 * c) = o; }
    asm volatile("s_waitcnt lgkmcnt(0)" ::: "memory");
}

__device__ __forceinline__ int conv_layer_count(int L) { return (L & 1) ? 9984 : 10496; }
__device__ __forceinline__ int conv_idle(int nwg, int G) { return (nwg % G) ? G - nwg % G : 0; }
__device__ __forceinline__ int conv_idle_phase(int l, int which, int G) {
    if (l > 2) return 0;
    if (which == 0) return conv_idle((TT / 256) * 22, G);
    if (which == 1) return conv_idle((TT / 256) * ((l & 1) ? 8 : 12), G);
    return conv_idle(((l < 2 ? TT : TL) / 256) * 22, G);
}
__device__ __forceinline__ int conv_idle_total(int l, int G) { return conv_idle_phase(l, 0, G) + conv_idle_phase(l, 1, G) + conv_idle_phase(l, 2, G); }
__device__ __forceinline__ void conv_layer_items(const ArgView& a, unsigned char* ws, int L, int first, int last, int w, int W, LAS float* scr, int lane) {
    constexpr int I_GU = 16 * 176, I_DN = 44 * 32, I_AIN = 16 * 96, I_SQ = 16 * 32, I_SIN = 16 * 64;
    const int j = L >> 1;
    for (int it = first + w; it < last; it += W) {
        if (it < 2 * I_GU) { const int mi = 2 * L + it / I_GU, r = it % I_GU, kb = r / 176, nb = r % 176; const int n0 = nb * 32; const int jj = n0 < DFF ? n0 : n0 - DFF; const int half = n0 < DFF ? 0 : 1;
            transpose_item(a.in(I_WGU) + (size_t)mi * DM * 2 * DFF, DM, 2 * DFF, (bf16*)(ws + OFF_WGU) + (size_t)mi * 2 * DFF * DM, kb * 64, n0, 256 * (jj >> 7) + 128 * half + (jj & 127), scr, lane); }
        else if (it < 2 * I_GU + 2 * I_DN) { const int q = it - 2 * I_GU, mi = 2 * L + q / I_DN, r = q % I_DN, kb = r / 32, nb = r % 32;
            transpose_item(a.in(I_WDN) + (size_t)mi * DFF * DM, DFF, DM, (bf16*)(ws + OFF_WDN) + (size_t)mi * DM * DFF, kb * 64, nb * 32, nb * 32, scr, lane); }
        else if ((L & 1) == 0) { const int q = it - 2 * I_GU - 2 * I_DN;
            if (q < I_AIN) { const int kb = q / 96, nb = q % 96;
                transpose_item(a.in(I_DAIN) + (size_t)j * DM * 3 * DM, DM, 3 * DM, (bf16*)(ws + OFF_WINA) + (size_t)j * 3 * DM * DM, kb * 64, nb * 32, nb * 32, scr, lane); }
            else { const int r = q - I_AIN, kb = r / 32, nb = r % 32;
                transpose_item(a.in(I_DAOUT) + (size_t)j * DM * DM, DM, DM, (bf16*)(ws + OFF_WOUTA) + (size_t)j * DM * DM, kb * 64, nb * 32, nb * 32, scr, lane); } }
        else { const int q = it - 2 * I_GU - 2 * I_DN;
            if (q < I_SIN) { const int kb = q / 64, nb = q % 64;
                transpose_item(a.in(I_SGIN) + (size_t)j * DM * 2 * DM, DM, 2 * DM, (bf16*)(ws + OFF_WINS) + (size_t)j * 2 * DM * DM, kb * 64, nb * 32, nb * 32, scr, lane); }
            else { const int r = q - I_SIN, kb = r / 32, nb = r % 32;
                transpose_item(a.in(I_SGOUT) + (size_t)j * DM * DM, DM, DM, (bf16*)(ws + OFF_WOUTS) + (size_t)j * DM * DM, kb * 64, nb * 32, nb * 32, scr, lane); } }
    }
}
__device__ __forceinline__ void prologue(LAS unsigned char* lds, int blk, int G, int tid) {
    const int lane = tid & 63, wave = tid >> 6;
    const ArgView a = get_args();
    unsigned char* ws = a.ws();
    {
        LAS float* sc = (LAS float*)lds; LAS float* red = sc + 9 * DM;
        for (int i = tid; i < 9 * DM; i += 512) { const int b = i >> 10, k = i & 1023; const float v = b < 8 ? a.in(I_C)[b * DM + k] : a.in(I_CCTX)[k]; sc[i] = v / (1.0f + __expf(-v)); }
        __syncthreads();
        float* MOD = (float*)(ws + OFF_MOD);
        LAS float* red4 = sc + 9 * DM;
        for (int it = blk; it < 4 * 36; it += G) {
            const int l = it / 36, n0 = (it % 36) * 256, kp = tid >> 6, ln = tid & 63;
            const float* wp = a.in(I_WMOD) + ((size_t)l * DM + kp * 128) * NMODW + n0 + 4 * ln;
            f32x4 a0 = {0.f, 0.f, 0.f, 0.f}, a1 = a0, a2 = a0, a3 = a0, a4 = a0, a5 = a0, a6 = a0, a7 = a0, a8 = a0;
            const LAS float* sp = sc + kp * 128;
#pragma unroll 2
            for (int kk = 0; kk < 128; kk += 4) {
                const f32x4 w0 = *(const f32x4*)(wp + (size_t)kk * NMODW), w1 = *(const f32x4*)(wp + (size_t)(kk + 1) * NMODW), w2 = *(const f32x4*)(wp + (size_t)(kk + 2) * NMODW), w3 = *(const f32x4*)(wp + (size_t)(kk + 3) * NMODW);
#define MOD_ACC(ab, b) do { const f32x4 s_ = *(const LAS f32x4*)(sp + (b) * DM + kk); ab += w0 * s_[0] + w1 * s_[1] + w2 * s_[2] + w3 * s_[3]; } while (0)
                MOD_ACC(a0, 0); MOD_ACC(a1, 1); MOD_ACC(a2, 2); MOD_ACC(a3, 3); MOD_ACC(a4, 4); MOD_ACC(a5, 5); MOD_ACC(a6, 6); MOD_ACC(a7, 7); MOD_ACC(a8, 8);
#undef MOD_ACC
            }
            LAS f32x4* rp = (LAS f32x4*)(red4 + (size_t)kp * 9 * 256) + ln;
            rp[0] = a0; rp[64] = a1; rp[128] = a2; rp[192] = a3; rp[256] = a4; rp[320] = a5; rp[384] = a6; rp[448] = a7; rp[512] = a8;
            __syncthreads();
            for (int o = tid; o < 9 * 256; o += 512) {
                const int b = o >> 8, cc = o & 255; float s = 0.f;
#pragma unroll
                for (int k8 = 0; k8 < 8; ++k8) s += red4[(k8 * 9 + b) * 256 + cc];
                MOD[(size_t)(l * 9 + b) * NMODW + n0 + cc] = s + a.in(I_BMOD)[l * NMODW + n0 + cc];
            }
            __syncthreads();
        }
    }
#ifdef PROBE_XMASK
    if (tid == 0) { LAS unsigned* pacc_ = (LAS unsigned*)(lds + 131072 + 1024); const unsigned t_ = (unsigned)__builtin_amdgcn_s_memrealtime(); pacc_[10] += t_ - pacc_[16]; pacc_[16] = t_; }
#endif
    if (blk == G - 1) {
        float* rope = (float*)(ws + OFF_ROPE);
        for (int idx = tid; idx < 64 * 16; idx += 512) {
            const int pos = idx >> 4, f = idx & 15;
            const float inv = exp2f(-(float)f * 0.8304820237218406f);
            const float ang = (float)pos * inv;
            const double x = (double)ang; const double kq = rint(x * 0.15915494309189535); const double r = x - kq * 6.283185307179586476925;
            const double r2 = r * r; double ts = r, tc = 1.0, ss = r, cc = 1.0;
            for (int n = 1; n <= 16; ++n) { tc *= -r2 / (double)((2 * n - 1) * (2 * n)); ts *= -r2 / (double)((2 * n) * (2 * n + 1)); cc += tc; ss += ts; }
            rope[pos * 32 + f] = (float)cc; rope[pos * 32 + 16 + f] = (float)ss;
        }
    }
    {
        const int gt = blk * 512 + tid, NT = G * 512;
        bf16* wss = (bf16*)(ws + OFF_WSS);
        for (int i = gt; i < 2 * 8 * 128 * 128; i += NT) wss[i] = f2bf(a.in(I_SGWS)[i]);
    }
    __syncthreads();
    {
        LAS float* scr = (LAS float*)(lds + wave * 16384);
        for (int L = 0; L < 4; ++L)
            if (L == 0 || conv_idle_total(L - 1, G) == 0) {
                if (G > 4 * 36 + 32) { if (blk >= 4 * 36) conv_layer_items(a, ws, L, 0, conv_layer_count(L), (blk - 4 * 36) * 8 + wave, (G - 4 * 36) * 8, scr, lane); }
                else conv_layer_items(a, ws, L, 0, conv_layer_count(L), blk * 8 + wave, G * 8, scr, lane);
            }
    }
#ifdef PROBE_XMASK
    __syncthreads();
    if (tid == 0) { LAS unsigned* pacc_ = (LAS unsigned*)(lds + 131072 + 1024); const unsigned t_ = (unsigned)__builtin_amdgcn_s_memrealtime(); pacc_[11] += t_ - pacc_[16]; pacc_[16] = t_; }
#endif
}

template <bool INIT>
__device__ __forceinline__ void norm_phase(const float* x_lat, const float* x_ctx, bf16* H, bf16* XN, const float* g, const float* modl, int ishift, int iscale, int Mrows, int gw, int NGW, int lane,
                                           const bf16* part, int nsl, const float* pgate, float pcoef) {
    const int rpw = (TL + NGW - 1) / NGW;
    f32x4 gs[4], sh[4]; int curb = -1;
    constexpr int R = 4;
    for (int i0 = 0; i0 < rpw; i0 += R) {
        f32x4 v[R][4]; float ss[R];
#pragma unroll
        for (int q = 0; q < R; ++q) {
            int row = gw * rpw + i0 + q; if (i0 + q >= rpw || row >= TL) row = gw * rpw < TL ? gw * rpw : 0;
#pragma unroll
            for (int j = 0; j < 4; ++j) v[q][j] = INIT ? ((const f32x4*)(x_lat + (size_t)row * DM))[lane + 64 * j] : ldh4(H + (size_t)row * DM + 4 * lane + 256 * j);
        }
#pragma unroll
        for (int q = 0; q < R; ++q) { float s = 0.f;
#pragma unroll
            for (int j = 0; j < 4; ++j) s += (v[q][j][0] * v[q][j][0] + v[q][j][1] * v[q][j][1]) + (v[q][j][2] * v[q][j][2] + v[q][j][3] * v[q][j][3]);
            ss[q] = s; }
#pragma unroll
        for (int o = 1; o < 64; o <<= 1) {
#pragma unroll
            for (int q = 0; q < R; ++q) ss[q] += __shfl_xor(ss[q], o);
        }
#pragma unroll
        for (int q = 0; q < R; ++q) {
            const int row = gw * rpw + i0 + q;
            if (i0 + q < rpw && row < TL) {
                const int b9 = row >> 11;
                if (b9 != curb) { curb = b9; const float* mp = modl + (size_t)b9 * NMODW;
#pragma unroll
                    for (int j = 0; j < 4; ++j) { const int col = 4 * lane + 256 * j; gs[j] = *(const f32x4*)(g + col) * (*(const f32x4*)(mp + iscale * DM + col) + 1.0f); sh[j] = *(const f32x4*)(mp + ishift * DM + col); } }
                const float rstd = 1.0f / sqrtf(ss[q] * (1.0f / DM) + 1e-6f);
#pragma unroll
                for (int j = 0; j < 4; ++j) {
                    const int col = 4 * lane + 256 * j;
                    const f32x4 y = (v[q][j] * rstd) * gs[j] + sh[j];
                    v2u w; w.x = pk2(y[0], y[1]); w.y = pk2(y[2], y[3]);
                    *(v2u*)(XN + (size_t)row * DM + col) = w;
                    if (INIT) sth4(H + (size_t)row * DM + col, v[q][j]);
                }
            }
        }
    }
    for (int row = TL + gw; row < Mrows; row += NGW) {
        f32x4 v[4];
#pragma unroll
        for (int j = 0; j < 4; ++j) v[j] = INIT ? ((const f32x4*)(x_ctx + (size_t)(row - TL) * DM))[lane + 64 * j] : ldh4(H + (size_t)row * DM + 4 * lane + 256 * j);
        if (nsl > 0) {
            const int rr = row - TL, pmc = rr >> 8, r = rr & 255;
#pragma unroll
            for (int j = 0; j < 4; ++j) {
                const bf16* pb = part + ((size_t)(pmc * 4 + j) * nsl) * 65536 + (size_t)r * 256 + 4 * lane;
                f32x4 pv[8];
#pragma unroll
                for (int sl = 0; sl < 8; ++sl) pv[sl] = sl < nsl ? ldh4(pb + (size_t)sl * 65536) : (f32x4){0.f, 0.f, 0.f, 0.f};
                const f32x4 sacc = ((pv[0] + pv[1]) + (pv[2] + pv[3])) + ((pv[4] + pv[5]) + (pv[6] + pv[7]));
                v[j] = v[j] + (*(const f32x4*)(pgate + 4 * lane + 256 * j) * pcoef) * sacc;
                sth4(H + (size_t)row * DM + 4 * lane + 256 * j, v[j]);
            }
        }
        float s = 0.f;
#pragma unroll
        for (int j = 0; j < 4; ++j) s += (v[j][0] * v[j][0] + v[j][1] * v[j][1]) + (v[j][2] * v[j][2] + v[j][3] * v[j][3]);
        s = wave_sum(s);
        const float rstd = 1.0f / sqrtf(s * (1.0f / DM) + 1e-6f);
        const float* mp = modl + (size_t)8 * NMODW;
#pragma unroll
        for (int j = 0; j < 4; ++j) {
            const int col = 4 * lane + 256 * j;
            const f32x4 gg = *(const f32x4*)(g + col), sc = *(const f32x4*)(mp + iscale * DM + col), s4 = *(const f32x4*)(mp + ishift * DM + col);
            const f32x4 y = (v[j] * rstd) * gg * (sc + 1.0f) + s4;
            v2u w; w.x = pk2(y[0], y[1]); w.y = pk2(y[2], y[3]);
            *(v2u*)(XN + (size_t)row * DM + col) = w;
            if (INIT) sth4(H + (size_t)row * DM + col, v[j]);
        }
    }
}
__device__ __forceinline__ void final_norm_phase(const bf16* H, float* out, const float* g, int gw, int NGW, int lane) {
    const int rpw = (TL + NGW - 1) / NGW;
    f32x4 gg[4];
#pragma unroll
    for (int j = 0; j < 4; ++j) gg[j] = *(const f32x4*)(g + 4 * lane + 256 * j);
    constexpr int R = 4;
    for (int i0 = 0; i0 < rpw; i0 += R) {
        f32x4 v[R][4]; float ss[R];
#pragma unroll
        for (int q = 0; q < R; ++q) {
            int row = gw * rpw + i0 + q; if (i0 + q >= rpw || row >= TL) row = gw * rpw < TL ? gw * rpw : 0;
#pragma unroll
            for (int j = 0; j < 4; ++j) v[q][j] = ldh4(H + (size_t)row * DM + 4 * lane + 256 * j);
        }
#pragma unroll
        for (int q = 0; q < R; ++q) { float s = 0.f;
#pragma unroll
            for (int j = 0; j < 4; ++j) s += (v[q][j][0] * v[q][j][0] + v[q][j][1] * v[q][j][1]) + (v[q][j][2] * v[q][j][2] + v[q][j][3] * v[q][j][3]);
            ss[q] = s; }
#pragma unroll
        for (int o = 1; o < 64; o <<= 1) {
#pragma unroll
            for (int q = 0; q < R; ++q) ss[q] += __shfl_xor(ss[q], o);
        }
#pragma unroll
        for (int q = 0; q < R; ++q) {
            const int row = gw * rpw + i0 + q;
            if (i0 + q < rpw && row < TL) {
                const float rstd = 1.0f / sqrtf(ss[q] * (1.0f / DM) + 1e-6f);
#pragma unroll
                for (int j = 0; j < 4; ++j) *(f32x4*)(out + (size_t)row * DM + 4 * lane + 256 * j) = (v[q][j] * rstd) * gg[j];
            }
        }
    }
}

constexpr int AT_KB = 64 * 256, AT_VB = 128 * 128, AT_K0 = 0, AT_V0 = 3 * AT_KB;
template <int VAR>
__device__ __forceinline__ void attn_phase(LAS unsigned char* lds, const bf16* Q, const bf16* K, const bf16* Vt, bf16* AO, const float* lam4, const float* subg, float lam_init, bool ctxq, int G, int blk, int tid) {
    const int lane = tid & 63, wave = __builtin_amdgcn_readfirstlane(tid >> 6), rg = wave & 3, r = wave >> 2, q32 = lane & 31, hi = lane >> 5;
    float lamv;
    { float x = 0.f, y = 0.f;
      for (int i = 0; i < 64; ++i) { x += lam4[i] * lam4[64 + i]; y += lam4[128 + i] * lam4[192 + i]; }
      lamv = __expf(x) - __expf(y) + lam_init; }
    const int nunits = 1024 + (ctxq ? 128 : 0);
    const int vcu = (G % 8 == 0) ? (blk % 8) * (G / 8) + blk / 8 : blk;
    for (int uidx = vcu; uidx < nunits; uidx += G) {
        int b, h, qrow0, t0, t1;
        if (uidx < 1024) { b = uidx >> 7; h = (uidx >> 4) & 7; qrow0 = b * SEQ + (uidx & 15) * 128; t0 = 0; t1 = 36; }
        else { const int v = uidx - 1024; b = v >> 4; h = (v >> 1) & 7; qrow0 = TL + b * CTXL + (v & 1) * 128; t0 = 32; t1 = 36; }
        bf16x8 qf[4];
        { const bf16* qp = Q + (size_t)(qrow0 + rg * 32 + q32) * DM + h * 128 + r * 64 + hi * 8;
#pragma unroll
          for (int d0 = 0; d0 < 4; ++d0) qf[d0] = *(const bf16x8*)(qp + d0 * 16);
#pragma unroll
          for (int d0 = 0; d0 < 4; ++d0) asm volatile("" : "+v"(qf[d0])); }
        f32x16 o[4];
#pragma unroll
        for (int db = 0; db < 4; ++db)
#pragma unroll
            for (int i = 0; i < 16; ++i) o[db][i] = 0.f;
        float mrun = 0.f, lrun = 0.f;
        f32x16 negm;
#pragma unroll
        for (int i = 0; i < 16; ++i) negm[i] = 0.f;
        const bf16* kbase = K + h * 128;
        const bf16* vbase = Vt + (size_t)(b * NHEAD + h) * 128 * KVN;
#define AT_ROWB(t) ((t) < 32 ? (size_t)b * SEQ + (size_t)(t) * 64 : (size_t)TL + (size_t)b * CTXL + (size_t)((t) - 32) * 64)
#define AT_DMA(t, kbuf, vbuf) do { const char* kp_ = (const char*)kbase + AT_ROWB(t) * (size_t)(DM * 2); const char* vp_ = (const char*)vbase + (size_t)(t) * 128; \
            _Pragma("unroll") for (int i_ = 0; i_ < 2; ++i_) { \
                const int krow_ = 8 * wave + 4 * i_ + (lane >> 4); \
                __builtin_amdgcn_global_load_lds((const unsigned*)(kp_ + (size_t)krow_ * (DM * 2) + (((lane & 15) ^ (krow_ & 15)) * 16)), (LAS unsigned*)(lds + AT_K0 + (kbuf) * AT_KB + wave * 2048 + i_ * 1024), 16, 0, 0); } \
            _Pragma("unroll") for (int i_ = 0; i_ < 2; ++i_) { \
                const int vrow_ = 16 * wave + 8 * i_ + (lane >> 3); \
                __builtin_amdgcn_global_load_lds((const unsigned*)(vp_ + (size_t)vrow_ * (KVN * 2) + (((lane & 7) ^ ((vrow_ >> 1) & 7)) * 16)), (LAS unsigned*)(lds + AT_V0 + (vbuf) * AT_VB + wave * 2048 + i_ * 1024), 16, 0, 0); } } while (0)
#define AT_SB() __builtin_amdgcn_sched_barrier(0)
        unsigned kfo[4], vfo[4];
#pragma unroll
        for (int i = 0; i < 4; ++i) { kfo[i] = (unsigned)(q32 * 256 + (((r * 8 + 2 * i + hi) ^ (q32 & 15)) * 16)); vfo[i] = (unsigned)(q32 * 128 + (((2 * i + hi) ^ ((q32 >> 1) & 7)) * 16)); }
#define AT_QK(S0, S1, buf) do { const LAS unsigned char* kb_ = lds + AT_K0 + (buf) * AT_KB; bf16x8 kf_[4]; \
            _Pragma("unroll") for (int d_ = 0; d_ < 2; ++d_) { kf_[2 * d_] = *(const LAS bf16x8*)(kb_ + kfo[d_]); kf_[2 * d_ + 1] = *(const LAS bf16x8*)(kb_ + 32 * 256 + kfo[d_]); } \
            AT_SB(); \
            S0 = MFMA32(kf_[0], qf[0], negm); S1 = MFMA32(kf_[1], qf[0], negm); \
            S0 = MFMA32(kf_[2], qf[1], S0); S1 = MFMA32(kf_[3], qf[1], S1); \
            AT_SB(); \
            _Pragma("unroll") for (int d_ = 0; d_ < 2; ++d_) { kf_[2 * d_] = *(const LAS bf16x8*)(kb_ + kfo[d_ + 2]); kf_[2 * d_ + 1] = *(const LAS bf16x8*)(kb_ + 32 * 256 + kfo[d_ + 2]); } \
            AT_SB(); \
            S0 = MFMA32(kf_[0], qf[2], S0); S1 = MFMA32(kf_[1], qf[2], S1); S0 = MFMA32(kf_[2], qf[3], S0); S1 = MFMA32(kf_[3], qf[3], S1); } while (0)
        bf16x8 va[4];
#pragma unroll
        for (int i = 0; i < 4; ++i) va[i] = (bf16x8){0, 0, 0, 0, 0, 0, 0, 0};
#define AT_PV_PRE(VB) do { const LAS unsigned char* vb = lds + AT_V0 + (VB) * AT_VB; \
            _Pragma("unroll") for (int ks = 0; ks < 4; ++ks) va[ks] = *(const LAS bf16x8*)(vb + vfo[ks]); } while (0)
#define AT_PV_RUN(PF, VB) do { const LAS unsigned char* vb = lds + AT_V0 + (VB) * AT_VB; bf16x8 vc[4], ve[4]; \
            _Pragma("unroll") for (int ks = 0; ks < 4; ++ks) vc[ks] = *(const LAS bf16x8*)(vb + 1 * 32 * 128 + vfo[ks]); \
            _Pragma("unroll") for (int ks = 0; ks < 4; ++ks) ve[ks] = *(const LAS bf16x8*)(vb + 2 * 32 * 128 + vfo[ks]); \
            AT_SB(); __builtin_amdgcn_s_setprio(1); \
            _Pragma("unroll") for (int ks = 0; ks < 4; ++ks) o[0] = MFMA32(va[ks], PF[ks], o[0]); \
            AT_SB(); \
            _Pragma("unroll") for (int ks = 0; ks < 4; ++ks) va[ks] = *(const LAS bf16x8*)(vb + 3 * 32 * 128 + vfo[ks]); \
            AT_SB(); \
            _Pragma("unroll") for (int ks = 0; ks < 4; ++ks) o[1] = MFMA32(vc[ks], PF[ks], o[1]); \
            AT_SB(); \
            _Pragma("unroll") for (int ks = 0; ks < 4; ++ks) o[2] = MFMA32(ve[ks], PF[ks], o[2]); \
            AT_SB(); \
            _Pragma("unroll") for (int ks = 0; ks < 4; ++ks) o[3] = MFMA32(va[ks], PF[ks], o[3]); \
            __builtin_amdgcn_s_setprio(0); \
            AT_SB(); } while (0)
#define AT_STEP(C0, C1, t) do { \
            if (!(VAR & 8)) { if ((t) + 2 < t1) AT_DMA((t) + 2, (kc + 2) % 3, (vc4 + 2) & 3); } \
            if (!(VAR & 2)) { if (r == 1 && (t) > t0) AT_PV_PRE((vc4 + 3) & 3); } \
            if (!(VAR & 4)) AT_QK(C0, C1, kc); else { C0 = negm; C1 = negm; }    \
            if (!(VAR & 2)) { if (r == 1 && (t) > t0) AT_PV_RUN(pfp, (vc4 + 3) & 3); if (r == 0) AT_PV_PRE(vc4); } \
            AT_SB(); \
            asm volatile("s_nop 15\n\ts_nop 7" : "+v"(C0), "+v"(C1));     \
            if (!(VAR & 1)) { \
            float rm, rb_; \
            rm = max3f(C0[0], C0[1], C1[0]); rb_ = max3f(C0[2], C0[3], C1[1]); rm = max3f(rm, C1[2], C1[3]); \
            _Pragma("unroll") for (int i = 4; i < 16; i += 4) { rm = max3f(rm, C0[i], C0[i + 1]); rb_ = max3f(rb_, C0[i + 2], C0[i + 3]); rm = max3f(rm, C1[i], C1[i + 1]); rb_ = max3f(rb_, C1[i + 2], C1[i + 3]); } \
            rm = xhalf_max(fmaxf(rm, rb_)); \
            if (__any(rm > 8.0f) || (t) == t0) { const float dl = (t) == t0 ? rm : fmaxf(rm, 0.f), alpha = fast_exp2(-dl); mrun += dl; lrun *= alpha; \
                _Pragma("unroll") for (int i = 0; i < 16; ++i) { C0[i] -= dl; C1[i] -= dl; negm[i] = -mrun; } \
                _Pragma("unroll") for (int db = 0; db < 4; ++db) _Pragma("unroll") for (int i = 0; i < 16; ++i) o[db][i] *= alpha; } \
            f32x2_t ps_ = (f32x2_t){0.f, 0.f}; \
            _Pragma("unroll") for (int i = 0; i < 16; i += 2) { C0[i] = fast_exp2(C0[i]); C0[i + 1] = fast_exp2(C0[i + 1]); C1[i] = fast_exp2(C1[i]); C1[i + 1] = fast_exp2(C1[i + 1]); \
                ps_ += (f32x2_t){C0[i], C0[i + 1]}; ps_ += (f32x2_t){C1[i], C1[i + 1]}; } \
            lrun += ps_[0] + ps_[1]; \
            } \
            { v4u w; \
              w.x = pk2(C0[0], C0[1]); w.y = pk2(C0[2], C0[3]); w.z = pk2(C0[4], C0[5]); w.w = pk2(C0[6], C0[7]); pfp[0] = __builtin_bit_cast(bf16x8, w); \
              w.x = pk2(C0[8], C0[9]); w.y = pk2(C0[10], C0[11]); w.z = pk2(C0[12], C0[13]); w.w = pk2(C0[14], C0[15]); pfp[1] = __builtin_bit_cast(bf16x8, w); \
              w.x = pk2(C1[0], C1[1]); w.y = pk2(C1[2], C1[3]); w.z = pk2(C1[4], C1[5]); w.w = pk2(C1[6], C1[7]); pfp[2] = __builtin_bit_cast(bf16x8, w); \
              w.x = pk2(C1[8], C1[9]); w.y = pk2(C1[10], C1[11]); w.z = pk2(C1[12], C1[13]); w.w = pk2(C1[14], C1[15]); pfp[3] = __builtin_bit_cast(bf16x8, w); } \
            AT_SB(); \
            if (!(VAR & 2)) { if (r == 0) AT_PV_RUN(pfp, vc4); } \
            if (!(VAR & 8) && (t) + 2 < t1) asm volatile("s_waitcnt vmcnt(4) lgkmcnt(0)" ::: "memory"); else asm volatile("s_waitcnt vmcnt(0) lgkmcnt(0)" ::: "memory"); \
            __builtin_amdgcn_s_barrier(); asm volatile("" ::: "memory"); \
            kc = (kc + 1) % 3; vc4 = (vc4 + 1) & 3; } while (0)
        bf16x8 pfp[4];
#pragma unroll
        for (int i = 0; i < 4; ++i) pfp[i] = (bf16x8){0, 0, 0, 0, 0, 0, 0, 0};
        int kc = 0, vc4 = 0;
        AT_DMA(t0, 0, 0); AT_DMA(t0 + 1, 1, 1);
        asm volatile("s_waitcnt vmcnt(4) lgkmcnt(0)" ::: "memory"); __builtin_amdgcn_s_barrier(); asm volatile("" ::: "memory");
        for (int t = t0; t < t1; ++t) {
            f32x16 sa0, sa1;
            AT_STEP(sa0, sa1, t);
        }
        if (!(VAR & 2)) { if (r == 1) { AT_PV_PRE((vc4 + 3) & 3); AT_PV_RUN(pfp, (vc4 + 3) & 3); } }
        __syncthreads();
#undef AT_PV_PRE
#undef AT_PV_RUN
#undef AT_ROWB
#undef AT_DMA
#undef AT_SB
#undef AT_QK
#undef AT_STEP
        lrun = xhalf_sum(lrun);
        const float inv = 1.0f / lrun;
        LAS float* xch = (LAS float*)lds + rg * 4096;
        if (r == 1) {
#pragma unroll
            for (int db = 0; db < 4; ++db)
#pragma unroll
                for (int i = 0; i < 16; ++i) xch[(db * 16 + i) * 64 + lane] = o[db][i] * inv;
        }
        __syncthreads();
        if (r == 0) {
            float ss = 0.f;
#pragma unroll
            for (int db = 0; db < 4; ++db)
#pragma unroll
                for (int i = 0; i < 16; ++i) { const float d = o[db][i] * inv - lamv * xch[(db * 16 + i) * 64 + lane]; o[db][i] = d; ss += d * d; }
            ss = xhalf_sum(ss);
            const float rn = (1.0f / sqrtf(ss * (1.0f / 128.0f) + 1e-6f)) * (1.0f - lam_init);
            bf16* op = AO + (size_t)(qrow0 + rg * 32 + q32) * DM + h * 128;
#pragma unroll
            for (int db = 0; db < 4; ++db)
#pragma unroll
                for (int i4 = 0; i4 < 4; ++i4) {
                    const int dcol = 32 * db + 8 * i4 + 4 * hi;
                    const f32x4 g4 = *(const f32x4*)(subg + dcol);
                    v2u w; w.x = pk2(o[db][4 * i4] * rn * g4[0], o[db][4 * i4 + 1] * rn * g4[1]); w.y = pk2(o[db][4 * i4 + 2] * rn * g4[2], o[db][4 * i4 + 3] * rn * g4[3]);
                    *(v2u*)(op + dcol) = w;
                }
        }
        __syncthreads();
    }
}

__device__ __forceinline__ void sgmix_phase(LAS unsigned char* lds, const bf16* ZU, const bf16* ZVT, const float* stats, const bf16* WS, const float* bs, const float* lng, const float* lnb, bf16* Gout, int nchunks, int G, int blk, int tid) {
    const int lane = tid & 63, wave = __builtin_amdgcn_readfirstlane(tid >> 6), q32 = lane & 31, hi = lane >> 5;
    const int vcu = (G % 8 == 0) ? (blk % 8) * (G / 8) + blk / 8 : blk;
    const int tb = wave >> 1, ch = wave & 1;
    int buf = 0;
    for (int u = vcu; u < nchunks * 8; u += G, buf ^= 1) {
        const int chunk = u >> 3, g = u & 7;
        LAS unsigned char* tile = lds + buf * 34816;
        LAS float* smu = (LAS float*)(lds + 69632 + buf * 1024); LAS float* srs = smu + 128;
        const bf16* wp = WS + ((size_t)g * 128 + tb * 32 + q32) * 128 + hi * 8;
        bf16x8 wf[8];
#pragma unroll
        for (int k = 0; k < 8; ++k) wf[k] = *(const bf16x8*)(wp + k * 16);
        const int t = tb * 32 + q32; const size_t row = (size_t)chunk * 128 + t;
        const float bias = bs[g * 128 + t];
        v2u ug[2][4];
#pragma unroll
        for (int cb = 0; cb < 2; ++cb)
#pragma unroll
            for (int i4 = 0; i4 < 4; ++i4) ug[cb][i4] = *(const v2u*)(ZU + row * DM + g * 128 + ch * 64 + cb * 32 + 8 * i4 + 4 * hi);
        v4u raw[4];
#pragma unroll
        for (int it = 0; it < 4; ++it) { const int idx = it * 512 + tid, c = idx >> 4, s8 = (idx & 15) * 8; raw[it] = *(const v4u*)(ZVT + ((size_t)chunk * DM + g * 128 + c) * 128 + s8); }
        {
            const int r = tid >> 2, part = tid & 3;
            const f32x4* sp = (const f32x4*)(stats + ((size_t)(chunk * 128 + r) * 16 + part * 4) * 2);
            const f32x4 a0 = sp[0], a1 = sp[1];
            float s1 = (a0[0] + a0[2]) + (a1[0] + a1[2]), s2 = (a0[1] + a0[3]) + (a1[1] + a1[3]);
            s1 += __shfl_xor(s1, 1); s2 += __shfl_xor(s2, 1); s1 += __shfl_xor(s1, 2); s2 += __shfl_xor(s2, 2);
            if (part == 0) { const float mu = s1 * (1.0f / DM); const float var = fmaxf(s2 * (1.0f / DM) - mu * mu, 0.f); smu[r] = mu; srs[r] = 1.0f / sqrtf(var + 1e-5f); }
        }
        __syncthreads();
#pragma unroll
        for (int it = 0; it < 4; ++it) {
            const int idx = it * 512 + tid, c = idx >> 4, s8 = (idx & 15) * 8;
            const float gg = lng[g * 128 + c], bb = lnb[g * 128 + c];
            float y[8];
#pragma unroll
            for (int j = 0; j < 4; ++j) { const unsigned wv = raw[it][j];
                y[2 * j] = (bf2f(wv & 0xffffu) - smu[s8 + 2 * j]) * srs[s8 + 2 * j] * gg + bb;
                y[2 * j + 1] = (bf2f(wv >> 16) - smu[s8 + 2 * j + 1]) * srs[s8 + 2 * j + 1] * gg + bb; }
            v4u w; w.x = pk2(y[0], y[1]); w.y = pk2(y[2], y[3]); w.z = pk2(y[4], y[5]); w.w = pk2(y[6], y[7]);
            *(LAS v4u*)(tile + c * 272 + s8 * 2) = w;
        }
        __syncthreads();
        f32x16 acc0, acc1;
#pragma unroll
        for (int i = 0; i < 16; ++i) { acc0[i] = 0.f; acc1[i] = 0.f; }
        const LAS unsigned char* bp = tile + (ch * 64 + q32) * 272 + hi * 16;
#pragma unroll
        for (int k = 0; k < 8; ++k) {
            const bf16x8 b0 = *(const LAS bf16x8*)(bp + k * 32), b1 = *(const LAS bf16x8*)(bp + 32 * 272 + k * 32);
            acc0 = MFMA32(b0, wf[k], acc0); acc1 = MFMA32(b1, wf[k], acc1);
        }
#pragma unroll
        for (int i4 = 0; i4 < 4; ++i4) {
            const int col = g * 128 + ch * 64 + 8 * i4 + 4 * hi;
            const f32x4 u0 = (f32x4){bf2f(ug[0][i4].x & 0xffffu), bf2f(ug[0][i4].x >> 16), bf2f(ug[0][i4].y & 0xffffu), bf2f(ug[0][i4].y >> 16)};
            const f32x4 u1 = (f32x4){bf2f(ug[1][i4].x & 0xffffu), bf2f(ug[1][i4].x >> 16), bf2f(ug[1][i4].y & 0xffffu), bf2f(ug[1][i4].y >> 16)};
            const f32x4 m0 = (f32x4){acc0[4 * i4], acc0[4 * i4 + 1], acc0[4 * i4 + 2], acc0[4 * i4 + 3]}, m1 = (f32x4){acc1[4 * i4], acc1[4 * i4 + 1], acc1[4 * i4 + 2], acc1[4 * i4 + 3]};
            sth4(Gout + row * DM + col, (m0 + bias) * u0);
            sth4(Gout + row * DM + col + 32, (m1 + bias) * u1);
        }
    }
    __syncthreads();
}

#define XB_TMO      128
#define XB_XCNT(j)  (256  + 64 * (j))
#define XB_XSUB(j)  (1280 + 64 * (j))
#define XB_XGEN(j)  (2304 + 64 * (j))
#define XB_TOP      3328
#define XB_TOPGEN   3392
#define XCD_BAR_WORDS 3456
#define XB_SPIN_CAP (1u << 18)

__device__ __forceinline__ unsigned xb_ld(unsigned* p)              { return __hip_atomic_load(p, __ATOMIC_RELAXED, __HIP_MEMORY_SCOPE_AGENT); }
__device__ __forceinline__ unsigned xb_add(unsigned* p, unsigned v) { return __hip_atomic_fetch_add(p, v, __ATOMIC_RELAXED, __HIP_MEMORY_SCOPE_AGENT); }
__device__ __forceinline__ unsigned xb_xcc_id() { return (unsigned)__builtin_amdgcn_s_getreg((3 << 11) | 20) & 0xFu; }
#define XB_SPIN(cond, bar) do { unsigned _sp = 0; while (cond) { __builtin_amdgcn_s_sleep(1); \
    if ((++_sp & 255u) == 0u) { if (xb_ld(&(bar)[XB_TMO])) break; if (_sp > XB_SPIN_CAP) { atomicAdd(&(bar)[XB_TMO], 1u); break; } } } } while (0)

struct XcdBarrier {
    unsigned* bar; unsigned x;
    volatile LAS unsigned* st;
};

__device__ __forceinline__ XcdBarrier xcd_barrier_post(unsigned* bar, volatile LAS unsigned* st) {
    XcdBarrier b; b.bar = bar; b.x = xb_xcc_id(); b.st = st;
    if (threadIdx.x == 0) (void)xb_add(&bar[XB_XCNT(b.x)], 1u);
    return b;
}
__device__ __forceinline__ void xcd_barrier_complete(unsigned* bar, unsigned x, unsigned& nloc, unsigned& nx) {
    const unsigned G = gridDim.x * gridDim.y * gridDim.z;
    unsigned sum, cnt, mine, sp = 0u;
    for (;;) {
        sum = 0u; cnt = 0u; mine = 0u;
#pragma unroll
        for (unsigned j = 0; j < 16; ++j) { const unsigned c = xb_ld(&bar[XB_XCNT(j)]); sum += c; cnt += (c > 0u) ? 1u : 0u; mine = (j == x) ? c : mine; }
        if (sum == G) break;
        __builtin_amdgcn_s_sleep(1);
        if ((++sp & 255u) == 0u) { if (xb_ld(&bar[XB_TMO])) break; if (sp > XB_SPIN_CAP) { atomicAdd(&bar[XB_TMO], 1u); break; } }
    }
    nloc = mine > 0u ? mine : 1u; nx = cnt > 0u ? cnt : 1u;
}

__device__ __forceinline__ void xcd_barrier(const XcdBarrier& b) {
    asm volatile("s_waitcnt vmcnt(0)" ::: "memory");
    __syncthreads();
    if (threadIdx.x == 0) {
        unsigned* bar = b.bar;
        __builtin_amdgcn_s_waitcnt(0);
        unsigned nloc = b.st[0], nx = b.st[1];
        if (nloc == 0u) { xcd_barrier_complete(bar, b.x, nloc, nx); b.st[0] = nloc; b.st[1] = nx; }
        const unsigned old = xb_add(&bar[XB_XSUB(b.x)], 1u);
        const unsigned gen = old / nloc;
        if (old + 1u == (gen + 1u) * nloc) {
            __builtin_amdgcn_fence(__ATOMIC_RELEASE, "agent");
            asm volatile("s_waitcnt vmcnt(0)" ::: "memory");
            const unsigned og = xb_add(&bar[XB_TOP], 1u);
            const unsigned tg = og / nx;
            if (og + 1u == (tg + 1u) * nx) xb_add(&bar[XB_TOPGEN], 1u);
            else XB_SPIN(xb_ld(&bar[XB_TOPGEN]) == tg, bar);
            __builtin_amdgcn_fence(__ATOMIC_ACQUIRE, "agent");
            xb_add(&bar[XB_XGEN(b.x)], 1u);
            asm volatile("s_waitcnt vmcnt(0)" ::: "memory");
        } else {
            XB_SPIN(xb_ld(&bar[XB_XGEN(b.x)]) == gen, bar);
            __builtin_amdgcn_fence(__ATOMIC_ACQUIRE, "agent");
            asm volatile("s_waitcnt vmcnt(0)" ::: "memory");
        }
    }
    __syncthreads();
}

constexpr int LDS_BYTES = 131072 + 2048;
__global__ void __launch_bounds__(512, 2) hybrid_fwd(Args a) {
    extern __shared__ __attribute__((aligned(16))) unsigned char lds_raw[];
    LAS unsigned char* lds = (LAS unsigned char*)lds_raw;
    cg::grid_group grid = cg::this_grid();
    const int G = gridDim.x, blk = blockIdx.x;
    if (threadIdx.x < 4) ((LAS unsigned*)(lds + 131072 + 512))[threadIdx.x] = 0u;
    __syncthreads();
    (void)xcd_barrier_post((unsigned*)(get_args().ws() + OFF_BAR), (volatile LAS unsigned*)(lds + 131072 + 512));
#define GRID_BARRIER() do { XcdBarrier xb_; xb_.bar = (unsigned*)(get_args().ws() + OFF_BAR); xb_.x = (unsigned)__builtin_amdgcn_readfirstlane((int)xb_xcc_id()); xb_.st = (volatile LAS unsigned*)(lds + 131072 + 512); xcd_barrier(xb_); } while (0)

#ifdef PROBE_XMASK
    LAS unsigned* pacc = (LAS unsigned*)(lds + 131072 + 1024);
    if (threadIdx.x == 0) { for (int i = 0; i < 16; ++i) pacc[i] = 0u; const unsigned long long t = __builtin_amdgcn_s_memrealtime(); pacc[16] = (unsigned)t; }
#define PSTAMP(type) do { if (threadIdx.x == 0) { const unsigned t_ = (unsigned)__builtin_amdgcn_s_memrealtime(); pacc[(type)] += t_ - pacc[16]; pacc[16] = t_; } } while (0)
#else
#define PSTAMP(type) do {} while (0)
#endif
#ifndef DIS_PRO
    prologue(lds, blk, G, threadIdx.x);
#endif
    if (G == 0x7fffffff) grid.sync();
    GRID_BARRIER();
    PSTAMP(0);

    for (int ph = 0; ph < 41; ++ph) {
        int tid = threadIdx.x; asm volatile("" : "+v"(tid));
        const int lane = tid & 63, wave = __builtin_amdgcn_readfirstlane(tid >> 6);
        const int gw = blk * 8 + wave, NGW = G * 8;
        const ArgView a = get_args();
        unsigned char* ws = a.ws();
        bf16* H = (bf16*)(ws + OFF_H);
        bf16* XN = (bf16*)(ws + OFF_XN);
        bf16* BIG = (bf16*)(ws + OFF_BIG);
        const float* MOD = (const float*)(ws + OFF_MOD);
        if (ph == 40) { final_norm_phase(H, a.out(), a.in(I_FINALG), gw, NGW, lane);
#ifdef PROBE_XMASK
            GRID_BARRIER(); PSTAMP(9);
            if (blk == 0 && threadIdx.x == 0) {
                unsigned xt = 0, yt = 0;
                for (int i = 0; i < 16; ++i) { if ((PROBE_XMASK >> i) & 1) xt += pacc[i]; if ((PROBE_YMASK >> i) & 1) yt += pacc[i]; }
                const unsigned xus = xt / 100u, yq = (yt / 100u + 16u) / 32u;
                const unsigned long long spin = ((unsigned long long)xus + 2048ull * yq) * 100ull, t0 = __builtin_amdgcn_s_memrealtime();
                while (__builtin_amdgcn_s_memrealtime() - t0 < spin) __builtin_amdgcn_s_sleep(32);
            }
#endif
            break; }
        const int l = ph / 10, s = ph % 10, j = l >> 1;
        const bool attn_layer = (l & 1) == 0;
        const float* modl = MOD + (size_t)l * 9 * NMODW;
        int Mrows = TT; if (l == 3 || (l == 2 && s >= 6)) Mrows = TL;
        if (s == 0 || s == 3 || s == 7) {
            const int k = s == 0 ? 0 : (s == 3 ? 1 : 2);
            const bool init = (ph == 0);
#ifndef DIS_NORM
            int pl = l, pg = 2, pn = 0; float pc = 0.5f;
            if (k == 0) { pl = l - 1; pg = 8; pn = (l == 1 || l == 2) ? 8 : 0; }
            else if (k == 1) { pg = 2; pn = (l <= 2) ? 8 : 0; }
            else { pg = 5; pc = 1.0f; pn = (l <= 1) ? 4 : 0; }
            if (pl < 0) pl = 0;
            if (init) norm_phase<true>(a.in(I_X), a.in(I_CTX), H, XN, a.in(I_NORMG) + (size_t)(l * 3 + k) * DM, modl, 3 * k, 3 * k + 1, Mrows, gw, NGW, lane, (const bf16*)(ws + OFF_PART), 0, MOD, pc);
            else norm_phase<false>(nullptr, nullptr, H, XN, a.in(I_NORMG) + (size_t)(l * 3 + k) * DM, modl, 3 * k, 3 * k + 1, Mrows, gw, NGW, lane,
                       (const bf16*)(ws + OFF_PART), pn, MOD + (size_t)(pl * 9 + 8) * NMODW + pg * DM, pc);
#endif
        } else if (s == 1 || s == 8) {
            const int f = s == 1 ? 0 : 1;
            pg8::Gemm g{XN, (const bf16*)(ws + OFF_WGU) + (size_t)(l * 2 + f) * 2 * DFF * DM, Mrows, 2 * DFF, DM};
            pg8::StaticOrder S; S.init(Mrows, 2 * DFF, G, blk); S.nkt_full = DM / 64;
            EpiSwiGLU E{BIG};
#ifndef DIS_GU
            pg8::gemm_phase<EpiSwiGLU, pg8::StaticOrder, true, true>(lds, g, S, E);
#endif
        } else if (s == 2 || s == 9 || s == 6) {
            const bf16* A; const bf16* Bt; int Kd; int gidx; float coef;
            if (s == 6) { A = XN; Kd = DM; gidx = 5; coef = 1.0f; Bt = attn_layer ? (const bf16*)(ws + OFF_WOUTA) + (size_t)j * DM * DM : (const bf16*)(ws + OFF_WOUTS) + (size_t)j * DM * DM; }
            else { const int f = s == 2 ? 0 : 1; A = BIG; Kd = DFF; gidx = s == 2 ? 2 : 8; coef = 0.5f; Bt = (const bf16*)(ws + OFF_WDN) + (size_t)(l * 2 + f) * DM * DFF; }
            pg8::Gemm g{A, Bt, Mrows, DM, Kd};
            SplitOrder S; S.init(Mrows == TT ? (Kd == DFF ? 8 : 4) : 0, Kd / 64, G, blk);
            EpiResid E{ws, modl + gidx * DM, coef == 0.5f ? 1 : 0};
#ifndef DIS_RES
            pg8::gemm_phase<EpiResid, SplitOrder, true, true>(lds, g, S, E);
#endif
        } else if (s == 4) {
            if (attn_layer) {
                pg8::Gemm g{XN, (const bf16*)(ws + OFF_WINA) + (size_t)j * 3 * DM * DM, Mrows, 3 * DM, DM};
                pg8::StaticOrder S; S.init(Mrows, 3 * DM, G, blk); S.nkt_full = DM / 64;
                EpiQKV E{BIG, (bf16*)((unsigned char*)BIG + SZ_TOK), (bf16*)((unsigned char*)BIG + 2 * SZ_TOK), (const float*)(ws + OFF_ROPE)};
#ifndef DIS_QKV
                pg8::gemm_phase<EpiQKV, pg8::StaticOrder, true, true>(lds, g, S, E);
#endif
            } else {
                pg8::Gemm g{XN, (const bf16*)(ws + OFF_WINS) + (size_t)j * 2 * DM * DM, Mrows, 2 * DM, DM};
                pg8::StaticOrder S; S.init(Mrows, 2 * DM, G, blk); S.nkt_full = DM / 64;
                EpiSG E{BIG, (bf16*)((unsigned char*)BIG + SZ_TOK), (float*)(ws + OFF_SGST2) + (size_t)j * TT * 32};
#ifndef DIS_SG
                pg8::gemm_phase<EpiSG, pg8::StaticOrder, true, true>(lds, g, S, E);
#endif
            }
        } else {
            if (attn_layer) {
                const float lam_init = 0.8f - 0.6f * __expf(-0.3f * (float)l);
#ifndef DIS_ATT
                attn_phase<0>(lds, BIG, (const bf16*)((unsigned char*)BIG + SZ_TOK), (const bf16*)((unsigned char*)BIG + 2 * SZ_TOK), XN, a.in(I_DALAM) + j * 256, a.in(I_DASUB) + j * 128, lam_init, l == 0, G, blk, tid);
#ifdef PROBE_ATT
                if (l == 0) attn_phase<PROBE_ATT>(lds, BIG, (const bf16*)((unsigned char*)BIG + SZ_TOK), (const bf16*)((unsigned char*)BIG + 2 * SZ_TOK), (bf16*)(ws + OFF_PART), a.in(I_DALAM) + j * 256, a.in(I_DASUB) + j * 128, lam_init, false, G, blk, tid);
#endif
#endif
            } else {
#ifndef DIS_MIX
                sgmix_phase(lds, BIG, (const bf16*)((unsigned char*)BIG + SZ_TOK), (const float*)(ws + OFF_SGST2) + (size_t)j * TT * 32, (const bf16*)(ws + OFF_WSS) + (size_t)j * 8 * 128 * 128,
                            a.in(I_SGBS) + j * 8 * 128, a.in(I_SGLNG) + j * DM, a.in(I_SGLNB) + j * DM, XN, Mrows / 128, G, blk, tid);
#endif
            }
        }
        if (l < 3 && (s == 1 || s == 4 || s == 8)) {
            const int which = s == 1 ? 0 : (s == 4 ? 1 : 2);
            const int nid = conv_idle_phase(l, which, G), tot_idle = conv_idle_total(l, G);
            const int nwg = which == 0 ? (TT / 256) * 22 : (which == 1 ? (TT / 256) * (attn_layer ? 12 : 8) : ((l < 2 ? TT : TL) / 256) * 22);
            const int rem = nwg % G;
            if (nid > 0 && blk >= rem) {
                const int L = l + 1, tot = conv_layer_count(L);
                const int before = which == 0 ? 0 : (which == 1 ? conv_idle_phase(l, 0, G) : conv_idle_phase(l, 0, G) + conv_idle_phase(l, 1, G));
                const int first = (int)((long long)tot * before / tot_idle), last = (int)((long long)tot * (before + nid) / tot_idle);
                conv_layer_items(a, ws, L, first, last, (blk - rem) * 8 + wave, nid * 8, (LAS float*)(lds + wave * 16384), lane);
            }
        }
        GRID_BARRIER();
#ifdef PROBE_SYNC3
        GRID_BARRIER(); GRID_BARRIER();
#endif
        PSTAMP(s == 0 || s == 3 || s == 7 ? 1 : (s == 1 || s == 8 ? 2 : (s == 2 || s == 9 ? 3 : (s == 6 ? 4 : (s == 4 ? (attn_layer ? 5 : 6) : (attn_layer ? 7 : 8))))));
    }
}

extern "C" void kernel_launch(void* const* d_in, const int* in_sizes, int n_in, void* d_out, int out_size, void* d_ws, size_t ws_size, hipStream_t stream) {
    static int grid = 0;
    if (grid == 0) {
        if (n_in != 20 || ws_size < WS_NEED || out_size != TL * DM) { fprintf(stderr, "kernel_launch: unexpected problem (n_in %d, ws %zu, out %d)\n", n_in, ws_size, out_size); grid = -1; return; }
        int dev = 0, cus = 0, per_cu = 0;
        if (hipGetDevice(&dev) != hipSuccess || hipDeviceGetAttribute(&cus, hipDeviceAttributeMultiprocessorCount, dev) != hipSuccess) { grid = -1; return; }
        if (hipFuncSetAttribute((const void*)hybrid_fwd, hipFuncAttributeMaxDynamicSharedMemorySize, LDS_BYTES) != hipSuccess) { fprintf(stderr, "kernel_launch: hipFuncSetAttribute failed\n"); grid = -1; return; }
        if (hipOccupancyMaxActiveBlocksPerMultiprocessor(&per_cu, (const void*)hybrid_fwd, 512, LDS_BYTES) != hipSuccess || per_cu < 1) { fprintf(stderr, "kernel_launch: occupancy query says %d\n", per_cu); per_cu = 1; }
        (void)hipGetLastError();
        grid = cus;
    }
    if (grid < 0) return;
    if (hipMemsetAsync((char*)d_ws + OFF_BAR, 0, 16384, stream) != hipSuccess) { fprintf(stderr, "kernel_launch: memset failed\n"); return; }
    Args a{};
    for (int i = 0; i < 20; ++i) a.in_[i] = (GAS const float*)d_in[i];
    a.out_ = (GAS float*)d_out; a.ws_ = (GAS unsigned char*)d_ws;
    void* params[] = {&a};
    hipError_t e = hipLaunchCooperativeKernel((const void*)hybrid_fwd, dim3(grid), dim3(512), params, LDS_BYTES, stream);
    if (e != hipSuccess) fprintf(stderr, "kernel_launch: cooperative launch failed: %s (grid %d)\n", hipGetErrorString(e), grid);
}
```
